# Optimizing an MI355X kernel written in HIP

```python
import math
import jax, jax.numpy as jnp
from jax import lax
import numpy as np

D_MODEL = 1024
BATCH = 2
SEQ = 8192
DEPTH = 1
DEC_BATCH = 128
DEC_SEQ = 1
PAST_LEN = 2048
PAGE_SIZE = 128

H_A = 4
DK_A = 64
DV_A = 2 * DK_A
H_R = 4
DK_R = 64
DV_R = 128
RET_CHUNK = 128
N_MEM = 256
H_M = 4
DH_M = D_MODEL // H_M
D_FF = 4 * D_MODEL
NUM_BUCKETS = 32
MAX_DISTANCE = 128
Q_BLOCK = 128
EPS = 1e-6
ROPE_BASE = 10000.0
WA_QK = H_A * 2 * DK_A
WA_V = H_A * DV_A
WR_QK = H_R * DK_R
WR_V = H_R * DV_R
D_IN = 2 * WA_QK + WA_V + 2 * WR_QK + 2 * WR_V
D_MIX = H_A * DV_A + H_R * DV_R

kernel_name = 'hybrid_diffattn_retention_decoder_step'


def rmsnorm(x, g):
    xf = x.astype(jnp.float32)
    y = xf * lax.rsqrt(jnp.mean(xf * xf, axis=-1, keepdims=True) + EPS)
    return (y * g.astype(jnp.float32)).astype(x.dtype)


def head_rms(x):
    return x * lax.rsqrt(jnp.mean(x * x, axis=-1, keepdims=True) + EPS)


def t5_bucket(rel):
    n = jnp.maximum(rel, 0)
    max_exact = NUM_BUCKETS // 2
    nf = jnp.maximum(n, 1).astype(jnp.float32)
    large = max_exact + (jnp.log(nf / max_exact) / math.log(MAX_DISTANCE / max_exact)
                         * (NUM_BUCKETS - max_exact)).astype(jnp.int32)
    large = jnp.minimum(large, NUM_BUCKETS - 1)
    return jnp.where(n < max_exact, n, large)


def project(h, w_in):
    B, T = h.shape[0], h.shape[1]
    z = h @ w_in
    sizes = [WA_QK, WA_QK, WA_V, WR_QK, WR_QK, WR_V, WR_V]
    offs = np.cumsum(sizes)[:-1].tolist()
    qa, ka, va, qr, kr, vr, gr = jnp.split(z, offs, axis=-1)
    return (qa.reshape(B, T, H_A, 2 * DK_A), ka.reshape(B, T, H_A, 2 * DK_A),
            va.reshape(B, T, H_A, DV_A), qr.reshape(B, T, H_R, DK_R),
            kr.reshape(B, T, H_R, DK_R), vr.reshape(B, T, H_R, DV_R), gr)


def diff_attention(q, k, v, q_pos, k_pos, rel_bias, lam):
    f32 = jnp.float32
    scale = DK_A ** -0.5
    q1, q2 = q[..., :DK_A], q[..., DK_A:]
    k1, k2 = k[..., :DK_A], k[..., DK_A:]
    rel = q_pos[:, None] - k_pos[None, :]
    bias = jnp.transpose(rel_bias[t5_bucket(rel)], (2, 0, 1))[None].astype(f32)
    mask = (rel >= 0)[None, None]
    neg = jnp.finfo(f32).min

    def probs(qi, ki):
        s = jnp.einsum('bqhd,bkhd->bhqk', qi, ki).astype(f32) * scale + bias
        return jax.nn.softmax(jnp.where(mask, s, neg), axis=-1)

    attn = probs(q1, k1) - lam * probs(q2, k2)
    return jnp.einsum('bhqk,bkhd->bqhd', attn, v.astype(f32))


def diff_attention_prompt(qa, ka, va, rel_bias, lam):
    B, T = qa.shape[0], qa.shape[1]
    nb = T // Q_BLOCK
    k_pos = jnp.arange(T)

    def block(i):
        qb = lax.dynamic_slice_in_dim(qa, i * Q_BLOCK, Q_BLOCK, axis=1)
        q_pos = i * Q_BLOCK + jnp.arange(Q_BLOCK)
        return diff_attention(qb, ka, va, q_pos, k_pos, rel_bias, lam)

    ob = lax.map(block, jnp.arange(nb))
    return jnp.moveaxis(ob, 0, 1).reshape(B, T, H_A, DV_A)


def rotary(x, pos):
    half = x.shape[-1] // 2
    inv_freq = ROPE_BASE ** (-jnp.linspace(0.0, 1.0, half, dtype=jnp.float32))
    ang = pos.astype(jnp.float32)[:, None] * inv_freq[None, :]
    cos = jnp.cos(ang)[:, None, :]
    sin = jnp.sin(ang)[:, None, :]
    xf = x.astype(jnp.float32)
    x1, x2 = xf[..., :half], xf[..., half:]
    return jnp.concatenate([x1 * cos - x2 * sin, x2 * cos + x1 * sin], axis=-1)


def retention_log_decay():
    return jnp.log(1.0 - 2.0 ** (-5.0 - jnp.arange(H_R, dtype=jnp.float32)))


def retention_chunk(S, q, k, v, lg):
    C = q.shape[1]
    i = jnp.arange(C, dtype=jnp.float32)
    d = i[:, None] - i[None, :]
    decay = jnp.where(d >= 0, jnp.exp(d[None] * lg[:, None, None]), 0.0)
    scores = jnp.einsum('bihd,bjhd->bhij', q, k) * decay[None]
    o = jnp.einsum('bhij,bjhe->bihe', scores, v)
    o = o + jnp.einsum('bihd,bhde->bihe', q, S) * jnp.exp((i + 1.0)[:, None] * lg[None, :])[None, :, :, None]
    k_dec = k * jnp.exp((C - 1.0 - i)[:, None] * lg[None, :])[None, :, :, None]
    S_new = jnp.exp(C * lg)[None, :, None, None] * S + jnp.einsum('bjhd,bjhe->bhde', k_dec, v)
    return S_new, o


def retention_prompt(q, k, v, lg):
    B, T = q.shape[0], q.shape[1]
    nc = T // RET_CHUNK

    def chunks(a):
        return jnp.moveaxis(a.reshape(B, nc, RET_CHUNK, a.shape[2], a.shape[3]), 1, 0)

    S0 = jnp.zeros((B, H_R, DK_R, DV_R), jnp.float32)
    S, oc = lax.scan(lambda s, xs: retention_chunk(s, xs[0], xs[1], xs[2], lg),
                     S0, (chunks(q), chunks(k), chunks(v)))
    return S, jnp.moveaxis(oc, 0, 1).reshape(B, T, H_R, DV_R)


def merge_groups(oa, orr, gr, subln, lam_init):
    B, T = oa.shape[0], oa.shape[1]
    a = head_rms(oa) * subln.astype(jnp.float32) * (1.0 - lam_init)
    r = head_rms(orr).reshape(B, T, H_R * DV_R) * jax.nn.silu(gr.astype(jnp.float32))
    return jnp.concatenate([a.reshape(B, T, H_A * DV_A), r], axis=-1)


def mem_kv(mem, g, w_mk, w_mv):
    B, M = mem.shape[0], mem.shape[1]
    h = rmsnorm(mem, g)
    return (h @ w_mk).reshape(B, M, H_M, DH_M), (h @ w_mv).reshape(B, M, H_M, DH_M)


def mem_attend(h, mk, mv, w_mq, w_mo):
    B, T = h.shape[0], h.shape[1]
    q = (h @ w_mq).reshape(B, T, H_M, DH_M)
    s = jnp.einsum('bthd,bmhd->bhtm', q, mk.astype(q.dtype)).astype(jnp.float32) * DH_M ** -0.5
    p = jax.nn.softmax(s, axis=-1)
    o = jnp.einsum('bhtm,bmhd->bthd', p, mv.astype(jnp.float32)).reshape(B, T, D_MODEL)
    return o.astype(h.dtype) @ w_mo


def sq_relu_mlp(h, w_up, w_down):
    return jnp.square(jax.nn.relu(h @ w_up)) @ w_down


def setup_inputs(seed: int = 0) -> dict:
    key = jax.random.key(seed)
    ks = jax.random.split(key, 32)
    f32 = jnp.float32
    n_pages = PAST_LEN // PAGE_SIZE
    n_used = DEC_BATCH * n_pages
    n_phys = n_used + max(n_used // 4, 1)

    def nrm(k, shape, s=1.0):
        return jax.random.normal(k, shape, f32) * s

    def gain(k, shape):
        return 1.0 + 0.05 * jax.random.normal(k, shape, f32)

    page_table = jax.random.permutation(ks[5], n_phys)[:n_used].reshape(DEC_BATCH, n_pages).astype(jnp.int32)
    return {
        'x_prompt': nrm(ks[0], (BATCH, SEQ, D_MODEL)),
        'x_sample': nrm(ks[1], (DEC_BATCH, DEC_SEQ, D_MODEL)),
        'mem_prompt': nrm(ks[2], (BATCH, N_MEM, D_MODEL)),
        'cache_k': nrm(ks[3], (DEPTH, n_phys, PAGE_SIZE, H_A, 2 * DK_A)),
        'cache_v': nrm(ks[4], (DEPTH, n_phys, PAGE_SIZE, H_A, DV_A)),
        'page_table': page_table,
        'state_ret': nrm(ks[6], (DEPTH, DEC_BATCH, H_R, DK_R, DV_R), 0.5),
        'cache_mem_k': nrm(ks[7], (DEPTH, DEC_BATCH, N_MEM, H_M, DH_M)),
        'cache_mem_v': nrm(ks[8], (DEPTH, DEC_BATCH, N_MEM, H_M, DH_M)),
        'rel_bias': nrm(ks[9], (NUM_BUCKETS, H_A), 0.5),
        'norm_mix': gain(ks[10], (DEPTH, D_MODEL)),
        'w_in': nrm(ks[11], (DEPTH, D_MODEL, D_IN), D_MODEL ** -0.5),
        'lambda_q1': nrm(ks[12], (DEPTH, DK_A), 0.1),
        'lambda_k1': nrm(ks[13], (DEPTH, DK_A), 0.1),
        'lambda_q2': nrm(ks[14], (DEPTH, DK_A), 0.1),
        'lambda_k2': nrm(ks[15], (DEPTH, DK_A), 0.1),
        'subln_a': gain(ks[16], (DEPTH, DV_A)),
        'w_out': nrm(ks[17], (DEPTH, D_MIX, D_MODEL), D_MIX ** -0.5),
        'norm_mem_q': gain(ks[18], (DEPTH, D_MODEL)),
        'norm_mem_kv': gain(ks[19], (DEPTH, D_MODEL)),
        'w_mq': nrm(ks[20], (DEPTH, D_MODEL, D_MODEL), D_MODEL ** -0.5),
        'w_mk': nrm(ks[21], (DEPTH, D_MODEL, D_MODEL), D_MODEL ** -0.5),
        'w_mv': nrm(ks[22], (DEPTH, D_MODEL, D_MODEL), D_MODEL ** -0.5),
        'w_mo': nrm(ks[23], (DEPTH, D_MODEL, D_MODEL), D_MODEL ** -0.5),
        'norm_mlp': gain(ks[24], (DEPTH, D_MODEL)),
        'w_up': nrm(ks[25], (DEPTH, D_MODEL, D_FF), D_MODEL ** -0.5),
        'w_down': nrm(ks[26], (DEPTH, D_FF, D_MODEL), D_FF ** -0.5),
        'norm_final': gain(ks[27], (D_MODEL,)),
    }


def reference(x_prompt, x_sample, mem_prompt, cache_k, cache_v, page_table, state_ret,
              cache_mem_k, cache_mem_v, rel_bias, norm_mix, w_in, lambda_q1, lambda_k1,
              lambda_q2, lambda_k2, subln_a, w_out, norm_mem_q, norm_mem_kv, w_mq, w_mk,
              w_mv, w_mo, norm_mlp, w_up, w_down, norm_final):
    f32 = jnp.float32
    B, T = x_prompt.shape[0], x_prompt.shape[1]
    Bd, Td = x_sample.shape[0], x_sample.shape[1]
    past = page_table.shape[1] * PAGE_SIZE
    pos_p = jnp.arange(T)
    pos_d = past + jnp.arange(Td)
    kpos_d = jnp.arange(past + Td)
    lg = retention_log_decay()
    kr_scale = DK_R ** -0.5

    xp, xd = x_prompt, x_sample
    kp_l, vp_l, sp_l, mkp_l, mvp_l, kd_l, vd_l, sd_l = [], [], [], [], [], [], [], []
    for l in range(DEPTH):
        lam_init = 0.8 - 0.6 * math.exp(-0.3 * l)
        lam = (jnp.exp(jnp.sum(lambda_q1[l].astype(f32) * lambda_k1[l].astype(f32)))
               - jnp.exp(jnp.sum(lambda_q2[l].astype(f32) * lambda_k2[l].astype(f32))) + lam_init)

        hp = rmsnorm(xp, norm_mix[l])
        qa, ka, va, qr, kr, vr, gr = project(hp, w_in[l])
        oa = diff_attention_prompt(qa, ka, va, rel_bias, lam)
        s_p, o_r = retention_prompt(rotary(qr, pos_p), rotary(kr, pos_p) * kr_scale, vr.astype(f32), lg)
        xp = xp + merge_groups(oa, o_r, gr, subln_a[l], lam_init).astype(xp.dtype) @ w_out[l]
        mk_p, mv_p = mem_kv(mem_prompt, norm_mem_kv[l], w_mk[l], w_mv[l])
        xp = xp + mem_attend(rmsnorm(xp, norm_mem_q[l]), mk_p, mv_p, w_mq[l], w_mo[l])
        xp = xp + sq_relu_mlp(rmsnorm(xp, norm_mlp[l]), w_up[l], w_down[l])
        kp_l.append(ka.reshape(B, T // PAGE_SIZE, PAGE_SIZE, H_A, 2 * DK_A))
        vp_l.append(va.reshape(B, T // PAGE_SIZE, PAGE_SIZE, H_A, DV_A))
        sp_l.append(s_p)
        mkp_l.append(mk_p)
        mvp_l.append(mv_p)

        hd = rmsnorm(xd, norm_mix[l])
        qa_d, ka_d, va_d, qr_d, kr_d, vr_d, gr_d = project(hd, w_in[l])
        k_past = cache_k[l][page_table].reshape(Bd, past, H_A, 2 * DK_A)
        v_past = cache_v[l][page_table].reshape(Bd, past, H_A, DV_A)
        k_all = jnp.concatenate([k_past.astype(ka_d.dtype), ka_d], axis=1)
        v_all = jnp.concatenate([v_past.astype(va_d.dtype), va_d], axis=1)
        oa_d = diff_attention(qa_d, k_all, v_all, pos_d, kpos_d, rel_bias, lam)
        s_d, o_rd = retention_chunk(state_ret[l].astype(f32), rotary(qr_d, pos_d),
                                    rotary(kr_d, pos_d) * kr_scale, vr_d.astype(f32), lg)
        xd = xd + merge_groups(oa_d, o_rd, gr_d, subln_a[l], lam_init).astype(xd.dtype) @ w_out[l]
        xd = xd + mem_attend(rmsnorm(xd, norm_mem_q[l]), cache_mem_k[l], cache_mem_v[l], w_mq[l], w_mo[l])
        xd = xd + sq_relu_mlp(rmsnorm(xd, norm_mlp[l]), w_up[l], w_down[l])
        kd_l.append(ka_d)
        vd_l.append(va_d)
        sd_l.append(s_d)

    y_prompt = rmsnorm(xp, norm_final)
    y_sample = rmsnorm(xd, norm_final)
    k_prompt = jnp.stack(kp_l)
    v_prompt = jnp.stack(vp_l)
    state_ret_prompt = jnp.stack(sp_l)
    mem_k_prompt = jnp.stack(mkp_l)
    mem_v_prompt = jnp.stack(mvp_l)
    k_sample = jnp.stack(kd_l)
    v_sample = jnp.stack(vd_l)
    state_ret_sample = jnp.stack(sd_l)
    return (y_prompt, y_sample, k_prompt, v_prompt, state_ret_prompt, mem_k_prompt, mem_v_prompt, k_sample, v_sample, state_ret_sample)
```

```cpp
#include <hip/hip_runtime.h>
#include <hip/hip_bf16.h>
#include <cstdio>
#include <cstdint>
#include <cmath>
#ifndef MK_PER_PHASE
#define MK_PER_PHASE 0
#endif
namespace pg8 {
#define PG8_LAS __attribute__((address_space(3)))
typedef unsigned short bf16_t;
typedef short bf16x8 __attribute__((ext_vector_type(8)));
typedef float f32x4 __attribute__((ext_vector_type(4)));
typedef unsigned u32x4 __attribute__((ext_vector_type(4)));
constexpr int BM = 256, BK = 64, HALF = 128, HTB = HALF * BK * 2  , STAGE_BYTES = 8 * HTB, NXCD = 8, WGM = 8;

__host__ __device__ __forceinline__ int lds_byte(int r, int c) { const int st = (r >> 4) * 2 + (c >> 5), rr = r & 15, cc = c & 31, ob = rr * 64 + cc * 2; return st * 1024 + (ob ^ (((ob >> 9) & 1) << 5)); }
__host__ __device__ __forceinline__ void stage_rc(int b, int& R, int& C) { const int st = b / 1024, sb = b % 1024, swz = sb ^ (((sb >> 9) & 1) << 5); R = (st >> 1) * 16 + swz / 64; C = (st & 1) * 32 + (swz % 64) / 2; }
__host__ __device__ __forceinline__ int perm32(int rho) { const int n = rho >> 4, i = rho & 15; return 8 * (i >> 2) + 4 * n + (i & 3); }

struct Unit { int pm, pn; };
struct Gemm { const bf16_t* A; const bf16_t* Bt; int M, N, K, lda, ldb; };

struct StaticOrder {
    int nM, nN, nwg, G, c;
    __host__ __device__ void init(int M, int N, int G_, int c_) { nM = M / BM; nN = N / BM; nwg = nM * nN; G = G_; c = c_; }
    __host__ __device__ bool next(int i, Unit& u) const {
        const long L = (long)i * G + c; if (L >= nwg) return false;
        int wgid = (int)L; { const int q = nwg / NXCD, r = nwg % NXCD, xcd = wgid % NXCD, off = wgid / NXCD; wgid = (xcd < r ? xcd * (q + 1) : r * (q + 1) + (xcd - r) * q) + off; }
        const int nig = WGM * nN, gid = wgid / nig, fm = gid * WGM, gsz = (nM - fm) < WGM ? (nM - fm) : WGM;
        u.pm = fm + ((wgid % nig) % gsz); u.pn = (wgid % nig) / gsz; return true;
    }
    __device__ __forceinline__ void a_ready(const Unit&) const {}
    __device__ __forceinline__ void done(const Unit&) const {}
};
struct OneUnit {
    Unit u0; bool has;
    __device__ __forceinline__ bool next(int i, Unit& u) const { if (i != 0 || !has) return false; u = u0; return true; }
    __device__ __forceinline__ void a_ready(const Unit&) const {}
    __device__ __forceinline__ void done(const Unit&) const {}
};
__device__ __forceinline__ unsigned cvt_pk_bf16(float lo, float hi) { unsigned r; asm volatile("v_cvt_pk_bf16_f32 %0, %1, %2" : "=v"(r) : "v"(lo), "v"(hi)); return r; }
template <class Epi, class Sched, bool ALIGN_EPI = false, bool SP2 = false>
__device__ __forceinline__ void gemm_phase(PG8_LAS unsigned char* lds, const Gemm g, const Sched& S, const Epi& E) {
    int tid_ = threadIdx.x; asm volatile("" : "+v"(tid_));
    const int tid = tid_, wid = __builtin_amdgcn_readfirstlane(tid >> 6), lane = tid & 63, wr = wid >> 2, wc = wid & 3, fr = lane & 15, fq = lane >> 4;
    const int K = g.K, nt = K / BK;
    unsigned voffA[2], voffB[2];
#pragma unroll
    for (int i = 0; i < 2; ++i) { int R, C; stage_rc(tid * 16 + i * 8192, R, C); const int Rb = Epi::PERM ? ((R & ~31) + perm32(R & 31)) : R;
        voffA[i] = (unsigned)(R * g.lda + C) * 2u; voffB[i] = (unsigned)(Rb * g.ldb + C) * 2u; }
    const size_t kstep = (size_t)(BK * 2);
    const size_t hstepA = (size_t)HALF * g.lda * 2, hstepB = (size_t)HALF * g.ldb * 2;
    const size_t tstepA = 2 * hstepA, tstepB = 2 * hstepB;
    const unsigned ldsw = (unsigned)wid * 1024u;
    const int aoff = lds_byte(wr * 64 + fr, fq * 8), boff = lds_byte(wc * 32 + fr, fq * 8);
#define PG8_SA(b, h) (((b) * 2 + (h)) * HTB)
#define PG8_SB(b, h) ((4 + (b) * 2 + (h)) * HTB)
#define PG8_STAGE(bufoff, gbase, voff) do { _Pragma("unroll") for (int _i = 0; _i < 2; ++_i) \
        __builtin_amdgcn_global_load_lds((const unsigned*)((const char*)(gbase) + (voff)[_i]), (PG8_LAS unsigned*)(lds + (bufoff) + ldsw + _i * 8192), 16, 0, 0); } while (0)
#define PG8_LDA(dst, b, h) do { _Pragma("unroll") for (int m = 0; m < 4; ++m) _Pragma("unroll") for (int k = 0; k < 2; ++k) dst[m][k] = *(const PG8_LAS bf16x8*)(lds + PG8_SA(b, h) + aoff + m * 2048 + k * 1024); } while (0)
#define PG8_LDB(dst, b, h) do { _Pragma("unroll") for (int n = 0; n < 2; ++n) _Pragma("unroll") for (int k = 0; k < 2; ++k) dst[n][k] = *(const PG8_LAS bf16x8*)(lds + PG8_SB(b, h) + boff + n * 2048 + k * 1024); } while (0)
#define PG8_MMA(ai, bj, At, Bt) do { __builtin_amdgcn_s_setprio(1); _Pragma("unroll") for (int m = 0; m < 4; ++m) _Pragma("unroll") for (int n = 0; n < 2; ++n) _Pragma("unroll") for (int k = 0; k < 2; ++k) \
        acc[ai][bj][m][n] = __builtin_amdgcn_mfma_f32_16x16x32_bf16(Bt[n][k], At[m][k], acc[ai][bj][m][n], 0, 0, 0); __builtin_amdgcn_s_setprio(0); } while (0)
#define PG8_WAIT_V(n) asm volatile("s_waitcnt vmcnt(" #n ")" ::: "memory")
#define PG8_WAIT_L(n) asm volatile("s_waitcnt lgkmcnt(" #n ")" ::: "memory")
#define PG8_BAR __builtin_amdgcn_s_barrier()
#define PG8_SCHED __builtin_amdgcn_sched_barrier(0)
    Unit cur, nxt; int ui = 0;
    if (!S.next(0, cur)) return;
    f32x4 acc[2][2][4][2];
#pragma unroll
    for (int a = 0; a < 2; ++a)
#pragma unroll
        for (int b = 0; b < 2; ++b)
#pragma unroll
            for (int m = 0; m < 4; ++m)
#pragma unroll
                for (int n = 0; n < 2; ++n) acc[a][b][m][n] = (f32x4){0.f, 0.f, 0.f, 0.f};
    bf16x8 At[4][2], B0[2][2], B1[2][2];
    const char* cA = (const char*)g.A + (size_t)cur.pm * tstepA; const char* cB = (const char*)g.Bt + (size_t)cur.pn * tstepB;
    S.a_ready(cur);
    if constexpr (SP2) {
        PG8_STAGE(PG8_SB(0, 0), cB, voffB); PG8_STAGE(PG8_SB(0, 1), cB + hstepB, voffB); PG8_STAGE(PG8_SA(0, 0), cA, voffA); PG8_STAGE(PG8_SA(0, 1), cA + hstepA, voffA);
        if (wr == 1) PG8_BAR;
        PG8_WAIT_V(2); PG8_BAR;
        PG8_STAGE(PG8_SB(1, 0), cB + kstep, voffB); PG8_STAGE(PG8_SA(1, 0), cA + kstep, voffA); PG8_STAGE(PG8_SB(1, 1), cB + hstepB + kstep, voffB);
        PG8_WAIT_V(6); PG8_BAR;
    } else {
        PG8_STAGE(PG8_SB(0, 0), cB, voffB); PG8_STAGE(PG8_SA(0, 0), cA, voffA); PG8_STAGE(PG8_SB(0, 1), cB + hstepB, voffB); PG8_STAGE(PG8_SA(0, 1), cA + hstepA, voffA);
        if (wr == 1) PG8_BAR;
        PG8_WAIT_V(4); PG8_BAR;
        PG8_STAGE(PG8_SB(1, 0), cB + kstep, voffB); PG8_STAGE(PG8_SA(1, 0), cA + kstep, voffA); PG8_STAGE(PG8_SB(1, 1), cB + hstepB + kstep, voffB);
        PG8_WAIT_V(6); PG8_BAR;
    }
    for (;;) {
        const bool has_next = S.next(ui + 1, nxt);
        const char* nA = has_next ? (const char*)g.A + (size_t)nxt.pm * tstepA : cA; const char* nB = has_next ? (const char*)g.Bt + (size_t)nxt.pn * tstepB : cB;
        for (int t = 0; t < nt; t += 2) {
            const bool last = (t == nt - 2);
            const char* a1 = cA + (size_t)(t + 1) * kstep;
            const char* a2 = last ? nA : cA + (size_t)(t + 2) * kstep; const char* b2 = last ? nB : cB + (size_t)(t + 2) * kstep;
            const char* a3 = a2 + kstep; const char* b3 = b2 + kstep;
            if (last && has_next) S.a_ready(nxt);
            if constexpr (SP2) {
            PG8_LDB(B0, 0, 0); PG8_LDB(B1, 0, 1); PG8_SCHED; PG8_LDA(At, 0, 0); PG8_STAGE(PG8_SA(1, 1), a1 + hstepA, voffA);
            PG8_WAIT_V(8); PG8_WAIT_L(0); PG8_BAR; PG8_MMA(0, 0, At, B0); PG8_MMA(0, 1, At, B1); PG8_BAR; PG8_SCHED;
            PG8_LDA(At, 0, 1); PG8_STAGE(PG8_SB(0, 0), b2, voffB); PG8_STAGE(PG8_SB(0, 1), b2 + hstepB, voffB); PG8_STAGE(PG8_SA(0, 0), a2, voffA);
            PG8_WAIT_V(8); PG8_WAIT_L(0); PG8_BAR; PG8_MMA(1, 0, At, B0); PG8_MMA(1, 1, At, B1); PG8_BAR; PG8_SCHED;
            PG8_LDB(B0, 1, 0); PG8_LDB(B1, 1, 1); PG8_SCHED; PG8_LDA(At, 1, 0); PG8_STAGE(PG8_SA(0, 1), a2 + hstepA, voffA);
            PG8_WAIT_V(8); PG8_WAIT_L(0); PG8_BAR; PG8_MMA(0, 0, At, B0); PG8_MMA(0, 1, At, B1); PG8_BAR; PG8_SCHED;
            PG8_LDA(At, 1, 1); PG8_STAGE(PG8_SB(1, 0), b3, voffB); PG8_STAGE(PG8_SB(1, 1), b3 + hstepB, voffB); PG8_STAGE(PG8_SA(1, 0), a3, voffA);
            PG8_WAIT_V(8); PG8_WAIT_L(0); PG8_BAR; PG8_MMA(1, 0, At, B0); PG8_MMA(1, 1, At, B1); PG8_BAR; PG8_SCHED;
            } else {
            PG8_LDB(B0, 0, 0); PG8_SCHED; PG8_LDA(At, 0, 0); PG8_STAGE(PG8_SA(1, 1), a1 + hstepA, voffA);
            PG8_WAIT_L(8); PG8_BAR; PG8_WAIT_L(0); PG8_MMA(0, 0, At, B0); PG8_BAR; PG8_SCHED;
            PG8_LDB(B1, 0, 1); PG8_STAGE(PG8_SB(0, 0), b2, voffB);
            PG8_BAR; PG8_WAIT_L(0); PG8_MMA(0, 1, At, B1); PG8_BAR;
            PG8_LDA(At, 0, 1); PG8_STAGE(PG8_SA(0, 0), a2, voffA);
            PG8_BAR; PG8_WAIT_L(0); PG8_MMA(1, 0, At, B0); PG8_BAR; PG8_SCHED;
            PG8_STAGE(PG8_SB(0, 1), b2 + hstepB, voffB);
            PG8_WAIT_V(6); PG8_BAR; PG8_MMA(1, 1, At, B1); PG8_BAR;
            PG8_LDB(B0, 1, 0); PG8_SCHED; PG8_LDA(At, 1, 0); PG8_STAGE(PG8_SA(0, 1), a2 + hstepA, voffA);
            PG8_WAIT_L(8); PG8_BAR; PG8_WAIT_L(0); PG8_MMA(0, 0, At, B0); PG8_BAR; PG8_SCHED;
            PG8_LDB(B1, 1, 1); PG8_STAGE(PG8_SB(1, 0), b3, voffB);
            PG8_BAR; PG8_WAIT_L(0); PG8_MMA(0, 1, At, B1); PG8_BAR;
            PG8_LDA(At, 1, 1); PG8_STAGE(PG8_SA(1, 0), a3, voffA);
            PG8_BAR; PG8_WAIT_L(0); PG8_MMA(1, 0, At, B0); PG8_BAR; PG8_SCHED;
            PG8_STAGE(PG8_SB(1, 1), b3 + hstepB, voffB);
            PG8_WAIT_V(6); PG8_BAR; PG8_MMA(1, 1, At, B1); PG8_BAR;
            }
        }
        if constexpr (ALIGN_EPI) { if (wr == 0) PG8_BAR; }
        if constexpr (!Epi::AFTER_DRAIN) { E(acc, cur, wr, wc, fr, fq); S.done(cur); }
        if (!has_next) break;
#pragma unroll
        for (int a = 0; a < 2; ++a)
#pragma unroll
            for (int b = 0; b < 2; ++b)
#pragma unroll
                for (int m = 0; m < 4; ++m)
#pragma unroll
                    for (int n = 0; n < 2; ++n) acc[a][b][m][n] = (f32x4){0.f, 0.f, 0.f, 0.f};
        cur = nxt; cA = nA; cB = nB; ++ui;
        if constexpr (ALIGN_EPI) { if (wr == 1) PG8_BAR; }
    }
    PG8_WAIT_V(0);
    if constexpr (!ALIGN_EPI) { if (wr == 0) PG8_BAR; }
    PG8_BAR;
    if constexpr (Epi::AFTER_DRAIN) { E.fused(acc, cur, wr, wc, fr, fq, lds, wid, lane); S.done(cur); }
#undef PG8_SA
#undef PG8_SB
#undef PG8_STAGE
#undef PG8_LDA
#undef PG8_LDB
#undef PG8_MMA
#undef PG8_WAIT_V
#undef PG8_WAIT_L
#undef PG8_BAR
#undef PG8_SCHED
}
}
namespace attn_body {
using bf16=__hip_bfloat16;
using bf16x8=__attribute__((ext_vector_type(8)))short;
using s16x4=__attribute__((ext_vector_type(4)))short;
using f32x16=__attribute__((ext_vector_type(16)))float;
using u32x4=__attribute__((ext_vector_type(4)))unsigned;
constexpr int BATCH=2,NHEAD=16,SEQ=8192,D=64,ZP=3072,OP=1024;
constexpr int NW=8,QBLK=32,QB=QBLK*NW,KVBLK=64,NQB=SEQ/QB;
constexpr int ATTN_UNIT_ROWS=QB;
__device__ __forceinline__ int crow(int r,int hi){return (r&3)+8*(r>>2)+4*hi;}
#define SBAR() __builtin_amdgcn_sched_barrier(0)
typedef const __attribute__((address_space(3))) float* lds_cfp;
__device__ __forceinline__ void cmask(f32x16&p0,f32x16&p1,int jb,int qrel,int hi,lds_cfp tab){
  const float NEG=-INFINITY; const int kb=64*jb+4*hi;
  #pragma unroll
  for(int r=0;r<16;++r){ const int rel=qrel-(kb+(r&3)+8*(r>>2)); const int rel1=rel-32;
    int i0=rel<127?rel:127; i0=i0<0?0:i0; int i1=rel1<127?rel1:127; i1=i1<0?0:i1;
    const float b0=tab[i0], b1=tab[i1];
    p0[r]=rel<0?NEG:p0[r]+b0; p1[r]=rel1<0?NEG:p1[r]+b1; }
}

constexpr int NSLOT=3, SLOTB=8192;
constexpr int LDS_K=0, LDS_V=NSLOT*SLOTB, LDS_WS=2*NSLOT*SLOTB, LDS_OST=LDS_WS+NW*64*4, LDS_BYTES=LDS_OST+NW*4096;
constexpr float C2=0.125f*1.4426950408889634f;
__device__ __forceinline__ void glds16(const void*gsrc,unsigned lds_dst){unsigned keep;
  asm volatile("s_mov_b32 %0, m0\n\ts_mov_b32 m0, %2\n\ts_nop 0\n\tglobal_load_lds_dwordx4 %1, off\n\ts_mov_b32 m0, %0":"=&s"(keep):"v"(gsrc),"s"(lds_dst):"memory");}
__device__ __forceinline__ float max3f(float a,float b,float c){float r;asm("v_max3_f32 %0, %1, %2, %3":"=v"(r):"v"(a),"v"(b),"v"(c));return r;}
__device__ __forceinline__ float max2f(float a,float b){float r;asm("v_max_f32_e32 %0, %1, %2":"=v"(r):"v"(a),"v"(b));return r;}
__device__ __forceinline__ float fadd_s(float a,float b){float r;asm("v_add_f32_e32 %0, %1, %2":"=v"(r):"v"(a),"v"(b));return r;}
__device__ __forceinline__ float fsub_s(float a,float b){float r;asm("v_sub_f32_e32 %0, %1, %2":"=v"(r):"v"(a),"v"(b));return r;}
typedef float f32x2_t __attribute__((ext_vector_type(2))); typedef __bf16 bf16x2_t __attribute__((ext_vector_type(2)));
__device__ __forceinline__ unsigned cvtpk_s(float lo,float hi){f32x2_t v={lo,hi};bf16x2_t b=__builtin_convertvector(v,bf16x2_t);return __builtin_bit_cast(unsigned,b);}
#define WAIT_BAR(N) asm volatile("s_waitcnt vmcnt(" #N ") lgkmcnt(0)\n\ts_barrier":::"memory")

__device__ __forceinline__ void qkt(f32x16&p0,f32x16&p1,const char*Kslot,const bf16x8*qr,const f32x16&negm,int r32,int hi){
  const char*kb=Kslot+hi*1024+r32*16;
  #pragma unroll
  for(int d0=0;d0<4;++d0){
    const bf16x8 b0=*reinterpret_cast<const bf16x8*>(kb+d0*2048);
    const bf16x8 b1=*reinterpret_cast<const bf16x8*>(kb+d0*2048+512);
    if(d0==0){p0=__builtin_amdgcn_mfma_f32_32x32x16_bf16(b0,qr[0],negm,0,0,0);p1=__builtin_amdgcn_mfma_f32_32x32x16_bf16(b1,qr[0],negm,0,0,0);}
    else{p0=__builtin_amdgcn_mfma_f32_32x32x16_bf16(b0,qr[d0],p0,0,0,0);p1=__builtin_amdgcn_mfma_f32_32x32x16_bf16(b1,qr[d0],p1,0,0,0);}}
}
typedef __attribute__((address_space(3))) const char* lds_cptr;
typedef short v4i16_t __attribute__((ext_vector_type(4)));
__device__ __forceinline__ void kload8(bf16x8*kf,lds_cptr kp){
  kf[0]=*(const __attribute__((address_space(3))) bf16x8*)(kp);      kf[1]=*(const __attribute__((address_space(3))) bf16x8*)(kp+512);
  kf[2]=*(const __attribute__((address_space(3))) bf16x8*)(kp+2048); kf[3]=*(const __attribute__((address_space(3))) bf16x8*)(kp+2560);
  kf[4]=*(const __attribute__((address_space(3))) bf16x8*)(kp+4096); kf[5]=*(const __attribute__((address_space(3))) bf16x8*)(kp+4608);
  kf[6]=*(const __attribute__((address_space(3))) bf16x8*)(kp+6144); kf[7]=*(const __attribute__((address_space(3))) bf16x8*)(kp+6656);
}
__device__ __forceinline__ void kload2(bf16x8*kf,lds_cptr kp,int j){ kf[2*j]=*(const __attribute__((address_space(3))) bf16x8*)(kp+j*2048); kf[2*j+1]=*(const __attribute__((address_space(3))) bf16x8*)(kp+j*2048+512); }
__device__ __forceinline__ s16x4 vtr(lds_cptr p){ return __builtin_bit_cast(s16x4,__builtin_amdgcn_ds_read_tr16_b64_v4i16((__attribute__((address_space(3))) v4i16_t*)p)); }
__device__ __forceinline__ float rowmax(const f32x16&p0,const f32x16&p1){
  float a=max3f(p0[0],p0[1],p1[0]),b=max3f(p0[2],p0[3],p1[1]);a=max3f(a,p1[2],p1[3]);
  #pragma unroll
  for(int r=4;r<16;r+=4){a=max3f(a,p0[r],p0[r+1]);b=max3f(b,p0[r+2],p0[r+3]);a=max3f(a,p1[r],p1[r+1]);b=max3f(b,p1[r+2],p1[r+3]);}
  const float m=max2f(a,b);
  auto rr=__builtin_amdgcn_permlane32_swap(__float_as_uint(m),__float_as_uint(m),false,false);
  return max2f(__uint_as_float(rr[0]),__uint_as_float(rr[1]));
}
__device__ __forceinline__ void pv(f32x16*o,int vb,bf16x8 pa0,bf16x8 pa1,bf16x8 pa2,bf16x8 pa3){
  #pragma unroll
  for(int d0=0;d0<2;++d0){s16x4 lo[4],hi[4];
    #pragma unroll
    for(int ks=0;ks<4;++ks){
      asm volatile("ds_read_b64_tr_b16 %0,%1 offset:%c2":"=&v"(lo[ks]):"v"(vb),"i"(d0*4096+ks*1024):"memory");
      asm volatile("ds_read_b64_tr_b16 %0,%1 offset:%c2":"=&v"(hi[ks]):"v"(vb),"i"(d0*4096+ks*1024+512):"memory");}
    asm volatile("s_waitcnt lgkmcnt(0)":::"memory");SBAR();
    #define PK(k) (bf16x8){lo[k][0],lo[k][1],lo[k][2],lo[k][3],hi[k][0],hi[k][1],hi[k][2],hi[k][3]}
    o[d0]=__builtin_amdgcn_mfma_f32_32x32x16_bf16(pa0,PK(0),o[d0],0,0,0);
    o[d0]=__builtin_amdgcn_mfma_f32_32x32x16_bf16(pa1,PK(1),o[d0],0,0,0);
    o[d0]=__builtin_amdgcn_mfma_f32_32x32x16_bf16(pa2,PK(2),o[d0],0,0,0);
    o[d0]=__builtin_amdgcn_mfma_f32_32x32x16_bf16(pa3,PK(3),o[d0],0,0,0);
    #undef PK
  }
}

#ifndef ATTN_STORE16
#define ATTN_STORE16(p,v) (*(u32x4*)(p)=(v))
#endif
template<int THRL> __device__ __forceinline__ void attn_unit(int b,int qcol,int kcol,int vcol,int ocol,int qb,const bf16*__restrict__ Zb,bf16*O,char*shm,lds_cfp tab){
  const int tid=threadIdx.x,lane=tid&63,r32=lane&31,hi=lane>>5; const int wid=__builtin_amdgcn_readfirstlane(tid>>6);
  const long rowbase=(long)b*SEQ; const int q0=qb*QB;
  const bf16*Qw=Zb+(rowbase+q0+wid*QBLK)*ZP+qcol;
  const bf16*Kh=Zb+rowbase*ZP+kcol,*Vh=Zb+rowbase*ZP+vcol;
  const unsigned lds0=(unsigned)(uintptr_t)shm;
  float*wsf=(float*)(shm+LDS_WS)+wid*64;
  const bf16*ksrc=Kh+(long)lane*ZP+wid*8;
  const bf16*vsrc=Vh+(long)(16*(wid&3)+(lane>>2))*ZP+(wid>>2)*32+(lane&3)*8;
  const unsigned kdst=lds0+LDS_K+wid*1024, vdst=lds0+LDS_V+wid*1024;
  #define DMA_K(t,slot) glds16(ksrc+(long)(t)*KVBLK*ZP,(unsigned)__builtin_amdgcn_readfirstlane(kdst+(slot)))
  #define DMA_V(t,slot) glds16(vsrc+(long)(t)*KVBLK*ZP,(unsigned)__builtin_amdgcn_readfirstlane(vdst+(slot)))
  const int vb0=(int)(lds0+LDS_V)+((lane>>4)&1)*32+(lane&3)*8+(4*hi+((lane&15)>>2))*64;
  const char*Kbase=shm+LDS_K; bf16x8 kf[8];
  const lds_cptr shm3=(lds_cptr)shm; const lds_cptr kp0=shm3+LDS_K+hi*1024+r32*16; const lds_cptr vp0=shm3+LDS_V+((lane>>4)&1)*32+(lane&3)*8+(4*hi+((lane&15)>>2))*64;
  const int NT=(q0+QB)/KVBLK;
  DMA_K(0,0);DMA_V(0,0);DMA_K(1,SLOTB);
  bf16x8 qr[4];
  #pragma unroll
  for(int d0=0;d0<4;++d0)qr[d0]=*reinterpret_cast<const bf16x8*>(&Qw[(long)r32*ZP+d0*16+hi*8]);
  float mhat=0.f,l_reg=0.f;f32x16 o[2];o[0]=f32x16{};o[1]=f32x16{};f32x16 negm=f32x16{};asm volatile("":"+v"(negm));
  const int qrel=wid*QBLK+r32;
  #define CMASK(P0,P1,t) do{int jb_=(t)-(NT-4); if(jb_>=-2)cmask(P0,P1,jb_,qrel,hi,tab);}while(0)
  bool resc=false;
  #define START(P0,P1) do{ const float rm=rowmax(P0,P1); resc=false; \
    { const float dl=rm; mhat=fadd_s(mhat,dl); \
      _Pragma("unroll") for(int r=0;r<16;++r){P0[r]=fsub_s(P0[r],dl);P1[r]=fsub_s(P1[r],dl);} \
      _Pragma("unroll") for(int r=0;r<16;++r)negm[r]=-mhat; asm volatile("":"+v"(negm)); } \
    _Pragma("unroll") for(int r=0;r<16;++r)P0[r]=__builtin_amdgcn_exp2f(P0[r]); }while(0)
  #define RESC() do{ if(resc){ asm volatile("s_waitcnt lgkmcnt(0)":::"memory"); \
      _Pragma("unroll") for(int d_=0;d_<2;++d_) _Pragma("unroll") for(int r=0;r<16;++r)o[d_][r]*=wsf[crow(r,hi)]; } }while(0)
  f32x16 pA0,pA1,pB0,pB1;
  int sl_prev=0,sl_cur=0,sl_next=SLOTB;
  #define ROT() do{sl_prev=sl_cur;sl_cur=sl_next;sl_next=(sl_next==(NSLOT-1)*SLOTB)?0:sl_next+SLOTB;}while(0)
  DMA_K(2,2*SLOTB);
  WAIT_BAR(3);
  qkt(pA0,pA1,Kbase,qr,negm,r32,hi);asm volatile("s_nop 15\n\ts_nop 7":"+v"(pA0),"+v"(pA1));CMASK(pA0,pA1,0);
  START(pA0,pA1);
  _Pragma("unroll") for(int r=0;r<16;++r)pA1[r]=__builtin_amdgcn_exp2f(pA1[r]);
  WAIT_BAR(0);
  DMA_K(3,0);DMA_V(1,SLOTB);
  ROT();
  kload8(kf,kp0+sl_cur);
  WAIT_BAR(2);
  s16x4 vlo[8],vhi[8]; u32x4 pw0,pw1,pw2,pw3;
  #define PKW(P,B) cvtpk_s(P[B],P[B+1])
  #define PAF(k) __builtin_bit_cast(bf16x8,pw##k)
  #define VFR(i) (bf16x8){vlo[i][0],vlo[i][1],vlo[i][2],vlo[i][3],vhi[i][0],vhi[i][1],vhi[i][2],vhi[i][3]}
  #define PIN(x) asm volatile("":"+v"(x))
  #define MX3(a,b,c) __builtin_fmaxf(__builtin_fmaxf((a),(b)),(c))
  #define GAPA(MF,A0,A1,A2,A3,W0,W1,PW) do{ MF; sacc+=A0; sacc+=A1; sacc+=A2; sacc+=A3; PIN(sacc); W0; W1; PIN(PW); SBAR(); }while(0)
  #define EX(v) __builtin_amdgcn_exp2f(v)
  #define GAPB(MF,X,B) do{ MF; X[B]=EX(X[B]); X[B+1]=EX(X[B+1]); X[B+2]=EX(X[B+2]); X[B+3]=EX(X[B+3]); PIN(X); SBAR(); }while(0)
  #define VRD(i) do{ vlo[i]=vtr(vp_+(((i)>>2)*4096+((i)&3)*1024)); vhi[i]=vtr(vp_+(((i)>>2)*4096+((i)&3)*1024+512)); }while(0)
  #define KRD(G,j) do{ if(G){ kload2(kf,kp0+sl_next,j); SBAR(); } }while(0)
  #define STEP(C0,C1,P0,P1,t,GK,GV,GL) do{ SBAR(); \
    const lds_cptr vp_=vp0+sl_prev; \
    VRD(0); SBAR(); float sacc=(P0[0]+P0[1]); \
    GAPA(C0=__builtin_amdgcn_mfma_f32_32x32x16_bf16(kf[0],qr[0],negm,0,0,0), P0[2],P0[3],P0[4],P0[5],     pw0[0]=PKW(P0,0), pw0[1]=PKW(P0,2), pw0); \
    VRD(4); SBAR(); GAPA(C1=__builtin_amdgcn_mfma_f32_32x32x16_bf16(kf[1],qr[0],negm,0,0,0), P0[6],P0[7],P0[8],P0[9],     pw0[2]=PKW(P0,4), pw0[3]=PKW(P0,6), pw0); \
    VRD(1); SBAR(); GAPA(C0=__builtin_amdgcn_mfma_f32_32x32x16_bf16(kf[2],qr[1],C0,0,0,0),   P0[10],P0[11],P0[12],P0[13], pw1[0]=PKW(P0,8), pw1[1]=PKW(P0,10), pw1); \
    VRD(5); SBAR(); GAPA(C1=__builtin_amdgcn_mfma_f32_32x32x16_bf16(kf[3],qr[1],C1,0,0,0),   P0[14],P0[15],P1[0],P1[1],   pw1[2]=PKW(P0,12),pw1[3]=PKW(P0,14), pw1); \
    VRD(2); SBAR(); GAPA(C0=__builtin_amdgcn_mfma_f32_32x32x16_bf16(kf[4],qr[2],C0,0,0,0),   P1[2],P1[3],P1[4],P1[5],     pw2[0]=PKW(P1,0), pw2[1]=PKW(P1,2), pw2); \
    VRD(6); SBAR(); GAPA(C1=__builtin_amdgcn_mfma_f32_32x32x16_bf16(kf[5],qr[2],C1,0,0,0),   P1[6],P1[7],P1[8],P1[9],     pw2[2]=PKW(P1,4), pw2[3]=PKW(P1,6), pw2); \
    VRD(3); SBAR(); GAPA(C0=__builtin_amdgcn_mfma_f32_32x32x16_bf16(kf[6],qr[3],C0,0,0,0),   P1[10],P1[11],P1[12],P1[13], pw3[0]=PKW(P1,8), pw3[1]=PKW(P1,10), pw3); \
    VRD(7); SBAR(); GAPA(C1=__builtin_amdgcn_mfma_f32_32x32x16_bf16(kf[7],qr[3],C1,0,0,0),   P1[14],P1[15],0.f,0.f,       pw3[2]=PKW(P1,12),pw3[3]=PKW(P1,14), pw3); \
    l_reg+=sacc; \
    if(GK){DMA_K((t)+3,sl_cur);} if(GV){DMA_V((t)+1,sl_next);} \
    CMASK(C0,C1,t); \
    { float a=MX3(C0[0],C0[1],C1[0]),b=MX3(C0[2],C0[3],C1[1]); a=MX3(a,C1[2],C1[3]); \
      _Pragma("unroll") for(int r=4;r<16;r+=4){a=MX3(a,C0[r],C0[r+1]);b=MX3(b,C0[r+2],C0[r+3]);a=MX3(a,C1[r],C1[r+1]);b=MX3(b,C1[r+2],C1[r+3]);} \
      float rm=__builtin_fmaxf(a,b); { auto rr=__builtin_amdgcn_permlane32_swap(__float_as_uint(rm),__float_as_uint(rm),false,false); rm=__builtin_fmaxf(__uint_as_float(rr[0]),__uint_as_float(rr[1])); } \
      resc=false; \
      if(__builtin_expect(__any(rm>(float)THRL),0)){ const float dl=__builtin_fmaxf(rm,0.f); mhat+=dl; \
        _Pragma("unroll") for(int r=0;r<16;++r){C0[r]-=dl;C1[r]-=dl;} \
        _Pragma("unroll") for(int r=0;r<16;++r)negm[r]=-mhat; asm volatile("":"+v"(negm)); \
        const float f=__builtin_amdgcn_exp2f(-dl); l_reg*=f; if(hi==0)wsf[r32]=f; resc=true; } } \
    SBAR(); \
    GAPB(o[0]=__builtin_amdgcn_mfma_f32_32x32x16_bf16(PAF(0),VFR(0),o[0],0,0,0), C0,0); \
    GAPB(o[1]=__builtin_amdgcn_mfma_f32_32x32x16_bf16(PAF(0),VFR(4),o[1],0,0,0), C0,4); \
    KRD(GL,0); GAPB(o[0]=__builtin_amdgcn_mfma_f32_32x32x16_bf16(PAF(1),VFR(1),o[0],0,0,0), C0,8); \
    KRD(GL,1); GAPB(o[1]=__builtin_amdgcn_mfma_f32_32x32x16_bf16(PAF(1),VFR(5),o[1],0,0,0), C0,12); \
    KRD(GL,2); GAPB(o[0]=__builtin_amdgcn_mfma_f32_32x32x16_bf16(PAF(2),VFR(2),o[0],0,0,0), C1,0); \
    KRD(GL,3); GAPB(o[1]=__builtin_amdgcn_mfma_f32_32x32x16_bf16(PAF(2),VFR(6),o[1],0,0,0), C1,4); \
    GAPB(o[0]=__builtin_amdgcn_mfma_f32_32x32x16_bf16(PAF(3),VFR(3),o[0],0,0,0), C1,8); \
    GAPB(o[1]=__builtin_amdgcn_mfma_f32_32x32x16_bf16(PAF(3),VFR(7),o[1],0,0,0), C1,12); \
    }while(0)
  int t=1;
  #undef CMASK
  #define CMASK(P0,P1,t) do{}while(0)
  for(;t+7<NT;t+=2){
    STEP(pB0,pB1,pA0,pA1,t,true,true,true);     WAIT_BAR(2); RESC(); ROT();
    STEP(pA0,pA1,pB0,pB1,t+1,true,true,true);   WAIT_BAR(2); RESC(); ROT();
  }
  #undef CMASK
  #define CMASK(P0,P1,t) do{int jb_=(t)-(NT-4); if(jb_>=-2)cmask(P0,P1,jb_,qrel,hi,tab);}while(0)
  #define ENDW(tt) do{ if((tt)+3<NT){WAIT_BAR(2);} else if((tt)+2<NT){WAIT_BAR(1);} else {WAIT_BAR(0);} }while(0)
  for(;t+1<NT;t+=2){
    STEP(pB0,pB1,pA0,pA1,t,(t+3<NT),(t+1<NT),(t+1<NT));       ENDW(t);   RESC(); ROT();
    STEP(pA0,pA1,pB0,pB1,t+1,(t+4<NT),(t+2<NT),(t+2<NT));     ENDW(t+1); RESC(); ROT();
  }
  STEP(pB0,pB1,pA0,pA1,NT-1,false,false,false); RESC();
  { float sacc=pB0[0]+pB0[1]; _Pragma("unroll") for(int r=2;r<16;++r)sacc+=pB0[r]; _Pragma("unroll") for(int r=0;r<16;++r)sacc+=pB1[r]; l_reg+=sacc;
    pw0=(u32x4){PKW(pB0,0),PKW(pB0,2),PKW(pB0,4),PKW(pB0,6)};pw1=(u32x4){PKW(pB0,8),PKW(pB0,10),PKW(pB0,12),PKW(pB0,14)};pw2=(u32x4){PKW(pB1,0),PKW(pB1,2),PKW(pB1,4),PKW(pB1,6)};pw3=(u32x4){PKW(pB1,8),PKW(pB1,10),PKW(pB1,12),PKW(pB1,14)};
    SBAR(); pv(o,vb0+sl_cur,PAF(0),PAF(1),PAF(2),PAF(3)); }
  #undef PKW
  #undef PAF
  #undef VFR
  #undef PIN
  #undef MX3
  #undef GAPA
  #undef GAPB
  #undef EX
  #undef VRD
  #undef KRD
  #undef STEP
  #undef ENDW
  {auto rr=__builtin_amdgcn_permlane32_swap(__float_as_uint(l_reg),__float_as_uint(l_reg),false,false);l_reg=__uint_as_float(rr[0])+__uint_as_float(rr[1]);}
  if(hi==0)wsf[32+r32]=l_reg;asm volatile("s_waitcnt lgkmcnt(0)":::"memory");
  float rli[16];
  #pragma unroll
  for(int r=0;r<16;++r)rli[r]=__builtin_amdgcn_rcpf(wsf[32+crow(r,hi)]);
  bf16*Ow=O+(rowbase+q0+wid*QBLK)*OP+ocol;
  { bf16*stg=(bf16*)(shm+LDS_OST)+wid*2048;
    #pragma unroll
    for(int r=0;r<16;++r){const int orow=crow(r,hi);
      #pragma unroll
      for(int d0=0;d0<2;++d0)stg[orow*64+d0*32+r32]=__float2bfloat16(o[d0][r]*rli[r]);}
    asm volatile("s_waitcnt lgkmcnt(0)":::"memory");
    #pragma unroll
    for(int i=0;i<4;++i){const int row=i*8+(lane>>3),ch=lane&7; const u32x4 v=*(const u32x4*)(stg+row*64+ch*8); ATTN_STORE16(Ow+(long)row*OP+ch*8,v);} }
  asm volatile("s_waitcnt lgkmcnt(0)\n\ts_barrier":::"memory");
  #undef DMA_K
  #undef DMA_V
  #undef CMASK
  #undef START
  #undef RESC
  #undef ROT
}
constexpr int ATTN_LDS_BYTES=LDS_BYTES;
struct AttnUnit { int bh; int qb; };
struct StaticOrder {
  int vcu;
  __device__ __forceinline__ explicit StaticOrder(int grid,int block):vcu((block%8)*(grid/8)+block/8){}
  __device__ __forceinline__ bool next(int i,AttnUnit&u)const{ if(i>=4)return false; const int s=vcu&7; u.bh=vcu>>3; u.qb=(i==0)?s:(i==1)?15-s:(i==2)?16+s:31-s; return true; }
  __device__ __forceinline__ void a_ready(const AttnUnit&)const{}
  __device__ __forceinline__ void done(const AttnUnit&)const{}
};
template<class Sched,int THRL=8> __device__ __forceinline__ void attn_phase(char*lds,const bf16*Zb,bf16*OA,lds_cfp tab,const Sched&S){
  AttnUnit u;
  for(int i=0;S.next(i,u);++i){ S.a_ready(u); const int b=u.bh>>4,vh=u.bh&15,map=vh>>3,h=(vh>>1)&3,vhalf=vh&1;
    attn_unit<THRL>(b,h*128+map*64,512+h*128+map*64,1024+h*128+vhalf*64,map*512+h*128+vhalf*64,u.qb,Zb,OA,lds,tab+h*128); S.done(u); }
}
#undef SBAR
#undef WAIT_BAR
}

constexpr int NWAVES = 8;
#ifndef MK_PER_PHASE
#define MK_PER_PHASE 0
#endif
constexpr int NPH = 12;

constexpr int MP = 16384, MS = 128, MV = MP + MS, MPAD = 16640;
constexpr int DM = 1024, DIN = 3072, FF = 4096, TSEQ = 8192, NMEM = 256, PASTLEN = 2048;
constexpr float EPS = 1e-6f, LOG2E = 1.4426950408889634f;
constexpr float C2A = 0.125f * LOG2E;
constexpr float C2M = 0.0625f * LOG2E;
constexpr float ONE_M_LAMINIT = 0.8f, LAMINIT = 0.2f;
constexpr int ZQA = 0, ZKA = 512, ZVA = 1024, ZQR = 1536, ZKR = 1792, ZVR = 2048, ZGR = 2560;
constexpr size_t OY_P = 0, OY_S = 16777216, OK_P = 16908288, OV_P = 25296896, OS_P = 33685504, OMK = 33751040, OMV = 34275328, OK_S = 34799616, OV_S = 34865152, OS_S = 34930688, OUT_TOTAL = 39124992;
enum { I_XP = 0, I_XS, I_MEMP, I_CK, I_CV, I_PT, I_SRET, I_CMK, I_CMV, I_RELB, I_NMIX, I_WIN, I_LQ1, I_LK1, I_LQ2, I_LK2, I_SUBLN, I_WOUT, I_NMEMQ, I_NMEMKV, I_WMQ, I_WMK, I_WMV, I_WMO, I_NMLP, I_WUP, I_WDN, I_NFIN, N_IN };

constexpr size_t MiB = 1u << 20;
constexpr size_t WS_CTL = 0, CTL_ZERO_BYTES = 1 * MiB;
constexpr size_t WS_WIN = 2 * MiB, WS_WOUT = 8 * MiB, WS_WMQ = 10 * MiB, WS_WMKV = 12 * MiB, WS_WMO = 16 * MiB, WS_WUP = 18 * MiB, WS_WDN = 26 * MiB;
constexpr size_t WS_MEMN = 34 * MiB, WS_MKB = 35 * MiB, WS_MVT = 36 * MiB, WS_SSQ1 = 37 * MiB, WS_SSQ2 = 39 * MiB, WS_SSQ3 = 41 * MiB;
constexpr size_t WS_XN = 48 * MiB, WS_Z = 82 * MiB, WS_OA = 180 * MiB, WS_MIX = 214 * MiB, WS_KRT = 248 * MiB, WS_VRT = 256 * MiB, WS_U = 272 * MiB, WS_SPT = 288 * MiB;
constexpr size_t WS_X1 = 296 * MiB, WS_X1B = 362 * MiB, WS_QM = 396 * MiB, WS_PM = 430 * MiB, WS_OM = 464 * MiB, WS_X2 = 498 * MiB, WS_X2B = 564 * MiB, WS_H = 598 * MiB, WS_X3 = 730 * MiB, WS_END = 796 * MiB;
static_assert(WS_XN + (size_t)MPAD * DM * 2 <= WS_Z && WS_Z + (size_t)MPAD * DIN * 2 <= WS_OA && WS_OA + (size_t)MPAD * DM * 2 <= WS_MIX && WS_MIX + (size_t)MPAD * DM * 2 <= WS_KRT, "ws map 1");
static_assert(WS_X1 + (size_t)MPAD * DM * 4 <= WS_X1B && WS_H + (size_t)MPAD * FF * 2 <= WS_X3 && WS_X3 + (size_t)MPAD * DM * 4 <= WS_END && WS_SSQ1 + (size_t)MPAD * 16 * 4 <= WS_SSQ2, "ws map 2");
constexpr int CW_TMO = 0, CW_CODE = 1, CW_BAR = 4096;

constexpr int RING_OFF = 0, RING_BYTES = 131072;
constexpr int LDSCTL_OFF = RING_BYTES, MISC_OFF = LDSCTL_OFF + 320;
constexpr int TAB_OFF = RING_BYTES + 1024;
constexpr int LDS_BYTES = 147456;
static_assert(MISC_OFF + 128 <= TAB_OFF && TAB_OFF + 2048 <= LDS_BYTES, "LDS map");

#define GAS __attribute__((address_space(1)))
#define LAS __attribute__((address_space(3)))
typedef unsigned short bf16;
typedef unsigned v4u __attribute__((ext_vector_type(4)));
typedef float f32x4 __attribute__((ext_vector_type(4)));
typedef short bf16x8 __attribute__((ext_vector_type(8)));
typedef GAS unsigned gu32;
typedef GAS unsigned long long gu64;
#define RLX_AGENT __ATOMIC_RELAXED, __HIP_MEMORY_SCOPE_AGENT
#define LDS_WAIT() asm volatile("s_waitcnt lgkmcnt(0)" ::: "memory")
#define VM_WAIT() asm volatile("s_waitcnt vmcnt(0)" ::: "memory")
__device__ __forceinline__ unsigned long long rt() { return __builtin_amdgcn_s_memrealtime(); }
__device__ __forceinline__ unsigned f2bf(float f) { unsigned u = __builtin_bit_cast(unsigned, f); return (u + 0x7fffu + ((u >> 16) & 1u)) >> 16; }
__device__ __forceinline__ unsigned pk2(float lo, float hi) { return f2bf(lo) | (f2bf(hi) << 16); }

#define XB_TMO      128
#define XB_XCNT(j)  (256  + 64 * (j))
#define XB_XSUB(j)  (1280 + 64 * (j))
#define XB_XGEN(j)  (2304 + 64 * (j))
#define XB_TOP      3328
#define XB_TOPGEN   3392
#define XCD_BAR_WORDS 3456
#define XB_SPIN_CAP (1u << 18)

__device__ __forceinline__ unsigned xb_ld(unsigned* p)              { return __hip_atomic_load(p, __ATOMIC_RELAXED, __HIP_MEMORY_SCOPE_AGENT); }
__device__ __forceinline__ unsigned xb_add(unsigned* p, unsigned v) { return __hip_atomic_fetch_add(p, v, __ATOMIC_RELAXED, __HIP_MEMORY_SCOPE_AGENT); }
__device__ __forceinline__ unsigned xb_xcc_id() { return (unsigned)__builtin_amdgcn_s_getreg((3 << 11) | 20) & 0xFu; }
#define XB_SPIN(cond, bar) do { unsigned _sp = 0; while (cond) { __builtin_amdgcn_s_sleep(1); \
    if ((++_sp & 255u) == 0u) { if (xb_ld(&(bar)[XB_TMO])) break; if (_sp > XB_SPIN_CAP) { atomicAdd(&(bar)[XB_TMO], 1u); break; } } } } while (0)

struct XcdBarrier {
    unsigned* bar; unsigned x;
    volatile LAS unsigned* st;
};

__device__ __forceinline__ XcdBarrier xcd_barrier_post(unsigned* bar, volatile LAS unsigned* st) {
    XcdBarrier b; b.bar = bar; b.x = xb_xcc_id(); b.st = st;
    if (threadIdx.x == 0) (void)xb_add(&bar[XB_XCNT(b.x)], 1u);
    return b;
}
__device__ __forceinline__ void xcd_barrier_complete(unsigned* bar, unsigned x, unsigned& nloc, unsigned& nx) {
    const unsigned G = gridDim.x * gridDim.y * gridDim.z;
    unsigned sum, cnt, mine, sp = 0u;
    for (;;) {
        sum = 0u; cnt = 0u; mine = 0u;
#pragma unroll
        for (unsigned j = 0; j < 16; ++j) { const unsigned c = xb_ld(&bar[XB_XCNT(j)]); sum += c; cnt += (c > 0u) ? 1u : 0u; mine = (j == x) ? c : mine; }
        if (sum == G) break;
        __builtin_amdgcn_s_sleep(1);
        if ((++sp & 255u) == 0u) { if (xb_ld(&bar[XB_TMO])) break; if (sp > XB_SPIN_CAP) { atomicAdd(&bar[XB_TMO], 1u); break; } }
    }
    nloc = mine > 0u ? mine : 1u; nx = cnt > 0u ? cnt : 1u;
}

__device__ __forceinline__ void xcd_barrier(const XcdBarrier& b) {
    asm volatile("s_waitcnt vmcnt(0)" ::: "memory");
    __syncthreads();
    if (threadIdx.x == 0) {
        unsigned* bar = b.bar;
        __builtin_amdgcn_s_waitcnt(0);
        unsigned nloc = b.st[0], nx = b.st[1];
        if (nloc == 0u) { xcd_barrier_complete(bar, b.x, nloc, nx); b.st[0] = nloc; b.st[1] = nx; }
        const unsigned old = xb_add(&bar[XB_XSUB(b.x)], 1u);
        const unsigned gen = old / nloc;
        if (old + 1u == (gen + 1u) * nloc) {
            __builtin_amdgcn_fence(__ATOMIC_RELEASE, "agent");
            asm volatile("s_waitcnt vmcnt(0)" ::: "memory");
            const unsigned og = xb_add(&bar[XB_TOP], 1u);
            const unsigned tg = og / nx;
            if (og + 1u == (tg + 1u) * nx) xb_add(&bar[XB_TOPGEN], 1u);
            else XB_SPIN(xb_ld(&bar[XB_TOPGEN]) == tg, bar);
            __builtin_amdgcn_fence(__ATOMIC_ACQUIRE, "agent");
            xb_add(&bar[XB_XGEN(b.x)], 1u);
            asm volatile("s_waitcnt vmcnt(0)" ::: "memory");
        } else {
            XB_SPIN(xb_ld(&bar[XB_XGEN(b.x)]) == gen, bar);
            __builtin_amdgcn_fence(__ATOMIC_ACQUIRE, "agent");
            asm volatile("s_waitcnt vmcnt(0)" ::: "memory");
        }
    }
    __syncthreads();
}

typedef unsigned u32x2 __attribute__((ext_vector_type(2)));
typedef float f32x16 __attribute__((ext_vector_type(16)));
typedef short s16x4 __attribute__((ext_vector_type(4)));
struct Frame {
    LAS unsigned char* lds;
    volatile LAS unsigned* MISC;
    gu32* ctl;
    int tid, lane, wave, vcu, G;
    const float* const* in;
    float* out; unsigned char* ws;
};
#define WSP(T, off) ((T*)(F.ws + (off)))

__device__ __forceinline__ float bf2f(unsigned short b) { return __uint_as_float((unsigned)b << 16); }
__device__ __forceinline__ float bflo(unsigned w) { return __uint_as_float(w << 16); }
__device__ __forceinline__ float bfhi(unsigned w) { return __uint_as_float(w & 0xffff0000u); }
__device__ __forceinline__ v4u pack8(const f32x4 a, const f32x4 b) { v4u w; w.x = pg8::cvt_pk_bf16(a.x, a.y); w.y = pg8::cvt_pk_bf16(a.z, a.w); w.z = pg8::cvt_pk_bf16(b.x, b.y); w.w = pg8::cvt_pk_bf16(b.z, b.w); return w; }
template <int CTRL> __device__ __forceinline__ float dpp_mov(float v) { return __builtin_bit_cast(float, __builtin_amdgcn_update_dpp(0, __builtin_bit_cast(int, v), CTRL, 0xF, 0xF, true)); }
__device__ __forceinline__ float row16_sum(float v) {
    v += dpp_mov<0xB1>(v);
    v += dpp_mov<0x4E>(v);
    v += dpp_mov<0x141>(v);
    v += dpp_mov<0x140>(v);
    return v;
}
__device__ __forceinline__ float wave_sum(float v) { v = row16_sum(v); v += __shfl_xor(v, 16); v += __shfl_xor(v, 32); return v; }
__device__ __forceinline__ float wave_max(float v) {
#pragma unroll
    for (int o = 1; o < 64; o <<= 1) v = fmaxf(v, __shfl_xor(v, o));
    return v;
}
__device__ __forceinline__ float log2gamma(int h) { return log2f(1.0f - exp2f(-(float)(5 + h))); }
__device__ __forceinline__ int t5_bucket(int n) {
    if (n < 16) return n;
    return 16 + (n >= 19) + (n >= 21) + (n >= 24) + (n >= 27) + (n >= 31) + (n >= 35) + (n >= 40) + (n >= 46) + (n >= 52) + (n >= 59) + (n >= 67) + (n >= 77) + (n >= 87) + (n >= 99) + (n >= 113);
}
__device__ __forceinline__ float lam_value(Frame& F) {
    const float a = F.in[I_LQ1][F.lane] * F.in[I_LK1][F.lane], b = F.in[I_LQ2][F.lane] * F.in[I_LK2][F.lane];
    return expf(wave_sum(a)) - expf(wave_sum(b)) + LAMINIT;
}

__device__ __forceinline__ int win_src_col(int n) {
    if (n < ZQR || n >= ZVR) return n;
    const int p = (n - ZQR) & 63;
    return (n - p) + (p >> 1) + 32 * (p & 1);
}
__device__ __forceinline__ void p0_transpose_item(const float* W, int K, int N, bf16* WT, int row_off, LAS float* scr, int item, int lane, const float* gk, bool perm) {
    const int nblk = N / 32, kb = item / nblk, nb = item % nblk, k0 = 64 * kb, n0 = 32 * nb;
    const int sc = perm ? win_src_col(n0 + (lane & 31)) : n0 + (lane & 31);
#pragma unroll 8
    for (int i = 0; i < 32; ++i) { const int kk = 2 * i + (lane >> 5); float v = W[(size_t)(k0 + kk) * N + sc]; if (gk) v *= gk[k0 + kk]; scr[kk * 33 + (lane & 31)] = v; }
    LDS_WAIT(); asm volatile("" ::: "memory");
    const int c = lane & 7;
#pragma unroll
    for (int j = 0; j < 4; ++j) { const int n = (lane >> 3) + 8 * j; const LAS float* s = scr + (8 * c) * 33 + n;
        v4u o; o.x = pk2(s[0 * 33], s[1 * 33]); o.y = pk2(s[2 * 33], s[3 * 33]); o.z = pk2(s[4 * 33], s[5 * 33]); o.w = pk2(s[6 * 33], s[7 * 33]);
        *(GAS v4u*)(WT + (size_t)(row_off + n0 + n) * K + k0 + 8 * c) = o; }
    LDS_WAIT(); asm volatile("" ::: "memory");
}
__device__ __forceinline__ void rms_row_to_bf16(int lane, const float* xrow, const float* g, bf16* orow) {
    const GAS f32x4* xr = (const GAS f32x4*)xrow + lane; const GAS f32x4* gr = (const GAS f32x4*)g + lane;
    f32x4 v[4]; float s = 0.f;
#pragma unroll
    for (int j = 0; j < 4; ++j) { v[j] = xr[64 * j]; s += (v[j].x * v[j].x + v[j].y * v[j].y) + (v[j].z * v[j].z + v[j].w * v[j].w); }
    const float rstd = 1.f / sqrtf(wave_sum(s) * (1.f / DM) + EPS);
    GAS unsigned long long* o8 = (GAS unsigned long long*)orow + lane;
#pragma unroll
    for (int j = 0; j < 4; ++j) { const f32x4 gv = gr[64 * j];
        o8[64 * j] = (unsigned long long)pk2(v[j].x * rstd * gv.x, v[j].y * rstd * gv.y) | ((unsigned long long)pk2(v[j].z * rstd * gv.z, v[j].w * rstd * gv.w) << 32); }
}
__device__ __forceinline__ void p0_prologue(Frame& F) {
    LAS float* scr = (LAS float*)(F.lds + RING_OFF + F.wave * 16384);
    const int gw = F.vcu * NWAVES + F.wave, NGW = F.G * NWAVES;
    constexpr int I_IN = 16 * 96, I_SQ = 16 * 32, I_UP = 16 * 128, I_DN = 64 * 32;
    constexpr int NITEMS = I_IN + 5 * I_SQ + I_UP + I_DN;
    for (int it = gw; it < NITEMS; it += NGW) {
        int r = it;
        if (r < I_IN) { p0_transpose_item(F.in[I_WIN], DM, DIN, WSP(bf16, WS_WIN), 0, scr, r, F.lane, nullptr, true); continue; } r -= I_IN;
        if (r < I_SQ) { p0_transpose_item(F.in[I_WOUT], DM, DM, WSP(bf16, WS_WOUT), 0, scr, r, F.lane, nullptr, false); continue; } r -= I_SQ;
        if (r < I_SQ) { p0_transpose_item(F.in[I_WMQ], DM, DM, WSP(bf16, WS_WMQ), 0, scr, r, F.lane, F.in[I_NMEMQ], false); continue; } r -= I_SQ;
        if (r < I_SQ) { p0_transpose_item(F.in[I_WMK], DM, DM, WSP(bf16, WS_WMKV), 0, scr, r, F.lane, nullptr, false); continue; } r -= I_SQ;
        if (r < I_SQ) { p0_transpose_item(F.in[I_WMV], DM, DM, WSP(bf16, WS_WMKV), DM, scr, r, F.lane, nullptr, false); continue; } r -= I_SQ;
        if (r < I_SQ) { p0_transpose_item(F.in[I_WMO], DM, DM, WSP(bf16, WS_WMO), 0, scr, r, F.lane, nullptr, false); continue; } r -= I_SQ;
        if (r < I_UP) { p0_transpose_item(F.in[I_WUP], DM, FF, WSP(bf16, WS_WUP), 0, scr, r, F.lane, F.in[I_NMLP], false); continue; } r -= I_UP;
        p0_transpose_item(F.in[I_WDN], FF, DM, WSP(bf16, WS_WDN), 0, scr, r, F.lane, nullptr, false);
    }
    bf16* XN = WSP(bf16, WS_XN); bf16* MEMN = WSP(bf16, WS_MEMN);
    for (int m = gw; m < MPAD + 2 * NMEM; m += NGW) {
        if (m < MP) rms_row_to_bf16(F.lane, F.in[I_XP] + (size_t)m * DM, F.in[I_NMIX], XN + (size_t)m * DM);
        else if (m < MV) rms_row_to_bf16(F.lane, F.in[I_XS] + (size_t)(m - MP) * DM, F.in[I_NMIX], XN + (size_t)m * DM);
        else if (m < MPAD) { GAS v4u* o = (GAS v4u*)(XN + (size_t)m * DM) + F.lane; o[0] = (v4u){0u, 0u, 0u, 0u}; o[64] = (v4u){0u, 0u, 0u, 0u}; }
        else rms_row_to_bf16(F.lane, F.in[I_MEMP] + (size_t)(m - MPAD) * DM, F.in[I_NMEMKV], MEMN + (size_t)(m - MPAD) * DM);
    }
}

__device__ __forceinline__ f32x4 silu4(f32x4 x) {
    f32x4 r;
    r.x = x.x * __builtin_amdgcn_rcpf(1.f + __builtin_amdgcn_exp2f(-x.x * LOG2E)); r.y = x.y * __builtin_amdgcn_rcpf(1.f + __builtin_amdgcn_exp2f(-x.y * LOG2E));
    r.z = x.z * __builtin_amdgcn_rcpf(1.f + __builtin_amdgcn_exp2f(-x.z * LOG2E)); r.w = x.w * __builtin_amdgcn_rcpf(1.f + __builtin_amdgcn_exp2f(-x.w * LOG2E));
    return r;
}
__device__ __forceinline__ void st_bf16(bf16* p, float v) { *(GAS unsigned short*)p = (unsigned short)f2bf(v); }

struct EpiZ {
    static constexpr bool PERM = true, AFTER_DRAIN = false;
    bf16* Z; float* out; bf16* KRT; bf16* VRT;
    __device__ __forceinline__ void operator()(const pg8::f32x4 (&acc)[2][2][4][2], const pg8::Unit& u, int wr, int wc, int fr, int fq) const {
        const int pn = u.pn, row0 = u.pm * 256 + wr * 64 + fr, colw = wc * 32 + 8 * fq;
        if (pn < 2 || pn >= 10) {
#pragma unroll
            for (int ai = 0; ai < 2; ++ai)
#pragma unroll
                for (int m = 0; m < 4; ++m) { const int row = row0 + ai * 128 + m * 16; bf16* zp = Z + (size_t)row * DIN + pn * 256 + colw;
#pragma unroll
                    for (int bj = 0; bj < 2; ++bj) { f32x4 v0 = acc[ai][bj][m][0], v1 = acc[ai][bj][m][1];
                        if (pn < 2) { v0 = v0 * C2A; v1 = v1 * C2A; } else { v0 = silu4(v0); v1 = silu4(v1); }
                        *(GAS v4u*)(zp + bj * 128) = pack8(v0, v1); } }
        } else if (pn < 6) {
            const bool isK = pn < 4; const int cb = (pn & 1) * 256;
#pragma unroll
            for (int ai = 0; ai < 2; ++ai)
#pragma unroll
                for (int m = 0; m < 4; ++m) { const int row = row0 + ai * 128 + m * 16; bf16* zp = Z + (size_t)row * DIN + pn * 256 + colw;
                    float* dst = nullptr;
                    if (row < MP) dst = out + (isK ? OK_P : OV_P) + (size_t)row * 512; else if (row < MV) dst = out + (isK ? OK_S : OV_S) + (size_t)(row - MP) * 512;
#pragma unroll
                    for (int bj = 0; bj < 2; ++bj) { const f32x4 v0 = acc[ai][bj][m][0], v1 = acc[ai][bj][m][1]; const int c = cb + bj * 128 + colw;
                        if (dst) { *(GAS f32x4*)(dst + c) = v0; *(GAS f32x4*)(dst + c + 4) = v1; }
                        *(GAS v4u*)(zp + bj * 128) = pack8(v0, v1); } }
        } else if (pn < 8) {
            const bool isKr = pn == 7; const int j0 = 16 * (wc & 1) + 4 * fq, p0 = colw & 63;
            float invf[4];
#pragma unroll
            for (int i = 0; i < 4; ++i) invf[i] = exp2f(-(float)(j0 + i) * (13.287712379549449f / 31.0f));
            const float l2g0 = log2gamma(wc >> 1), l2g1 = log2gamma(2 + (wc >> 1));
#pragma unroll
            for (int ai = 0; ai < 2; ++ai)
#pragma unroll
                for (int m = 0; m < 4; ++m) { const int row = row0 + ai * 128 + m * 16; const int pos = row < MP ? (row & (TSEQ - 1)) : PASTLEN;
                    float cs[4], sn[4];
#pragma unroll
                    for (int i = 0; i < 4; ++i) { const float ang = (float)pos * invf[i]; double rv = (double)ang * 0.15915494309189535; rv -= floor(rv); const float rf = (float)rv;
                        sn[i] = __builtin_amdgcn_sinf(rf); cs[i] = __builtin_amdgcn_cosf(rf); }
                    const int t = row & (TSEQ - 1), b = row >> 13;
#pragma unroll
                    for (int bj = 0; bj < 2; ++bj) { const f32x4 v0 = acc[ai][bj][m][0], v1 = acc[ai][bj][m][1]; const int head = 2 * bj + (wc >> 1);
                        float y[8];
                        y[0] = v0.x * cs[0] - v0.y * sn[0]; y[1] = v0.y * cs[0] + v0.x * sn[0]; y[2] = v0.z * cs[1] - v0.w * sn[1]; y[3] = v0.w * cs[1] + v0.z * sn[1];
                        y[4] = v1.x * cs[2] - v1.y * sn[2]; y[5] = v1.y * cs[2] + v1.x * sn[2]; y[6] = v1.z * cs[3] - v1.w * sn[3]; y[7] = v1.w * cs[3] + v1.z * sn[3];
                        if (isKr) {
#pragma unroll
                            for (int e = 0; e < 8; ++e) y[e] *= 0.125f; }
                        *(GAS v4u*)(Z + (size_t)row * DIN + pn * 256 + bj * 128 + colw) = pack8((f32x4){y[0], y[1], y[2], y[3]}, (f32x4){y[4], y[5], y[6], y[7]});
                        if (isKr && row < MP) { const float dec = exp2f((float)(127 - (t & 127)) * (bj ? l2g1 : l2g0));
                            bf16* kp = KRT + ((size_t)((b * 4 + head) * 64 + p0)) * TSEQ + t;
#pragma unroll
                            for (int e = 0; e < 8; ++e) st_bf16(kp + (size_t)e * TSEQ, y[e] * dec); } } }
        } else {
#pragma unroll
            for (int ai = 0; ai < 2; ++ai)
#pragma unroll
                for (int m = 0; m < 4; ++m) { const int row = row0 + ai * 128 + m * 16; const int t = row & (TSEQ - 1), b = row >> 13;
#pragma unroll
                    for (int bj = 0; bj < 2; ++bj) { const f32x4 v0 = acc[ai][bj][m][0], v1 = acc[ai][bj][m][1]; const int head = (pn - 8) * 2 + bj;
                        *(GAS v4u*)(Z + (size_t)row * DIN + pn * 256 + bj * 128 + colw) = pack8(v0, v1);
                        if (row < MP) { bf16* vp = VRT + ((size_t)((b * 4 + head) * 128 + colw)) * TSEQ + t;
                            st_bf16(vp, v0.x); st_bf16(vp + (size_t)TSEQ, v0.y); st_bf16(vp + (size_t)2 * TSEQ, v0.z); st_bf16(vp + (size_t)3 * TSEQ, v0.w);
                            st_bf16(vp + (size_t)4 * TSEQ, v1.x); st_bf16(vp + (size_t)5 * TSEQ, v1.y); st_bf16(vp + (size_t)6 * TSEQ, v1.z); st_bf16(vp + (size_t)7 * TSEQ, v1.w); } } }
        }
    }
};
struct EpiMemKV {
    static constexpr bool PERM = true, AFTER_DRAIN = false;
    float* out; bf16* MKB; bf16* MVT;
    __device__ __forceinline__ void operator()(const pg8::f32x4 (&acc)[2][2][4][2], const pg8::Unit& u, int wr, int wc, int fr, int fq) const {
        const int pn = u.pn, row0 = u.pm * 256 + wr * 64 + fr, colw = wc * 32 + 8 * fq; const bool isK = pn < 4;
#pragma unroll
        for (int ai = 0; ai < 2; ++ai)
#pragma unroll
            for (int m = 0; m < 4; ++m) { const int row = row0 + ai * 128 + m * 16;
#pragma unroll
                for (int bj = 0; bj < 2; ++bj) { const f32x4 v0 = acc[ai][bj][m][0], v1 = acc[ai][bj][m][1]; const int c = (pn & 3) * 256 + bj * 128 + colw;
                    float* dst = out + (isK ? OMK : OMV) + (size_t)row * DM + c;
                    *(GAS f32x4*)dst = v0; *(GAS f32x4*)(dst + 4) = v1;
                    if (isK) *(GAS v4u*)(MKB + (size_t)row * DM + c) = pack8(v0, v1);
                    else { bf16* vp = MVT + (size_t)c * 512 + row;
                        st_bf16(vp, v0.x); st_bf16(vp + 512, v0.y); st_bf16(vp + 1024, v0.z); st_bf16(vp + 1536, v0.w); st_bf16(vp + 2048, v1.x); st_bf16(vp + 2560, v1.y); st_bf16(vp + 3072, v1.z); st_bf16(vp + 3584, v1.w); } } }
    }
};
struct EpiRes {
    static constexpr bool PERM = false, AFTER_DRAIN = false;
    const float* baseP; const float* baseS; float* out; bf16* outb; float* ssq;
    __device__ __forceinline__ void operator()(const pg8::f32x4 (&acc)[2][2][4][2], const pg8::Unit& u, int wr, int wc, int fr, int fq) const {
#pragma unroll
        for (int ai = 0; ai < 2; ++ai) {
            if (u.pm * 256 + ai * 128 >= MV) continue;
#pragma unroll
            for (int m = 0; m < 4; ++m) { const int row = u.pm * 256 + ai * 128 + wr * 64 + m * 16 + fr;
                const float* bp = row < MP ? baseP + (size_t)row * DM : baseS + (size_t)(row - MP) * DM; float ss = 0.f;
#pragma unroll
                for (int bj = 0; bj < 2; ++bj)
#pragma unroll
                    for (int n = 0; n < 2; ++n) { const int c = u.pn * 256 + bj * 128 + wc * 32 + n * 16 + 4 * fq;
                        const f32x4 o = *(const GAS f32x4*)(bp + c) + acc[ai][bj][m][n];
                        *(GAS f32x4*)(out + (size_t)row * DM + c) = o;
                        if (outb) { u32x2 w; w.x = pg8::cvt_pk_bf16(o.x, o.y); w.y = pg8::cvt_pk_bf16(o.z, o.w); *(GAS u32x2*)(outb + (size_t)row * DM + c) = w; }
                        ss += (o.x * o.x + o.y * o.y) + (o.z * o.z + o.w * o.w); }
                ss += __shfl_xor(ss, 16); ss += __shfl_xor(ss, 32);
                if (fq == 0) ssq[(size_t)row * 16 + u.pn * 4 + wc] = ss; }
        }
    }
};
__device__ __forceinline__ float rstd_from_ssq(const float* ssq, int row) {
    const GAS f32x4* p = (const GAS f32x4*)(ssq + (size_t)row * 16); const f32x4 a = p[0], b = p[1], c = p[2], d = p[3];
    const float s = ((a.x + a.y) + (a.z + a.w)) + ((b.x + b.y) + (b.z + b.w)) + ((c.x + c.y) + (c.z + c.w)) + ((d.x + d.y) + (d.z + d.w));
    return 1.f / sqrtf(s * (1.f / DM) + EPS);
}
template <int ACT  > struct EpiScale {
    static constexpr bool PERM = true, AFTER_DRAIN = false;
    bf16* O; int ldc; const float* ssq; float scale;
    __device__ __forceinline__ void operator()(const pg8::f32x4 (&acc)[2][2][4][2], const pg8::Unit& u, int wr, int wc, int fr, int fq) const {
        const int row0 = u.pm * 256 + wr * 64 + fr, colw = u.pn * 256 + wc * 32 + 8 * fq;
#pragma unroll
        for (int ai = 0; ai < 2; ++ai)
#pragma unroll
            for (int m = 0; m < 4; ++m) { const int row = row0 + ai * 128 + m * 16; const float rs = rstd_from_ssq(ssq, row) * scale;
#pragma unroll
                for (int bj = 0; bj < 2; ++bj) { f32x4 v0 = acc[ai][bj][m][0] * rs, v1 = acc[ai][bj][m][1] * rs;
                    if (ACT == 1) { v0.x = fmaxf(v0.x, 0.f); v0.y = fmaxf(v0.y, 0.f); v0.z = fmaxf(v0.z, 0.f); v0.w = fmaxf(v0.w, 0.f); v1.x = fmaxf(v1.x, 0.f); v1.y = fmaxf(v1.y, 0.f); v1.z = fmaxf(v1.z, 0.f); v1.w = fmaxf(v1.w, 0.f);
                        v0 = v0 * v0; v1 = v1 * v1; }
                    *(GAS v4u*)(O + (size_t)row * ldc + bj * 128 + colw) = pack8(v0, v1); } }
    }
};
struct EpiPlain {
    static constexpr bool PERM = true, AFTER_DRAIN = false;
    bf16* O; int ldc;
    __device__ __forceinline__ void operator()(const pg8::f32x4 (&acc)[2][2][4][2], const pg8::Unit& u, int wr, int wc, int fr, int fq) const {
        const int row0 = u.pm * 256 + wr * 64 + fr, colw = u.pn * 256 + wc * 32 + 8 * fq;
#pragma unroll
        for (int ai = 0; ai < 2; ++ai)
#pragma unroll
            for (int m = 0; m < 4; ++m) { const int row = row0 + ai * 128 + m * 16;
#pragma unroll
                for (int bj = 0; bj < 2; ++bj) *(GAS v4u*)(O + (size_t)row * ldc + bj * 128 + colw) = pack8(acc[ai][bj][m][0], acc[ai][bj][m][1]); }
    }
};
struct EpiSoftmax {
    static constexpr bool PERM = true, AFTER_DRAIN = true;
    bf16* O; int ldc;
    __device__ __forceinline__ void fused(pg8::f32x4 (&acc)[2][2][4][2], const pg8::Unit& u, int wr, int wc, int fr, int fq, PG8_LAS unsigned char* lds, int wid, int lane) const {
        PG8_LAS float* PMX = (PG8_LAS float*)lds;
        PG8_LAS float* PSM = (PG8_LAS float*)(lds + 4096);
#pragma unroll
        for (int ai = 0; ai < 2; ++ai)
#pragma unroll
            for (int m = 0; m < 4; ++m) { float mx = -INFINITY;
#pragma unroll
                for (int bj = 0; bj < 2; ++bj)
#pragma unroll
                    for (int n = 0; n < 2; ++n) { const pg8::f32x4 x = acc[ai][bj][m][n]; mx = fmaxf(mx, fmaxf(fmaxf(x.x, x.y), fmaxf(x.z, x.w))); }
                mx = fmaxf(mx, __shfl_xor(mx, 16)); mx = fmaxf(mx, __shfl_xor(mx, 32));
                if (fq == 0) PMX[(ai * 128 + wr * 64 + m * 16 + fr) * 4 + wc] = mx; }
        asm volatile("s_waitcnt lgkmcnt(0)" ::: "memory"); __builtin_amdgcn_s_barrier(); asm volatile("" ::: "memory");
#pragma unroll
        for (int ai = 0; ai < 2; ++ai)
#pragma unroll
            for (int m = 0; m < 4; ++m) { const int r = ai * 128 + wr * 64 + m * 16 + fr; const pg8::f32x4 q = *(const PG8_LAS pg8::f32x4*)(PMX + r * 4);
                const float mx = fmaxf(fmaxf(q.x, q.y), fmaxf(q.z, q.w)); float s = 0.f;
#pragma unroll
                for (int bj = 0; bj < 2; ++bj)
#pragma unroll
                    for (int n = 0; n < 2; ++n) { pg8::f32x4 x = acc[ai][bj][m][n];
                        x.x = __builtin_amdgcn_exp2f(x.x - mx); x.y = __builtin_amdgcn_exp2f(x.y - mx); x.z = __builtin_amdgcn_exp2f(x.z - mx); x.w = __builtin_amdgcn_exp2f(x.w - mx);
                        acc[ai][bj][m][n] = x; s += (x.x + x.y) + (x.z + x.w); }
                s += __shfl_xor(s, 16); s += __shfl_xor(s, 32);
                if (fq == 0) PSM[r * 4 + wc] = s; }
        asm volatile("s_waitcnt lgkmcnt(0)" ::: "memory"); __builtin_amdgcn_s_barrier(); asm volatile("" ::: "memory");
        const int colw = wc * 32 + 8 * fq;
#pragma unroll
        for (int ai = 0; ai < 2; ++ai)
#pragma unroll
            for (int m = 0; m < 4; ++m) { const int r = ai * 128 + wr * 64 + m * 16 + fr; const pg8::f32x4 q = *(const PG8_LAS pg8::f32x4*)(PSM + r * 4);
                const float inv = 1.f / ((q.x + q.y) + (q.z + q.w));
#pragma unroll
                for (int bj = 0; bj < 2; ++bj) *(GAS v4u*)(O + (size_t)(u.pm * 256 + r) * ldc + bj * 128 + colw) = pack8(acc[ai][bj][m][0] * inv, acc[ai][bj][m][1] * inv); }
    }
};

__device__ __forceinline__ f32x16 mfma32(bf16x8 a, bf16x8 b, f32x16 c) { return __builtin_amdgcn_mfma_f32_32x32x16_bf16(a, b, c, 0, 0, 0); }
__device__ __forceinline__ int crow16(int r, int hh) { return (r & 3) + 8 * (r >> 2) + 4 * hh; }

__device__ __forceinline__ void ret_stepA(Frame& F, int bh, int c) {
    const int w = F.wave, r = F.lane & 31, hh = F.lane >> 5, db = w >> 2, eb = w & 3;
    const bf16* ka = WSP(bf16, WS_KRT) + ((size_t)(bh * 64 + 32 * db + r)) * TSEQ + c * 128 + 8 * hh;
    const bf16* va = WSP(bf16, WS_VRT) + ((size_t)(bh * 128 + 32 * eb + r)) * TSEQ + c * 128 + 8 * hh;
    bf16x8 af[8], bfr[8];
#pragma unroll
    for (int ks = 0; ks < 8; ++ks) { af[ks] = *(const GAS bf16x8*)(ka + 16 * ks); bfr[ks] = *(const GAS bf16x8*)(va + 16 * ks); }
    f32x16 acc = {};
#pragma unroll
    for (int ks = 0; ks < 8; ++ks) acc = mfma32(af[ks], bfr[ks], acc);
    float* up = WSP(float, WS_U) + ((size_t)(bh * 64 + c) * 64 + 32 * db) * 128 + 32 * eb + r;
#pragma unroll
    for (int q = 0; q < 16; ++q) up[(size_t)crow16(q, hh) * 128] = acc[q];
}

__device__ __forceinline__ void dec_attn_unit(Frame& F, int s, int hp) {
    LAS float* sc = (LAS float*)(F.lds);
    LAS float* wm = (LAS float*)(F.lds + 36864);
    LAS float* wo = (LAS float*)(F.lds + 40960);
    const LAS float* tab = (const LAS float*)(F.lds + TAB_OFF);
    const int w = F.wave, l = F.lane, hsel = l >> 5, f = l & 31, g = l >> 4, h = 2 * hp + hsel, row = MP + s;
    const bf16* Z = WSP(bf16, WS_Z);
    const u32x2 qq = *(const GAS u32x2*)(Z + (size_t)row * DIN + ZQA + h * 128 + 4 * f);
    const f32x4 q4 = {bflo(qq.x), bfhi(qq.x), bflo(qq.y), bfhi(qq.y)};
    const int* pt = (const int*)F.in[I_PT] + s * 16;
    const int pg0 = __builtin_amdgcn_readfirstlane(pt[2 * w]), pg1 = __builtin_amdgcn_readfirstlane(pt[2 * w + 1]);
    LAS float* scw = sc + w * 1040;
    const LAS float* tabh = tab + h * 128;
    const float* ck = F.in[I_CK]; const float* cv = F.in[I_CV];
    for (int kk0 = 0; kk0 < 256; kk0 += 8) {
        const int page = kk0 < 128 ? pg0 : pg1; f32x4 kv[8];
#pragma unroll
        for (int i = 0; i < 8; ++i) kv[i] = *(const GAS f32x4*)(ck + ((size_t)(page * 128 + ((kk0 + i) & 127)) * 4 + 2 * hp) * 128 + 4 * l);
#pragma unroll
        for (int i = 0; i < 8; ++i) { float p = (kv[i].x * q4.x + kv[i].y * q4.y) + (kv[i].z * q4.z + kv[i].w * q4.w); p = row16_sum(p);
            const int rel = PASTLEN - (w * 256 + kk0 + i); const float bsv = tabh[rel < 127 ? rel : 127];
            if ((l & 15) == 0) scw[(kk0 + i) * 4 + g] = p + bsv; }
    }
    const int nk = (w == 0) ? 257 : 256;
    if (w == 0) { const f32x4 kn = *(const GAS f32x4*)(F.out + OK_S + (size_t)s * 512 + h * 128 + 4 * f);
        float p = (kn.x * q4.x + kn.y * q4.y) + (kn.z * q4.z + kn.w * q4.w); p = row16_sum(p);
        if ((l & 15) == 0) scw[256 * 4 + g] = p + tabh[0]; }
    LDS_WAIT(); asm volatile("" ::: "memory");
    float mg0, mg1, mg2, mg3, lg0, lg1, lg2, lg3;
    { float m0 = -INFINITY, m1 = -INFINITY, m2 = -INFINITY, m3 = -INFINITY;
      for (int kk = l; kk < nk; kk += 64) { const f32x4 v = *(const LAS f32x4*)(scw + kk * 4); m0 = fmaxf(m0, v.x); m1 = fmaxf(m1, v.y); m2 = fmaxf(m2, v.z); m3 = fmaxf(m3, v.w); }
      mg0 = wave_max(m0); mg1 = wave_max(m1); mg2 = wave_max(m2); mg3 = wave_max(m3);
      float s0 = 0.f, s1 = 0.f, s2 = 0.f, s3 = 0.f;
      for (int kk = l; kk < nk; kk += 64) { f32x4 v = *(const LAS f32x4*)(scw + kk * 4);
          v.x = __builtin_amdgcn_exp2f(v.x - mg0); v.y = __builtin_amdgcn_exp2f(v.y - mg1); v.z = __builtin_amdgcn_exp2f(v.z - mg2); v.w = __builtin_amdgcn_exp2f(v.w - mg3);
          *(LAS f32x4*)(scw + kk * 4) = v; s0 += v.x; s1 += v.y; s2 += v.z; s3 += v.w; }
      lg0 = wave_sum(s0); lg1 = wave_sum(s1); lg2 = wave_sum(s2); lg3 = wave_sum(s3); }
    LDS_WAIT(); asm volatile("" ::: "memory");
    f32x4 o1 = {0.f, 0.f, 0.f, 0.f}, o2 = {0.f, 0.f, 0.f, 0.f};
    for (int kk0 = 0; kk0 < 256; kk0 += 8) {
        const int page = kk0 < 128 ? pg0 : pg1; f32x4 vv[8];
#pragma unroll
        for (int i = 0; i < 8; ++i) vv[i] = *(const GAS f32x4*)(cv + ((size_t)(page * 128 + ((kk0 + i) & 127)) * 4 + 2 * hp) * 128 + 4 * l);
#pragma unroll
        for (int i = 0; i < 8; ++i) { const float p1 = scw[(kk0 + i) * 4 + hsel * 2], p2 = scw[(kk0 + i) * 4 + hsel * 2 + 1]; o1 = o1 + vv[i] * p1; o2 = o2 + vv[i] * p2; }
    }
    if (w == 0) { const f32x4 vn = *(const GAS f32x4*)(F.out + OV_S + (size_t)s * 512 + h * 128 + 4 * f);
        const float p1 = scw[256 * 4 + hsel * 2], p2 = scw[256 * 4 + hsel * 2 + 1]; o1 = o1 + vn * p1; o2 = o2 + vn * p2; }
    if (l < 4) { const float mv = l == 0 ? mg0 : l == 1 ? mg1 : l == 2 ? mg2 : mg3, lv = l == 0 ? lg0 : l == 1 ? lg1 : l == 2 ? lg2 : lg3; wm[w * 4 + l] = mv; wm[32 + w * 4 + l] = lv; }
    *(LAS f32x4*)(wo + ((w * 2 + 0) * 64 + l) * 4) = o1; *(LAS f32x4*)(wo + ((w * 2 + 1) * 64 + l) * 4) = o2;
    LDS_WAIT(); __syncthreads();
    if (F.tid < 128) { const int map = F.tid >> 6, ll = F.tid & 63, gg = (ll >> 5) * 2 + map;
        float M = -INFINITY;
#pragma unroll
        for (int ww = 0; ww < 8; ++ww) M = fmaxf(M, wm[ww * 4 + gg]);
        float L = 0.f; f32x4 o = {0.f, 0.f, 0.f, 0.f};
#pragma unroll
        for (int ww = 0; ww < 8; ++ww) { const float e = __builtin_amdgcn_exp2f(wm[ww * 4 + gg] - M); L += wm[32 + ww * 4 + gg] * e; o = o + *(const LAS f32x4*)(wo + ((ww * 2 + map) * 64 + ll) * 4) * e; }
        const float inv = 1.f / L; u32x2 ov; ov.x = pk2(o.x * inv, o.y * inv); ov.y = pk2(o.z * inv, o.w * inv);
        *(GAS u32x2*)(WSP(bf16, WS_OA) + (size_t)row * DM + map * 512 + (2 * hp + (ll >> 5)) * 128 + 4 * (ll & 31)) = ov; }
    LDS_WAIT(); __syncthreads();
}

__device__ __forceinline__ void dec_ret_unit(Frame& F, int s, int h) {
    LAS float* part = (LAS float*)(F.lds);
    LAS float* half = (LAS float*)(F.lds + 2048);
    const int e = F.tid & 127, dg = F.tid >> 7, row = MP + s;
    const bf16* Zr = WSP(bf16, WS_Z) + (size_t)row * DIN;
    const float gam = 1.0f - exp2f(-(float)(5 + h));
    const float v = bf2f(Zr[ZVR + h * 128 + e]);
    const float* Sin = F.in[I_SRET] + ((size_t)(s * 4 + h) * 64) * 128 + e; float* Sout = F.out + OS_S + ((size_t)(s * 4 + h) * 64) * 128 + e;
    float op = 0.f;
#pragma unroll 4
    for (int i = 0; i < 16; ++i) { const int d = dg * 16 + i, p = 2 * (d & 31) + (d >> 5);
        const float kq = bf2f(Zr[ZKR + h * 64 + p]), qq = bf2f(Zr[ZQR + h * 64 + p]);
        const float sn = gam * Sin[(size_t)d * 128] + kq * v; Sout[(size_t)d * 128] = sn; op += qq * sn; }
    part[dg * 128 + e] = op;
    LDS_WAIT(); __syncthreads();
    float o = 0.f;
    if (F.tid < 128) { o = (part[e] + part[128 + e]) + (part[256 + e] + part[384 + e]); const float ss = wave_sum(o * o); if (F.lane == 0) half[F.wave] = ss; }
    LDS_WAIT(); __syncthreads();
    if (F.tid < 128) { const float rs = 1.f / sqrtf((half[0] + half[1]) * (1.f / 128.f) + EPS);
        st_bf16(WSP(bf16, WS_MIX) + (size_t)row * DM + 512 + h * 128 + e, o * rs * bf2f(Zr[ZGR + h * 128 + e])); }
    LDS_WAIT(); __syncthreads();
}

__device__ __forceinline__ void ret_scan(Frame& F, int wgi) {
    const int bh = wgi >> 4, p = (wgi & 15) * 4 + (F.tid >> 7), e = F.tid & 127, h = bh & 3;
    const float g = exp2f(128.f * log2gamma(h));
    const float* up = WSP(float, WS_U) + ((size_t)(bh * 64) * 64 + p) * 128 + e;
    bf16* sp = WSP(bf16, WS_SPT) + ((size_t)(bh * 64) * 128 + e) * 64 + p;
    float st = 0.f;
    for (int c0 = 0; c0 < 64; c0 += 8) { float uu[8];
#pragma unroll
        for (int i = 0; i < 8; ++i) uu[i] = up[(size_t)(c0 + i) * 8192];
#pragma unroll
        for (int i = 0; i < 8; ++i) { st_bf16(sp + (size_t)(c0 + i) * 8192, st); st = g * st + uu[i]; } }
    const int dn = (p >> 1) + 32 * (p & 1);
    F.out[OS_P + ((size_t)(bh * 64 + dn)) * 128 + e] = st;
}
__device__ __forceinline__ void merge_a_rows(Frame& F) {
    const int gw = F.vcu * NWAVES + F.wave, NGW = F.G * NWAVES, l = F.lane;
    const float lam = lam_value(F);
    const f32x4 g0 = *(const GAS f32x4*)(F.in[I_SUBLN] + (8 * l & 127)), g1 = *(const GAS f32x4*)(F.in[I_SUBLN] + (8 * l & 127) + 4);
    const bf16* OA = WSP(bf16, WS_OA); bf16* MIX = WSP(bf16, WS_MIX);
    for (int m = gw; m < MV; m += NGW) {
        const v4u a = *(const GAS v4u*)(OA + (size_t)m * DM + 8 * l), b = *(const GAS v4u*)(OA + (size_t)m * DM + 512 + 8 * l);
        float x[8];
        x[0] = bflo(a.x) - lam * bflo(b.x); x[1] = bfhi(a.x) - lam * bfhi(b.x); x[2] = bflo(a.y) - lam * bflo(b.y); x[3] = bfhi(a.y) - lam * bfhi(b.y);
        x[4] = bflo(a.z) - lam * bflo(b.z); x[5] = bfhi(a.z) - lam * bfhi(b.z); x[6] = bflo(a.w) - lam * bflo(b.w); x[7] = bfhi(a.w) - lam * bfhi(b.w);
        float ss = 0.f;
#pragma unroll
        for (int i = 0; i < 8; ++i) ss += x[i] * x[i];
        ss = row16_sum(ss);
        const float rs = ONE_M_LAMINIT / sqrtf(ss * (1.f / 128.f) + EPS);
        v4u o; o.x = pk2(x[0] * rs * g0.x, x[1] * rs * g0.y); o.y = pk2(x[2] * rs * g0.z, x[3] * rs * g0.w); o.z = pk2(x[4] * rs * g1.x, x[5] * rs * g1.y); o.w = pk2(x[6] * rs * g1.z, x[7] * rs * g1.w);
        *(GAS v4u*)(MIX + (size_t)m * DM + 8 * l) = o;
    }
}

__device__ __forceinline__ void ret_stepC(Frame& F, int bh, int c) {
    LAS float* psum = (LAS float*)(F.lds);
    const int w = F.wave, r = F.lane & 31, hh = F.lane >> 5, rb = w >> 1, ch = w & 1, b = bh >> 2, h = bh & 3;
    const size_t row0 = (size_t)b * TSEQ + c * 128;
    const bf16* Z = WSP(bf16, WS_Z);
    const float l2g = log2gamma(h);
    bf16x8 qf[4];
#pragma unroll
    for (int ks = 0; ks < 4; ++ks) qf[ks] = *(const GAS bf16x8*)(Z + (row0 + 32 * rb + r) * DIN + ZQR + h * 64 + 16 * ks + 8 * hh);
    f32x16 o[2], oc[2];
    o[0] = (f32x16){}; o[1] = (f32x16){}; oc[0] = (f32x16){}; oc[1] = (f32x16){};
    const bf16* spt = WSP(bf16, WS_SPT) + ((size_t)(bh * 64 + c) * 128 + 64 * ch + r) * 64 + 8 * hh;
#pragma unroll
    for (int eb = 0; eb < 2; ++eb)
#pragma unroll
        for (int ks = 0; ks < 4; ++ks) { const bf16x8 sb = *(const GAS bf16x8*)(spt + (size_t)(32 * eb) * 64 + 16 * ks); oc[eb] = mfma32(qf[ks], sb, oc[eb]); }
    const bf16* vt = WSP(bf16, WS_VRT) + ((size_t)(bh * 128 + 64 * ch + r)) * TSEQ + c * 128 + 4 * hh;
    for (int jb = 0; jb <= rb; ++jb) {
        f32x16 st = {};
#pragma unroll
        for (int ks = 0; ks < 4; ++ks) { const bf16x8 kf = *(const GAS bf16x8*)(Z + (row0 + 32 * jb + r) * DIN + ZKR + h * 64 + 16 * ks + 8 * hh); st = mfma32(kf, qf[ks], st); }
        const int irel = 32 * (rb - jb) + r;
#pragma unroll
        for (int q = 0; q < 16; ++q) { const int d = irel - crow16(q, hh); st[q] = d >= 0 ? st[q] * exp2f((float)d * l2g) : 0.f; }
#pragma unroll
        for (int s2 = 0; s2 < 2; ++s2) {
            v4u pw; pw.x = pg8::cvt_pk_bf16(st[8 * s2 + 0], st[8 * s2 + 1]); pw.y = pg8::cvt_pk_bf16(st[8 * s2 + 2], st[8 * s2 + 3]); pw.z = pg8::cvt_pk_bf16(st[8 * s2 + 4], st[8 * s2 + 5]); pw.w = pg8::cvt_pk_bf16(st[8 * s2 + 6], st[8 * s2 + 7]);
            const bf16x8 pa = __builtin_bit_cast(bf16x8, pw);
#pragma unroll
            for (int eb = 0; eb < 2; ++eb) { const bf16* vp = vt + (size_t)(32 * eb) * TSEQ + 32 * jb + 16 * s2;
                const u32x2 lo = *(const GAS u32x2*)vp, hi2 = *(const GAS u32x2*)(vp + 8);
                v4u vb; vb.x = lo.x; vb.y = lo.y; vb.z = hi2.x; vb.w = hi2.y;
                o[eb] = mfma32(pa, __builtin_bit_cast(bf16x8, vb), o[eb]); }
        }
    }
    float ssr[16];
#pragma unroll
    for (int q = 0; q < 16; ++q) { const float sc = exp2f((float)(32 * rb + crow16(q, hh) + 1) * l2g);
        o[0][q] += sc * oc[0][q]; o[1][q] += sc * oc[1][q];
        float ss = o[0][q] * o[0][q] + o[1][q] * o[1][q]; ss = row16_sum(ss); ss += __shfl_xor(ss, 16); ssr[q] = ss; }
    if (r == 0) {
#pragma unroll
        for (int q = 0; q < 16; ++q) psum[ch * 128 + 32 * rb + crow16(q, hh)] = ssr[q]; }
    LDS_WAIT(); __syncthreads();
    bf16* MIX = WSP(bf16, WS_MIX);
#pragma unroll
    for (int q = 0; q < 16; ++q) { const int i = 32 * rb + crow16(q, hh); const float rs = 1.f / sqrtf((psum[i] + psum[128 + i]) * (1.f / 128.f) + EPS);
#pragma unroll
        for (int eb = 0; eb < 2; ++eb) { const int e = 64 * ch + 32 * eb + r; const float gt = bf2f(Z[(row0 + i) * DIN + ZGR + h * 128 + e]);
            st_bf16(MIX + (row0 + i) * DM + 512 + h * 128 + e, o[eb][q] * rs * gt); } }
    LDS_WAIT(); __syncthreads();
}

__device__ __forceinline__ void dec_mem_unit(Frame& F, int s, int hp) {
    LAS float* sc = (LAS float*)(F.lds);
    LAS float* wo = (LAS float*)(F.lds + 4096);
    const int w = F.wave, l = F.lane, row = MP + s;
    const bf16* QM = WSP(bf16, WS_QM);
    f32x4 q4[2];
#pragma unroll
    for (int hs = 0; hs < 2; ++hs) { const u32x2 qq = *(const GAS u32x2*)(QM + (size_t)row * DM + (2 * hp + hs) * 256 + 4 * l); q4[hs] = (f32x4){bflo(qq.x), bfhi(qq.x), bflo(qq.y), bfhi(qq.y)}; }
    const float* ck = F.in[I_CMK] + ((size_t)s * NMEM * 4 + 2 * hp) * 256 + 4 * l; const float* cv = F.in[I_CMV] + ((size_t)s * NMEM * 4 + 2 * hp) * 256 + 4 * l;
    for (int m0 = 0; m0 < 32; m0 += 4) { f32x4 kv[8];
#pragma unroll
        for (int i = 0; i < 8; ++i) kv[i] = *(const GAS f32x4*)(ck + (size_t)(32 * w + m0 + (i >> 1)) * 1024 + (i & 1) * 256);
#pragma unroll
        for (int i = 0; i < 8; ++i) { const f32x4 q = q4[i & 1]; float p = (kv[i].x * q.x + kv[i].y * q.y) + (kv[i].z * q.z + kv[i].w * q.w); p = wave_sum(p);
            if (l == 0) sc[(i & 1) * 256 + 32 * w + m0 + (i >> 1)] = p; } }
    LDS_WAIT(); __syncthreads();
    float M[2], IL[2];
#pragma unroll
    for (int hs = 0; hs < 2; ++hs) { const f32x4 v = *(const LAS f32x4*)(sc + hs * 256 + 4 * l); const float mx = wave_max(fmaxf(fmaxf(v.x, v.y), fmaxf(v.z, v.w)));
        const float sm = (__builtin_amdgcn_exp2f(v.x - mx) + __builtin_amdgcn_exp2f(v.y - mx)) + (__builtin_amdgcn_exp2f(v.z - mx) + __builtin_amdgcn_exp2f(v.w - mx));
        M[hs] = mx; IL[hs] = 1.f / wave_sum(sm); }
    f32x4 o[2]; o[0] = (f32x4){0.f, 0.f, 0.f, 0.f}; o[1] = (f32x4){0.f, 0.f, 0.f, 0.f};
    for (int m0 = 0; m0 < 32; m0 += 4) { f32x4 vv[8];
#pragma unroll
        for (int i = 0; i < 8; ++i) vv[i] = *(const GAS f32x4*)(cv + (size_t)(32 * w + m0 + (i >> 1)) * 1024 + (i & 1) * 256);
#pragma unroll
        for (int i = 0; i < 8; ++i) { const int hs = i & 1; const float p = __builtin_amdgcn_exp2f(sc[hs * 256 + 32 * w + m0 + (i >> 1)] - M[hs]) * IL[hs]; o[hs] = o[hs] + vv[i] * p; } }
    *(LAS f32x4*)(wo + ((w * 2 + 0) * 64 + l) * 4) = o[0]; *(LAS f32x4*)(wo + ((w * 2 + 1) * 64 + l) * 4) = o[1];
    LDS_WAIT(); __syncthreads();
    if (F.tid < 128) { const int hs = F.tid >> 6, ll = F.tid & 63; f32x4 a = {0.f, 0.f, 0.f, 0.f};
#pragma unroll
        for (int ww = 0; ww < 8; ++ww) a = a + *(const LAS f32x4*)(wo + ((ww * 2 + hs) * 64 + ll) * 4);
        u32x2 ov; ov.x = pk2(a.x, a.y); ov.y = pk2(a.z, a.w);
        *(GAS u32x2*)(WSP(bf16, WS_OM) + (size_t)row * DM + (2 * hp + hs) * 256 + 4 * ll) = ov; }
    LDS_WAIT(); __syncthreads();
}

__device__ __forceinline__ void final_norm_rows(Frame& F) {
    const int gw = F.vcu * NWAVES + F.wave, NGW = F.G * NWAVES, l = F.lane;
    const float* X3 = WSP(float, WS_X3); const float* ssq = WSP(float, WS_SSQ3);
    for (int m = gw; m < MV; m += NGW) {
        const float s = row16_sum(ssq[(size_t)m * 16 + (l & 15)]); const float rs = 1.f / sqrtf(s * (1.f / DM) + EPS);
        float* dst = m < MP ? F.out + OY_P + (size_t)m * DM : F.out + OY_S + (size_t)(m - MP) * DM;
#pragma unroll
        for (int j = 0; j < 4; ++j) { const f32x4 x = *(const GAS f32x4*)(X3 + (size_t)m * DM + 256 * j + 4 * l), g = *(const GAS f32x4*)(F.in[I_NFIN] + 256 * j + 4 * l);
            *(GAS f32x4*)(dst + 256 * j + 4 * l) = x * rs * g; }
    }
}

#ifndef PG8_SP2
#define PG8_SP2 true
#endif
#ifndef PG8_ALIGN
#define PG8_ALIGN true
#endif
struct Args { const float* in[N_IN]; float* out; unsigned char* ws; int ph_lo, ph_hi; };
__global__ void __launch_bounds__(NWAVES * 64, 2) fwd(Args args) {
    extern __shared__ __attribute__((aligned(16))) unsigned char lds[];
    Frame F;
    F.lds = (LAS unsigned char*)lds;
    F.MISC = (volatile LAS unsigned*)(F.lds + MISC_OFF);
    F.tid = threadIdx.x; F.lane = F.tid & 63; F.wave = __builtin_amdgcn_readfirstlane(F.tid >> 6);
    F.G = gridDim.x; { const int bx = blockIdx.x; F.vcu = (F.G % 8 == 0) ? (bx % 8) * (F.G / 8) + bx / 8 : bx; }
    F.in = args.in; F.out = args.out; F.ws = args.ws;
    F.ctl = (gu32*)(args.ws + WS_CTL);
    for (int u = F.tid; u < (TAB_OFF - LDSCTL_OFF) / 4; u += NWAVES * 64) ((LAS unsigned*)(F.lds + LDSCTL_OFF))[u] = 0u;
    { const int h = F.tid >> 7, rel = F.tid & 127; const float* rb = args.in[I_RELB];
      ((LAS float*)(F.lds + TAB_OFF))[F.tid] = (rb[t5_bucket(rel) * 4 + h] - rb[31 * 4 + h]) * LOG2E; }
    __syncthreads();
#if MK_PER_PHASE
#define GRID_BAR() do { } while (0)
#else
    XcdBarrier bar = xcd_barrier_post((unsigned*)(F.ctl + CW_BAR), F.MISC + 8);
#define GRID_BAR() xcd_barrier(bar)
#endif
    const int lo = args.ph_lo, hi = args.ph_hi, bx = blockIdx.x;
#define IN(k) (lo <= (k) && (k) < hi)
#define BOTH(k) (IN(k) && IN((k) + 1))
    bf16* const Zb = WSP(bf16, WS_Z);

    if (IN(0)) { p0_prologue(F); if (BOTH(0)) GRID_BAR(); }

    if (IN(1)) {
        { pg8::Gemm g{WSP(bf16, WS_XN), WSP(bf16, WS_WIN), MPAD, DIN, DM, DM, DM}; pg8::StaticOrder S; S.init(MPAD, DIN, F.G, bx);
          EpiZ E{Zb, F.out, WSP(bf16, WS_KRT), WSP(bf16, WS_VRT)};
          pg8::gemm_phase<EpiZ, pg8::StaticOrder, PG8_ALIGN, PG8_SP2>(F.lds + RING_OFF, g, S, E); }
        { pg8::Gemm g{WSP(bf16, WS_MEMN), WSP(bf16, WS_WMKV), 2 * NMEM, 2 * DM, DM, DM, DM}; pg8::StaticOrder S; S.init(2 * NMEM, 2 * DM, F.G, (bx + 16) % F.G);
          EpiMemKV E{F.out, WSP(bf16, WS_MKB), WSP(bf16, WS_MVT)};
          pg8::gemm_phase<EpiMemKV, pg8::StaticOrder, PG8_ALIGN, PG8_SP2>(F.lds + RING_OFF, g, S, E); }
        if (BOTH(1)) GRID_BAR();
    }

    if (IN(2)) {
        { const attn_body::StaticOrder S((int)F.G, bx);
          attn_body::attn_phase<attn_body::StaticOrder>((char*)lds + RING_OFF, (const attn_body::bf16*)Zb, (attn_body::bf16*)WSP(bf16, WS_OA), (attn_body::lds_cfp)(F.lds + TAB_OFF), S); }
        __syncthreads();
        for (int u = bx; u < 512; u += F.G) ret_stepA(F, u >> 6, u & 63);
        for (int u = bx; u < 256; u += F.G) dec_attn_unit(F, u >> 1, u & 1);
        for (int u = bx; u < 512; u += F.G) dec_ret_unit(F, u >> 2, u & 3);
        if (BOTH(2)) GRID_BAR();
    }

    if (IN(3)) { if (bx < 128) ret_scan(F, bx); merge_a_rows(F); if (BOTH(3)) GRID_BAR(); }

    if (IN(4)) { for (int u = bx; u < 512; u += F.G) ret_stepC(F, u >> 6, u & 63); if (BOTH(4)) GRID_BAR(); }

    if (IN(5)) {
        pg8::Gemm g{WSP(bf16, WS_MIX), WSP(bf16, WS_WOUT), MPAD, DM, DM, DM, DM}; pg8::StaticOrder S; S.init(MPAD, DM, F.G, bx);
        EpiRes E{args.in[I_XP], args.in[I_XS], WSP(float, WS_X1), WSP(bf16, WS_X1B), WSP(float, WS_SSQ1)};
        pg8::gemm_phase<EpiRes, pg8::StaticOrder, PG8_ALIGN, PG8_SP2>(F.lds + RING_OFF, g, S, E);
        if (BOTH(5)) GRID_BAR();
    }

    if (IN(6)) {
        pg8::Gemm g{WSP(bf16, WS_X1B), WSP(bf16, WS_WMQ), MPAD, DM, DM, DM, DM}; pg8::StaticOrder S; S.init(MPAD, DM, F.G, bx);
        EpiScale<0> E{WSP(bf16, WS_QM), DM, WSP(float, WS_SSQ1), C2M};
        pg8::gemm_phase<EpiScale<0>, pg8::StaticOrder, PG8_ALIGN, PG8_SP2>(F.lds + RING_OFF, g, S, E);
        if (BOTH(6)) GRID_BAR();
    }

    if (IN(7)) {
        if (bx < 256) {
            const int panel = bx >> 2, h = bx & 3, b = panel >> 5;
            { pg8::Gemm g{WSP(bf16, WS_QM) + h * 256, WSP(bf16, WS_MKB) + (size_t)b * NMEM * DM + h * 256, MP, 256, 256, DM, DM}; pg8::OneUnit S{{panel, 0}, true};
              EpiSoftmax E{WSP(bf16, WS_PM) + h * 256, DM};
              pg8::gemm_phase<EpiSoftmax, pg8::OneUnit, false, PG8_SP2>(F.lds + RING_OFF, g, S, E); }
            VM_WAIT(); __syncthreads();
            { pg8::Gemm g{WSP(bf16, WS_PM) + h * 256, WSP(bf16, WS_MVT) + (size_t)h * 256 * 512 + b * NMEM, MP, 256, 256, DM, 512}; pg8::OneUnit S{{panel, 0}, true};
              EpiPlain E{WSP(bf16, WS_OM) + h * 256, DM};
              pg8::gemm_phase<EpiPlain, pg8::OneUnit, false, PG8_SP2>(F.lds + RING_OFF, g, S, E); }
            __syncthreads();
            dec_mem_unit(F, bx >> 1, bx & 1);
        }
        if (BOTH(7)) GRID_BAR();
    }

    if (IN(8)) {
        pg8::Gemm g{WSP(bf16, WS_OM), WSP(bf16, WS_WMO), MPAD, DM, DM, DM, DM}; pg8::StaticOrder S; S.init(MPAD, DM, F.G, bx);
        EpiRes E{WSP(float, WS_X1), WSP(float, WS_X1) + (size_t)MP * DM, WSP(float, WS_X2), WSP(bf16, WS_X2B), WSP(float, WS_SSQ2)};
        pg8::gemm_phase<EpiRes, pg8::StaticOrder, PG8_ALIGN, PG8_SP2>(F.lds + RING_OFF, g, S, E);
        if (BOTH(8)) GRID_BAR();
    }

    if (IN(9)) {
        pg8::Gemm g{WSP(bf16, WS_X2B), WSP(bf16, WS_WUP), MPAD, FF, DM, DM, DM}; pg8::StaticOrder S; S.init(MPAD, FF, F.G, bx);
        EpiScale<1> E{WSP(bf16, WS_H), FF, WSP(float, WS_SSQ2), 1.0f};
        pg8::gemm_phase<EpiScale<1>, pg8::StaticOrder, PG8_ALIGN, PG8_SP2>(F.lds + RING_OFF, g, S, E);
        if (BOTH(9)) GRID_BAR();
    }

    if (IN(10)) {
        pg8::Gemm g{WSP(bf16, WS_H), WSP(bf16, WS_WDN), MPAD, DM, FF, FF, FF}; pg8::StaticOrder S; S.init(MPAD, DM, F.G, bx);
        EpiRes E{WSP(float, WS_X2), WSP(float, WS_X2) + (size_t)MP * DM, WSP(float, WS_X3), nullptr, WSP(float, WS_SSQ3)};
        pg8::gemm_phase<EpiRes, pg8::StaticOrder, PG8_ALIGN, PG8_SP2>(F.lds + RING_OFF, g, S, E);
        if (BOTH(10)) GRID_BAR();
    }

    if (IN(11)) final_norm_rows(F);
#undef IN
#undef BOTH
}

extern "C" void kernel_launch(void* const* d_in, const int* in_sizes, int n_in, void* d_out, int out_size, void* d_ws, size_t ws_size, hipStream_t stream) {
    static int grid = 0;
    if (grid == 0) {
        if (n_in != N_IN || in_sizes[0] != MP * DM || (size_t)out_size != OUT_TOTAL || ws_size < WS_END) { fprintf(stderr, "kernel_launch: unexpected shapes (n_in %d, in0 %d, out %d, ws %zu); nothing launched\n", n_in, n_in > 0 ? in_sizes[0] : -1, out_size, ws_size); grid = -1; return; }
        int dev = 0, cus = 0, per_cu = 0;
        if (hipGetDevice(&dev) != hipSuccess || hipDeviceGetAttribute(&cus, hipDeviceAttributeMultiprocessorCount, dev) != hipSuccess) { fprintf(stderr, "kernel_launch: device query failed\n"); grid = -1; return; }
        if (hipFuncSetAttribute((const void*)fwd, hipFuncAttributeMaxDynamicSharedMemorySize, LDS_BYTES) != hipSuccess) { fprintf(stderr, "kernel_launch: hipFuncSetAttribute failed\n"); grid = -1; return; }
        if (hipOccupancyMaxActiveBlocksPerMultiprocessor(&per_cu, (const void*)fwd, NWAVES * 64, LDS_BYTES) != hipSuccess || per_cu < 1)
            fprintf(stderr, "kernel_launch: note: occupancy query reports %d workgroups per CU\n", per_cu);
        (void)hipGetLastError();
        grid = cus;
        if (grid != 256) fprintf(stderr, "kernel_launch: this kernel's static work split expects 256 CUs, found %d\n", grid);
    }
    if (grid < 0) return;
    if (hipMemsetAsync((char*)d_ws + WS_CTL, 0, CTL_ZERO_BYTES, stream) != hipSuccess) { fprintf(stderr, "kernel_launch: memset failed\n"); return; }
    Args a{};
    for (int i = 0; i < N_IN; ++i) a.in[i] = (const float*)d_in[i];
    a.out = (float*)d_out; a.ws = (unsigned char*)d_ws;
#if MK_PER_PHASE
    for (int p = 0; p < NPH; ++p) { a.ph_lo = p; a.ph_hi = p + 1; hipLaunchKernelGGL(fwd, dim3(grid), dim3(NWAVES * 64), LDS_BYTES, stream, a); }
#else
    a.ph_lo = 0; a.ph_hi = NPH; hipLaunchKernelGGL(fwd, dim3(grid), dim3(NWAVES * 64), LDS_BYTES, stream, a);
#endif
    const hipError_t le = hipPeekAtLastError();
    if (le != hipSuccess) fprintf(stderr, "kernel_launch: launch failed: %s\n", hipGetErrorName(le));
}
```

```cpp
#include <hip/hip_runtime.h>
#include <hip/hip_bf16.h>
#include <cstdio>
#include <cstdint>
#include <cmath>
#ifndef MK_PER_PHASE
#define MK_PER_PHASE 0
#endif
namespace pg8 {
#define PG8_LAS __attribute__((address_space(3)))
typedef unsigned short bf16_t;
typedef short bf16x8 __attribute__((ext_vector_type(8)));
typedef float f32x4 __attribute__((ext_vector_type(4)));
typedef unsigned u32x4 __attribute__((ext_vector_type(4)));
constexpr int BM = 256, BK = 64, HALF = 128, HTB = HALF * BK * 2  , STAGE_BYTES = 8 * HTB, NXCD = 8, WGM = 8;

__host__ __device__ __forceinline__ int lds_byte(int r, int c) { const int st = (r >> 4) * 2 + (c >> 5), rr = r & 15, cc = c & 31, ob = rr * 64 + cc * 2; return st * 1024 + (ob ^ (((ob >> 9) & 1) << 5)); }
__host__ __device__ __forceinline__ void stage_rc(int b, int& R, int& C) { const int st = b / 1024, sb = b % 1024, swz = sb ^ (((sb >> 9) & 1) << 5); R = (st >> 1) * 16 + swz / 64; C = (st & 1) * 32 + (swz % 64) / 2; }
__host__ __device__ __forceinline__ int perm32(int rho) { const int n = rho >> 4, i = rho & 15; return 8 * (i >> 2) + 4 * n + (i & 3); }

struct Unit { int pm, pn; };
struct Gemm { const bf16_t* A; const bf16_t* Bt; int M, N, K, lda, ldb; };

struct StaticOrder {
    int nM, nN, nwg, G, c;
    __host__ __device__ void init(int M, int N, int G_, int c_) { nM = M / BM; nN = N / BM; nwg = nM * nN; G = G_; c = c_; }
    __host__ __device__ bool next(int i, Unit& u) const {
        const long L = (long)i * G + c; if (L >= nwg) return false;
        int wgid = (int)L; { const int q = nwg / NXCD, r = nwg % NXCD, xcd = wgid % NXCD, off = wgid / NXCD; wgid = (xcd < r ? xcd * (q + 1) : r * (q + 1) + (xcd - r) * q) + off; }
        const int nig = WGM * nN, gid = wgid / nig, fm = gid * WGM, gsz = (nM - fm) < WGM ? (nM - fm) : WGM;
        u.pm = fm + ((wgid % nig) % gsz); u.pn = (wgid % nig) / gsz; return true;
    }
    __device__ __forceinline__ void a_ready(const Unit&) const {}
    __device__ __forceinline__ void done(const Unit&) const {}
};
struct OneUnit {
    Unit u0; bool has;
    __device__ __forceinline__ bool next(int i, Unit& u) const { if (i != 0 || !has) return false; u = u0; return true; }
    __device__ __forceinline__ void a_ready(const Unit&) const {}
    __device__ __forceinline__ void done(const Unit&) const {}
};
__device__ __forceinline__ unsigned cvt_pk_bf16(float lo, float hi) { unsigned r; asm volatile("v_cvt_pk_bf16_f32 %0, %1, %2" : "=v"(r) : "v"(lo), "v"(hi)); return r; }
template <class Epi, class Sched, bool ALIGN_EPI = false, bool SP2 = false>
__device__ __forceinline__ void gemm_phase(PG8_LAS unsigned char* lds, const Gemm g, const Sched& S, const Epi& E) {
    int tid_ = threadIdx.x; asm volatile("" : "+v"(tid_));
    const int tid = tid_, wid = __builtin_amdgcn_readfirstlane(tid >> 6), lane = tid & 63, wr = wid >> 2, wc = wid & 3, fr = lane & 15, fq = lane >> 4;
    const int K = g.K, nt = K / BK;
    unsigned voffA[2], voffB[2];
#pragma unroll
    for (int i = 0; i < 2; ++i) { int R, C; stage_rc(tid * 16 + i * 8192, R, C); const int Rb = Epi::PERM ? ((R & ~31) + perm32(R & 31)) : R;
        voffA[i] = (unsigned)(R * g.lda + C) * 2u; voffB[i] = (unsigned)(Rb * g.ldb + C) * 2u; }
    const size_t kstep = (size_t)(BK * 2);
    const size_t hstepA = (size_t)HALF * g.lda * 2, hstepB = (size_t)HALF * g.ldb * 2;
    const size_t tstepA = 2 * hstepA, tstepB = 2 * hstepB;
    const unsigned ldsw = (unsigned)wid * 1024u;
    const int aoff = lds_byte(wr * 64 + fr, fq * 8), boff = lds_byte(wc * 32 + fr, fq * 8);
#define PG8_SA(b, h) (((b) * 2 + (h)) * HTB)
#define PG8_SB(b, h) ((4 + (b) * 2 + (h)) * HTB)
#define PG8_STAGE(bufoff, gbase, voff) do { _Pragma("unroll") for (int _i = 0; _i < 2; ++_i) \
        __builtin_amdgcn_global_load_lds((const unsigned*)((const char*)(gbase) + (voff)[_i]), (PG8_LAS unsigned*)(lds + (bufoff) + ldsw + _i * 8192), 16, 0, 0); } while (0)
#define PG8_LDA(dst, b, h) do { _Pragma("unroll") for (int m = 0; m < 4; ++m) _Pragma("unroll") for (int k = 0; k < 2; ++k) dst[m][k] = *(const PG8_LAS bf16x8*)(lds + PG8_SA(b, h) + aoff + m * 2048 + k * 1024); } while (0)
#define PG8_LDB(dst, b, h) do { _Pragma("unroll") for (int n = 0; n < 2; ++n) _Pragma("unroll") for (int k = 0; k < 2; ++k) dst[n][k] = *(const PG8_LAS bf16x8*)(lds + PG8_SB(b, h) + boff + n * 2048 + k * 1024); } while (0)
#define PG8_MMA(ai, bj, At, Bt) do { __builtin_amdgcn_s_setprio(1); _Pragma("unroll") for (int m = 0; m < 4; ++m) _Pragma("unroll") for (int n = 0; n < 2; ++n) _Pragma("unroll") for (int k = 0; k < 2; ++k) \
        acc[ai][bj][m][n] = __builtin_amdgcn_mfma_f32_16x16x32_bf16(Bt[n][k], At[m][k], acc[ai][bj][m][n], 0, 0, 0); __builtin_amdgcn_s_setprio(0); } while (0)
#define PG8_WAIT_V(n) asm volatile("s_waitcnt vmcnt(" #n ")" ::: "memory")
#define PG8_WAIT_L(n) asm volatile("s_waitcnt lgkmcnt(" #n ")" ::: "memory")
#define PG8_BAR __builtin_amdgcn_s_barrier()
#define PG8_SCHED __builtin_amdgcn_sched_barrier(0)
    Unit cur, nxt; int ui = 0;
    if (!S.next(0, cur)) return;
    f32x4 acc[2][2][4][2];
#pragma unroll
    for (int a = 0; a < 2; ++a)
#pragma unroll
        for (int b = 0; b < 2; ++b)
#pragma unroll
            for (int m = 0; m < 4; ++m)
#pragma unroll
                for (int n = 0; n < 2; ++n) acc[a][b][m][n] = (f32x4){0.f, 0.f, 0.f, 0.f};
    bf16x8 At[4][2], B0[2][2], B1[2][2];
    const char* cA = (const char*)g.A + (size_t)cur.pm * tstepA; const char* cB = (const char*)g.Bt + (size_t)cur.pn * tstepB;
    S.a_ready(cur);
    if constexpr (SP2) {
        PG8_STAGE(PG8_SB(0, 0), cB, voffB); PG8_STAGE(PG8_SB(0, 1), cB + hstepB, voffB); PG8_STAGE(PG8_SA(0, 0), cA, voffA); PG8_STAGE(PG8_SA(0, 1), cA + hstepA, voffA);
        if (wr == 1) PG8_BAR;
        PG8_WAIT_V(2); PG8_BAR;
        PG8_STAGE(PG8_SB(1, 0), cB + kstep, voffB); PG8_STAGE(PG8_SA(1, 0), cA + kstep, voffA); PG8_STAGE(PG8_SB(1, 1), cB + hstepB + kstep, voffB);
        PG8_WAIT_V(6); PG8_BAR;
    } else {
        PG8_STAGE(PG8_SB(0, 0), cB, voffB); PG8_STAGE(PG8_SA(0, 0), cA, voffA); PG8_STAGE(PG8_SB(0, 1), cB + hstepB, voffB); PG8_STAGE(PG8_SA(0, 1), cA + hstepA, voffA);
        if (wr == 1) PG8_BAR;
        PG8_WAIT_V(4); PG8_BAR;
        PG8_STAGE(PG8_SB(1, 0), cB + kstep, voffB); PG8_STAGE(PG8_SA(1, 0), cA + kstep, voffA); PG8_STAGE(PG8_SB(1, 1), cB + hstepB + kstep, voffB);
        PG8_WAIT_V(6); PG8_BAR;
    }
    for (;;) {
        const bool has_next = S.next(ui + 1, nxt);
        const char* nA = has_next ? (const char*)g.A + (size_t)nxt.pm * tstepA : cA; const char* nB = has_next ? (const char*)g.Bt + (size_t)nxt.pn * tstepB : cB;
        for (int t = 0; t < nt; t += 2) {
            const bool last = (t == nt - 2);
            const char* a1 = cA + (size_t)(t + 1) * kstep;
            const char* a2 = last ? nA : cA + (size_t)(t + 2) * kstep; const char* b2 = last ? nB : cB + (size_t)(t + 2) * kstep;
            const char* a3 = a2 + kstep; const char* b3 = b2 + kstep;
            if (last && has_next) S.a_ready(nxt);
            if constexpr (SP2) {
            PG8_LDB(B0, 0, 0); PG8_LDB(B1, 0, 1); PG8_SCHED; PG8_LDA(At, 0, 0); PG8_STAGE(PG8_SA(1, 1), a1 + hstepA, voffA);
            PG8_WAIT_V(8); PG8_WAIT_L(0); PG8_BAR; PG8_MMA(0, 0, At, B0); PG8_MMA(0, 1, At, B1); PG8_BAR; PG8_SCHED;
            PG8_LDA(At, 0, 1); PG8_STAGE(PG8_SB(0, 0), b2, voffB); PG8_STAGE(PG8_SB(0, 1), b2 + hstepB, voffB); PG8_STAGE(PG8_SA(0, 0), a2, voffA);
            PG8_WAIT_V(8); PG8_WAIT_L(0); PG8_BAR; PG8_MMA(1, 0, At, B0); PG8_MMA(1, 1, At, B1); PG8_BAR; PG8_SCHED;
            PG8_LDB(B0, 1, 0); PG8_LDB(B1, 1, 1); PG8_SCHED; PG8_LDA(At, 1, 0); PG8_STAGE(PG8_SA(0, 1), a2 + hstepA, voffA);
            PG8_WAIT_V(8); PG8_WAIT_L(0); PG8_BAR; PG8_MMA(0, 0, At, B0); PG8_MMA(0, 1, At, B1); PG8_BAR; PG8_SCHED;
            PG8_LDA(At, 1, 1); PG8_STAGE(PG8_SB(1, 0), b3, voffB); PG8_STAGE(PG8_SB(1, 1), b3 + hstepB, voffB); PG8_STAGE(PG8_SA(1, 0), a3, voffA);
            PG8_WAIT_V(8); PG8_WAIT_L(0); PG8_BAR; PG8_MMA(1, 0, At, B0); PG8_MMA(1, 1, At, B1); PG8_BAR; PG8_SCHED;
            } else {
            PG8_LDB(B0, 0, 0); PG8_SCHED; PG8_LDA(At, 0, 0); PG8_STAGE(PG8_SA(1, 1), a1 + hstepA, voffA);
            PG8_WAIT_L(8); PG8_BAR; PG8_WAIT_L(0); PG8_MMA(0, 0, At, B0); PG8_BAR; PG8_SCHED;
            PG8_LDB(B1, 0, 1); PG8_STAGE(PG8_SB(0, 0), b2, voffB);
            PG8_BAR; PG8_WAIT_L(0); PG8_MMA(0, 1, At, B1); PG8_BAR;
            PG8_LDA(At, 0, 1); PG8_STAGE(PG8_SA(0, 0), a2, voffA);
            PG8_BAR; PG8_WAIT_L(0); PG8_MMA(1, 0, At, B0); PG8_BAR; PG8_SCHED;
            PG8_STAGE(PG8_SB(0, 1), b2 + hstepB, voffB);
            PG8_WAIT_V(6); PG8_BAR; PG8_MMA(1, 1, At, B1); PG8_BAR;
            PG8_LDB(B0, 1, 0); PG8_SCHED; PG8_LDA(At, 1, 0); PG8_STAGE(PG8_SA(0, 1), a2 + hstepA, voffA);
            PG8_WAIT_L(8); PG8_BAR; PG8_WAIT_L(0); PG8_MMA(0, 0, At, B0); PG8_BAR; PG8_SCHED;
            PG8_LDB(B1, 1, 1); PG8_STAGE(PG8_SB(1, 0), b3, voffB);
            PG8_BAR; PG8_WAIT_L(0); PG8_MMA(0, 1, At, B1); PG8_BAR;
            PG8_LDA(At, 1, 1); PG8_STAGE(PG8_SA(1, 0), a3, voffA);
            PG8_BAR; PG8_WAIT_L(0); PG8_MMA(1, 0, At, B0); PG8_BAR; PG8_SCHED;
            PG8_STAGE(PG8_SB(1, 1), b3 + hstepB, voffB);
            PG8_WAIT_V(6); PG8_BAR; PG8_MMA(1, 1, At, B1); PG8_BAR;
            }
        }
        if constexpr (ALIGN_EPI) { if (wr == 0) PG8_BAR; }
        if constexpr (!Epi::AFTER_DRAIN) { E(acc, cur, wr, wc, fr, fq); S.done(cur); }
        if (!has_next) break;
#pragma unroll
        for (int a = 0; a < 2; ++a)
#pragma unroll
            for (int b = 0; b < 2; ++b)
#pragma unroll
                for (int m = 0; m < 4; ++m)
#pragma unroll
                    for (int n = 0; n < 2; ++n) acc[a][b][m][n] = (f32x4){0.f, 0.f, 0.f, 0.f};
        cur = nxt; cA = nA; cB = nB; ++ui;
        if constexpr (ALIGN_EPI) { if (wr == 1) PG8_BAR; }
    }
    PG8_WAIT_V(0);
    if constexpr (!ALIGN_EPI) { if (wr == 0) PG8_BAR; }
    PG8_BAR;
    if constexpr (Epi::AFTER_DRAIN) { E.fused(acc, cur, wr, wc, fr, fq, lds, wid, lane); S.done(cur); }
#undef PG8_SA
#undef PG8_SB
#undef PG8_STAGE
#undef PG8_LDA
#undef PG8_LDB
#undef PG8_MMA
#undef PG8_WAIT_V
#undef PG8_WAIT_L
#undef PG8_BAR
#undef PG8_SCHED
}
}
namespace attn_body {
using bf16=__hip_bfloat16;
using bf16x8=__attribute__((ext_vector_type(8)))short;
using s16x4=__attribute__((ext_vector_type(4)))short;
using f32x16=__attribute__((ext_vector_type(16)))float;
using u32x4=__attribute__((ext_vector_type(4)))unsigned;
constexpr int BATCH=2,NHEAD=16,SEQ=8192,D=64,ZP=3072,OP=1024;
constexpr int NW=8,QBLK=32,QB=QBLK*NW,KVBLK=64,NQB=SEQ/QB;
constexpr int ATTN_UNIT_ROWS=QB;
__device__ __forceinline__ int crow(int r,int hi){return (r&3)+8*(r>>2)+4*hi;}
#define SBAR() __builtin_amdgcn_sched_barrier(0)
typedef const __attribute__((address_space(3))) float* lds_cfp;
__device__ __forceinline__ void cmask(f32x16&p0,f32x16&p1,int jb,int qrel,int hi,lds_cfp tab){
  const float NEG=-INFINITY; const int kb=64*jb+4*hi;
  #pragma unroll
  for(int r=0;r<16;++r){ const int rel=qrel-(kb+(r&3)+8*(r>>2)); const int rel1=rel-32;
    int i0=rel<127?rel:127; i0=i0<0?0:i0; int i1=rel1<127?rel1:127; i1=i1<0?0:i1;
    const float b0=tab[i0], b1=tab[i1];
    p0[r]=rel<0?NEG:p0[r]+b0; p1[r]=rel1<0?NEG:p1[r]+b1; }
}

constexpr int NSLOT=3, SLOTB=8192;
constexpr int LDS_K=0, LDS_V=NSLOT*SLOTB, LDS_WS=2*NSLOT*SLOTB, LDS_OST=LDS_WS+NW*64*4, LDS_BYTES=LDS_OST+NW*4096;
constexpr float C2=0.125f*1.4426950408889634f;
__device__ __forceinline__ void glds16(const void*gsrc,unsigned lds_dst){unsigned keep;
  asm volatile("s_mov_b32 %0, m0\n\ts_mov_b32 m0, %2\n\ts_nop 0\n\tglobal_load_lds_dwordx4 %1, off\n\ts_mov_b32 m0, %0":"=&s"(keep):"v"(gsrc),"s"(lds_dst):"memory");}
__device__ __forceinline__ float max3f(float a,float b,float c){float r;asm("v_max3_f32 %0, %1, %2, %3":"=v"(r):"v"(a),"v"(b),"v"(c));return r;}
__device__ __forceinline__ float max2f(float a,float b){float r;asm("v_max_f32_e32 %0, %1, %2":"=v"(r):"v"(a),"v"(b));return r;}
__device__ __forceinline__ float fadd_s(float a,float b){float r;asm("v_add_f32_e32 %0, %1, %2":"=v"(r):"v"(a),"v"(b));return r;}
__device__ __forceinline__ float fsub_s(float a,float b){float r;asm("v_sub_f32_e32 %0, %1, %2":"=v"(r):"v"(a),"v"(b));return r;}
typedef float f32x2_t __attribute__((ext_vector_type(2))); typedef __bf16 bf16x2_t __attribute__((ext_vector_type(2)));
__device__ __forceinline__ unsigned cvtpk_s(float lo,float hi){f32x2_t v={lo,hi};bf16x2_t b=__builtin_convertvector(v,bf16x2_t);return __builtin_bit_cast(unsigned,b);}
#define WAIT_BAR(N) asm volatile("s_waitcnt vmcnt(" #N ") lgkmcnt(0)\n\ts_barrier":::"memory")

__device__ __forceinline__ void qkt(f32x16&p0,f32x16&p1,const char*Kslot,const bf16x8*qr,const f32x16&negm,int r32,int hi){
  const char*kb=Kslot+hi*1024+r32*16;
  #pragma unroll
  for(int d0=0;d0<4;++d0){
    const bf16x8 b0=*reinterpret_cast<const bf16x8*>(kb+d0*2048);
    const bf16x8 b1=*reinterpret_cast<const bf16x8*>(kb+d0*2048+512);
    if(d0==0){p0=__builtin_amdgcn_mfma_f32_32x32x16_bf16(b0,qr[0],negm,0,0,0);p1=__builtin_amdgcn_mfma_f32_32x32x16_bf16(b1,qr[0],negm,0,0,0);}
    else{p0=__builtin_amdgcn_mfma_f32_32x32x16_bf16(b0,qr[d0],p0,0,0,0);p1=__builtin_amdgcn_mfma_f32_32x32x16_bf16(b1,qr[d0],p1,0,0,0);}}
}
typedef __attribute__((address_space(3))) const char* lds_cptr;
typedef short v4i16_t __attribute__((ext_vector_type(4)));
__device__ __forceinline__ void kload8(bf16x8*kf,lds_cptr kp){
  kf[0]=*(const __attribute__((address_space(3))) bf16x8*)(kp);      kf[1]=*(const __attribute__((address_space(3))) bf16x8*)(kp+512);
  kf[2]=*(const __attribute__((address_space(3))) bf16x8*)(kp+2048); kf[3]=*(const __attribute__((address_space(3))) bf16x8*)(kp+2560);
  kf[4]=*(const __attribute__((address_space(3))) bf16x8*)(kp+4096); kf[5]=*(const __attribute__((address_space(3))) bf16x8*)(kp+4608);
  kf[6]=*(const __attribute__((address_space(3))) bf16x8*)(kp+6144); kf[7]=*(const __attribute__((address_space(3))) bf16x8*)(kp+6656);
}
__device__ __forceinline__ void kload2(bf16x8*kf,lds_cptr kp,int j){ kf[2*j]=*(const __attribute__((address_space(3))) bf16x8*)(kp+j*2048); kf[2*j+1]=*(const __attribute__((address_space(3))) bf16x8*)(kp+j*2048+512); }
__device__ __forceinline__ s16x4 vtr(lds_cptr p){ return __builtin_bit_cast(s16x4,__builtin_amdgcn_ds_read_tr16_b64_v4i16((__attribute__((address_space(3))) v4i16_t*)p)); }
__device__ __forceinline__ float rowmax(const f32x16&p0,const f32x16&p1){
  float a=max3f(p0[0],p0[1],p1[0]),b=max3f(p0[2],p0[3],p1[1]);a=max3f(a,p1[2],p1[3]);
  #pragma unroll
  for(int r=4;r<16;r+=4){a=max3f(a,p0[r],p0[r+1]);b=max3f(b,p0[r+2],p0[r+3]);a=max3f(a,p1[r],p1[r+1]);b=max3f(b,p1[r+2],p1[r+3]);}
  const float m=max2f(a,b);
  auto rr=__builtin_amdgcn_permlane32_swap(__float_as_uint(m),__float_as_uint(m),false,false);
  return max2f(__uint_as_float(rr[0]),__uint_as_float(rr[1]));
}
__device__ __forceinline__ void pv(f32x16*o,int vb,bf16x8 pa0,bf16x8 pa1,bf16x8 pa2,bf16x8 pa3){
  #pragma unroll
  for(int d0=0;d0<2;++d0){s16x4 lo[4],hi[4];
    #pragma unroll
    for(int ks=0;ks<4;++ks){
      asm volatile("ds_read_b64_tr_b16 %0,%1 offset:%c2":"=&v"(lo[ks]):"v"(vb),"i"(d0*4096+ks*1024):"memory");
      asm volatile("ds_read_b64_tr_b16 %0,%1 offset:%c2":"=&v"(hi[ks]):"v"(vb),"i"(d0*4096+ks*1024+512):"memory");}
    asm volatile("s_waitcnt lgkmcnt(0)":::"memory");SBAR();
    #define PK(k) (bf16x8){lo[k][0],lo[k][1],lo[k][2],lo[k][3],hi[k][0],hi[k][1],hi[k][2],hi[k][3]}
    o[d0]=__builtin_amdgcn_mfma_f32_32x32x16_bf16(pa0,PK(0),o[d0],0,0,0);
    o[d0]=__builtin_amdgcn_mfma_f32_32x32x16_bf16(pa1,PK(1),o[d0],0,0,0);
    o[d0]=__builtin_amdgcn_mfma_f32_32x32x16_bf16(pa2,PK(2),o[d0],0,0,0);
    o[d0]=__builtin_amdgcn_mfma_f32_32x32x16_bf16(pa3,PK(3),o[d0],0,0,0);
    #undef PK
  }
}

#ifndef ATTN_STORE16
#define ATTN_STORE16(p,v) (*(u32x4*)(p)=(v))
#endif
template<int THRL> __device__ __forceinline__ void attn_unit(int b,int qcol,int kcol,int vcol,int ocol,int qb,const bf16*__restrict__ Zb,bf16*O,char*shm,lds_cfp tab){
  int tid_=threadIdx.x; asm volatile("":"+v"(tid_));
  const int tid=tid_,lane=tid&63,r32=lane&31,hi=lane>>5; const int wid=__builtin_amdgcn_readfirstlane(tid>>6);
  const long rowbase=(long)b*SEQ; const int q0=qb*QB;
  const bf16*Qw=Zb+(rowbase+q0+wid*QBLK)*ZP+qcol;
  const bf16*Kh=Zb+rowbase*ZP+kcol,*Vh=Zb+rowbase*ZP+vcol;
  const unsigned lds0=(unsigned)(uintptr_t)shm;
  float*wsf=(float*)(shm+LDS_WS)+wid*64;
  const bf16*ksrc=Kh+(long)lane*ZP+wid*8;
  const bf16*vsrc=Vh+(long)(16*(wid&3)+(lane>>2))*ZP+(wid>>2)*32+(lane&3)*8;
  const unsigned kdst=lds0+LDS_K+wid*1024, vdst=lds0+LDS_V+wid*1024;
  #define DMA_K(t,slot) glds16(ksrc+(long)(t)*KVBLK*ZP,(unsigned)__builtin_amdgcn_readfirstlane(kdst+(slot)))
  #define DMA_V(t,slot) glds16(vsrc+(long)(t)*KVBLK*ZP,(unsigned)__builtin_amdgcn_readfirstlane(vdst+(slot)))
  const int vb0=(int)(lds0+LDS_V)+((lane>>4)&1)*32+(lane&3)*8+(4*hi+((lane&15)>>2))*64;
  const char*Kbase=shm+LDS_K; bf16x8 kf[8];
  const lds_cptr shm3=(lds_cptr)shm; const lds_cptr kp0=shm3+LDS_K+hi*1024+r32*16; const lds_cptr vp0=shm3+LDS_V+((lane>>4)&1)*32+(lane&3)*8+(4*hi+((lane&15)>>2))*64;
  const int NT=(q0+QB)/KVBLK;
  DMA_K(0,0);DMA_V(0,0);DMA_K(1,SLOTB);
  bf16x8 qr[4];
  #pragma unroll
  for(int d0=0;d0<4;++d0)qr[d0]=*reinterpret_cast<const bf16x8*>(&Qw[(long)r32*ZP+d0*16+hi*8]);
  float mhat=0.f,l_reg=0.f;f32x16 o[2];o[0]=f32x16{};o[1]=f32x16{};f32x16 negm=f32x16{};asm volatile("":"+v"(negm));
  const int qrel=wid*QBLK+r32;
  #define CMASK(P0,P1,t) do{int jb_=(t)-(NT-4); if(jb_>=-2)cmask(P0,P1,jb_,qrel,hi,tab);}while(0)
  bool resc=false;
  #define START(P0,P1) do{ const float rm=rowmax(P0,P1); resc=false; \
    { const float dl=rm; mhat=fadd_s(mhat,dl); \
      _Pragma("unroll") for(int r=0;r<16;++r){P0[r]=fsub_s(P0[r],dl);P1[r]=fsub_s(P1[r],dl);} \
      _Pragma("unroll") for(int r=0;r<16;++r)negm[r]=-mhat; asm volatile("":"+v"(negm)); } \
    _Pragma("unroll") for(int r=0;r<16;++r)P0[r]=__builtin_amdgcn_exp2f(P0[r]); }while(0)
  #define RESC() do{ if(resc){ asm volatile("s_waitcnt lgkmcnt(0)":::"memory"); \
      _Pragma("unroll") for(int d_=0;d_<2;++d_) _Pragma("unroll") for(int r=0;r<16;++r)o[d_][r]*=wsf[crow(r,hi)]; } }while(0)
  f32x16 pA0,pA1,pB0,pB1;
  int sl_prev=0,sl_cur=0,sl_next=SLOTB;
  #define ROT() do{sl_prev=sl_cur;sl_cur=sl_next;sl_next=(sl_next==(NSLOT-1)*SLOTB)?0:sl_next+SLOTB;}while(0)
  DMA_K(2,2*SLOTB);
  WAIT_BAR(3);
  qkt(pA0,pA1,Kbase,qr,negm,r32,hi);asm volatile("s_nop 15\n\ts_nop 7":"+v"(pA0),"+v"(pA1));CMASK(pA0,pA1,0);
  START(pA0,pA1);
  _Pragma("unroll") for(int r=0;r<16;++r)pA1[r]=__builtin_amdgcn_exp2f(pA1[r]);
  WAIT_BAR(0);
  DMA_K(3,0);DMA_V(1,SLOTB);
  ROT();
  kload8(kf,kp0+sl_cur);
  WAIT_BAR(2);
  s16x4 vlo[8],vhi[8]; u32x4 pw0,pw1,pw2,pw3;
  #define PKW(P,B) cvtpk_s(P[B],P[B+1])
  #define PAF(k) __builtin_bit_cast(bf16x8,pw##k)
  #define VFR(i) (bf16x8){vlo[i][0],vlo[i][1],vlo[i][2],vlo[i][3],vhi[i][0],vhi[i][1],vhi[i][2],vhi[i][3]}
  #define PIN(x) asm volatile("":"+v"(x))
  #define MX3(a,b,c) __builtin_fmaxf(__builtin_fmaxf((a),(b)),(c))
  #define GAPA(MF,A0,A1,A2,A3,W0,W1,PW) do{ MF; sacc+=A0; sacc+=A1; sacc+=A2; sacc+=A3; PIN(sacc); W0; W1; PIN(PW); SBAR(); }while(0)
  #define EX(v) __builtin_amdgcn_exp2f(v)
  #define GAPB(MF,X,B) do{ MF; X[B]=EX(X[B]); X[B+1]=EX(X[B+1]); X[B+2]=EX(X[B+2]); X[B+3]=EX(X[B+3]); PIN(X); SBAR(); }while(0)
  #define VRD(i) do{ vlo[i]=vtr(vp_+(((i)>>2)*4096+((i)&3)*1024)); vhi[i]=vtr(vp_+(((i)>>2)*4096+((i)&3)*1024+512)); }while(0)
  #define KRD(G,j) do{ if(G){ kload2(kf,kp0+sl_next,j); SBAR(); } }while(0)
  #define STEP(C0,C1,P0,P1,t,GK,GV,GL) do{ SBAR(); \
    const lds_cptr vp_=vp0+sl_prev; \
    VRD(0); SBAR(); float sacc=(P0[0]+P0[1]); \
    GAPA(C0=__builtin_amdgcn_mfma_f32_32x32x16_bf16(kf[0],qr[0],negm,0,0,0), P0[2],P0[3],P0[4],P0[5],     pw0[0]=PKW(P0,0), pw0[1]=PKW(P0,2), pw0); \
    VRD(4); SBAR(); GAPA(C1=__builtin_amdgcn_mfma_f32_32x32x16_bf16(kf[1],qr[0],negm,0,0,0), P0[6],P0[7],P0[8],P0[9],     pw0[2]=PKW(P0,4), pw0[3]=PKW(P0,6), pw0); \
    VRD(1); SBAR(); GAPA(C0=__builtin_amdgcn_mfma_f32_32x32x16_bf16(kf[2],qr[1],C0,0,0,0),   P0[10],P0[11],P0[12],P0[13], pw1[0]=PKW(P0,8), pw1[1]=PKW(P0,10), pw1); \
    VRD(5); SBAR(); GAPA(C1=__builtin_amdgcn_mfma_f32_32x32x16_bf16(kf[3],qr[1],C1,0,0,0),   P0[14],P0[15],P1[0],P1[1],   pw1[2]=PKW(P0,12),pw1[3]=PKW(P0,14), pw1); \
    VRD(2); SBAR(); GAPA(C0=__builtin_amdgcn_mfma_f32_32x32x16_bf16(kf[4],qr[2],C0,0,0,0),   P1[2],P1[3],P1[4],P1[5],     pw2[0]=PKW(P1,0), pw2[1]=PKW(P1,2), pw2); \
    VRD(6); SBAR(); GAPA(C1=__builtin_amdgcn_mfma_f32_32x32x16_bf16(kf[5],qr[2],C1,0,0,0),   P1[6],P1[7],P1[8],P1[9],     pw2[2]=PKW(P1,4), pw2[3]=PKW(P1,6), pw2); \
    VRD(3); SBAR(); GAPA(C0=__builtin_amdgcn_mfma_f32_32x32x16_bf16(kf[6],qr[3],C0,0,0,0),   P1[10],P1[11],P1[12],P1[13], pw3[0]=PKW(P1,8), pw3[1]=PKW(P1,10), pw3); \
    VRD(7); SBAR(); GAPA(C1=__builtin_amdgcn_mfma_f32_32x32x16_bf16(kf[7],qr[3],C1,0,0,0),   P1[14],P1[15],0.f,0.f,       pw3[2]=PKW(P1,12),pw3[3]=PKW(P1,14), pw3); \
    l_reg+=sacc; \
    if(GK){DMA_K((t)+3,sl_cur);} if(GV){DMA_V((t)+1,sl_next);} \
    CMASK(C0,C1,t); \
    { float a=MX3(C0[0],C0[1],C1[0]),b=MX3(C0[2],C0[3],C1[1]); a=MX3(a,C1[2],C1[3]); \
      _Pragma("unroll") for(int r=4;r<16;r+=4){a=MX3(a,C0[r],C0[r+1]);b=MX3(b,C0[r+2],C0[r+3]);a=MX3(a,C1[r],C1[r+1]);b=MX3(b,C1[r+2],C1[r+3]);} \
      float rm=__builtin_fmaxf(a,b); { auto rr=__builtin_amdgcn_permlane32_swap(__float_as_uint(rm),__float_as_uint(rm),false,false); rm=__builtin_fmaxf(__uint_as_float(rr[0]),__uint_as_float(rr[1])); } \
      resc=false; \
      if(__builtin_expect(__any(rm>(float)THRL),0)){ const float dl=__builtin_fmaxf(rm,0.f); mhat+=dl; \
        _Pragma("unroll") for(int r=0;r<16;++r){C0[r]-=dl;C1[r]-=dl;} \
        _Pragma("unroll") for(int r=0;r<16;++r)negm[r]=-mhat; asm volatile("":"+v"(negm)); \
        const float f=__builtin_amdgcn_exp2f(-dl); l_reg*=f; if(hi==0)wsf[r32]=f; resc=true; } } \
    SBAR(); \
    GAPB(o[0]=__builtin_amdgcn_mfma_f32_32x32x16_bf16(PAF(0),VFR(0),o[0],0,0,0), C0,0); \
    GAPB(o[1]=__builtin_amdgcn_mfma_f32_32x32x16_bf16(PAF(0),VFR(4),o[1],0,0,0), C0,4); \
    KRD(GL,0); GAPB(o[0]=__builtin_amdgcn_mfma_f32_32x32x16_bf16(PAF(1),VFR(1),o[0],0,0,0), C0,8); \
    KRD(GL,1); GAPB(o[1]=__builtin_amdgcn_mfma_f32_32x32x16_bf16(PAF(1),VFR(5),o[1],0,0,0), C0,12); \
    KRD(GL,2); GAPB(o[0]=__builtin_amdgcn_mfma_f32_32x32x16_bf16(PAF(2),VFR(2),o[0],0,0,0), C1,0); \
    KRD(GL,3); GAPB(o[1]=__builtin_amdgcn_mfma_f32_32x32x16_bf16(PAF(2),VFR(6),o[1],0,0,0), C1,4); \
    GAPB(o[0]=__builtin_amdgcn_mfma_f32_32x32x16_bf16(PAF(3),VFR(3),o[0],0,0,0), C1,8); \
    GAPB(o[1]=__builtin_amdgcn_mfma_f32_32x32x16_bf16(PAF(3),VFR(7),o[1],0,0,0), C1,12); \
    }while(0)
  int t=1;
  #undef CMASK
  #define CMASK(P0,P1,t) do{}while(0)
  for(;t+7<NT;t+=2){
    STEP(pB0,pB1,pA0,pA1,t,true,true,true);     WAIT_BAR(2); RESC(); ROT();
    STEP(pA0,pA1,pB0,pB1,t+1,true,true,true);   WAIT_BAR(2); RESC(); ROT();
  }
  #undef CMASK
  #define CMASK(P0,P1,t) do{int jb_=(t)-(NT-4); if(jb_>=-2)cmask(P0,P1,jb_,qrel,hi,tab);}while(0)
  #define ENDW(tt) do{ if((tt)+3<NT){WAIT_BAR(2);} else if((tt)+2<NT){WAIT_BAR(1);} else {WAIT_BAR(0);} }while(0)
  for(;t+1<NT;t+=2){
    STEP(pB0,pB1,pA0,pA1,t,(t+3<NT),(t+1<NT),(t+1<NT));       ENDW(t);   RESC(); ROT();
    STEP(pA0,pA1,pB0,pB1,t+1,(t+4<NT),(t+2<NT),(t+2<NT));     ENDW(t+1); RESC(); ROT();
  }
  STEP(pB0,pB1,pA0,pA1,NT-1,false,false,false); RESC();
  { float sacc=pB0[0]+pB0[1]; _Pragma("unroll") for(int r=2;r<16;++r)sacc+=pB0[r]; _Pragma("unroll") for(int r=0;r<16;++r)sacc+=pB1[r]; l_reg+=sacc;
    pw0=(u32x4){PKW(pB0,0),PKW(pB0,2),PKW(pB0,4),PKW(pB0,6)};pw1=(u32x4){PKW(pB0,8),PKW(pB0,10),PKW(pB0,12),PKW(pB0,14)};pw2=(u32x4){PKW(pB1,0),PKW(pB1,2),PKW(pB1,4),PKW(pB1,6)};pw3=(u32x4){PKW(pB1,8),PKW(pB1,10),PKW(pB1,12),PKW(pB1,14)};
    SBAR(); pv(o,vb0+sl_cur,PAF(0),PAF(1),PAF(2),PAF(3)); }
  #undef PKW
  #undef PAF
  #undef VFR
  #undef PIN
  #undef MX3
  #undef GAPA
  #undef GAPB
  #undef EX
  #undef VRD
  #undef KRD
  #undef STEP
  #undef ENDW
  {auto rr=__builtin_amdgcn_permlane32_swap(__float_as_uint(l_reg),__float_as_uint(l_reg),false,false);l_reg=__uint_as_float(rr[0])+__uint_as_float(rr[1]);}
  if(hi==0)wsf[32+r32]=l_reg;asm volatile("s_waitcnt lgkmcnt(0)":::"memory");
  float rli[16];
  #pragma unroll
  for(int r=0;r<16;++r)rli[r]=__builtin_amdgcn_rcpf(wsf[32+crow(r,hi)]);
  bf16*Ow=O+(rowbase+q0+wid*QBLK)*OP+ocol;
  { bf16*stg=(bf16*)(shm+LDS_OST)+wid*2048;
    #pragma unroll
    for(int r=0;r<16;++r){const int orow=crow(r,hi);
      #pragma unroll
      for(int d0=0;d0<2;++d0)stg[orow*64+d0*32+r32]=__float2bfloat16(o[d0][r]*rli[r]);}
    asm volatile("s_waitcnt lgkmcnt(0)":::"memory");
    #pragma unroll
    for(int i=0;i<4;++i){const int row=i*8+(lane>>3),ch=lane&7; const u32x4 v=*(const u32x4*)(stg+row*64+ch*8); ATTN_STORE16(Ow+(long)row*OP+ch*8,v);} }
  asm volatile("s_waitcnt lgkmcnt(0)\n\ts_barrier":::"memory");
  #undef DMA_K
  #undef DMA_V
  #undef CMASK
  #undef START
  #undef RESC
  #undef ROT
}
constexpr int ATTN_LDS_BYTES=LDS_BYTES;
struct AttnUnit { int bh; int qb; };
struct StaticOrder {
  int vcu;
  __device__ __forceinline__ explicit StaticOrder(int grid,int block):vcu((block%8)*(grid/8)+block/8){}
  __device__ __forceinline__ bool next(int i,AttnUnit&u)const{ if(i>=4)return false; const int s=vcu&7; u.bh=vcu>>3; u.qb=(i==0)?s:(i==1)?15-s:(i==2)?16+s:31-s; return true; }
  __device__ __forceinline__ void a_ready(const AttnUnit&)const{}
  __device__ __forceinline__ void done(const AttnUnit&)const{}
};
template<class Sched,int THRL=8> __device__ __forceinline__ void attn_phase(char*lds,const bf16*Zb,bf16*OA,lds_cfp tab,const Sched&S){
  AttnUnit u;
  for(int i=0;S.next(i,u);++i){ S.a_ready(u); const int b=u.bh>>4,vh=u.bh&15,map=vh>>3,h=(vh>>1)&3,vhalf=vh&1;
    attn_unit<THRL>(b,h*128+map*64,512+h*128+map*64,1024+h*128+vhalf*64,map*512+h*128+vhalf*64,u.qb,Zb,OA,lds,tab+h*128); S.done(u); }
}
template<int THRL=8> __device__ __forceinline__ void attn_one(char*lds,const bf16*Zb,bf16*OA,lds_cfp tab,const AttnUnit&u){
  const int b=u.bh>>4,vh=u.bh&15,map=vh>>3,h=(vh>>1)&3,vhalf=vh&1;
  attn_unit<THRL>(b,h*128+map*64,512+h*128+map*64,1024+h*128+vhalf*64,map*512+h*128+vhalf*64,u.qb,Zb,OA,lds,tab+h*128);
}
#undef SBAR
#undef WAIT_BAR
}

constexpr int NWAVES = 8;
#ifndef MK_PER_PHASE
#define MK_PER_PHASE 0
#endif
constexpr int NPH = 12;

constexpr int MP = 16384, MS = 128, MV = MP + MS, MPAD = 16640;
constexpr int DM = 1024, DIN = 3072, FF = 4096, TSEQ = 8192, NMEM = 256, PASTLEN = 2048;
constexpr float EPS = 1e-6f, LOG2E = 1.4426950408889634f;
constexpr float C2A = 0.125f * LOG2E;
constexpr float C2M = 0.0625f * LOG2E;
constexpr float ONE_M_LAMINIT = 0.8f, LAMINIT = 0.2f;
constexpr int ZQA = 0, ZKA = 512, ZVA = 1024, ZQR = 1536, ZKR = 1792, ZVR = 2048, ZGR = 2560;
constexpr size_t OY_P = 0, OY_S = 16777216, OK_P = 16908288, OV_P = 25296896, OS_P = 33685504, OMK = 33751040, OMV = 34275328, OK_S = 34799616, OV_S = 34865152, OS_S = 34930688, OUT_TOTAL = 39124992;
enum { I_XP = 0, I_XS, I_MEMP, I_CK, I_CV, I_PT, I_SRET, I_CMK, I_CMV, I_RELB, I_NMIX, I_WIN, I_LQ1, I_LK1, I_LQ2, I_LK2, I_SUBLN, I_WOUT, I_NMEMQ, I_NMEMKV, I_WMQ, I_WMK, I_WMV, I_WMO, I_NMLP, I_WUP, I_WDN, I_NFIN, N_IN };

constexpr size_t MiB = 1u << 20;
constexpr size_t WS_CTL = 0, CTL_ZERO_BYTES = 1 * MiB;
constexpr size_t WS_WIN = 2 * MiB, WS_WOUT = 8 * MiB, WS_WMQ = 10 * MiB, WS_WMKV = 12 * MiB, WS_WMO = 16 * MiB, WS_WUP = 18 * MiB, WS_WDN = 26 * MiB;
constexpr size_t WS_MEMN = 34 * MiB, WS_MKB = 35 * MiB, WS_MVT = 36 * MiB, WS_SSQ1 = 37 * MiB, WS_SSQ2 = 39 * MiB, WS_SSQ3 = 41 * MiB;
constexpr size_t WS_XN = 48 * MiB, WS_Z = 82 * MiB, WS_OA = 180 * MiB, WS_MIX = 214 * MiB, WS_KRT = 248 * MiB, WS_VRT = 256 * MiB, WS_U = 272 * MiB, WS_SPT = 288 * MiB;
constexpr size_t WS_X1 = 296 * MiB, WS_X1B = 362 * MiB, WS_QM = 396 * MiB, WS_PM = 430 * MiB, WS_OM = 464 * MiB, WS_X2 = 498 * MiB, WS_X2B = 564 * MiB, WS_H = 598 * MiB, WS_X3 = 730 * MiB, WS_END = 796 * MiB;
static_assert(WS_XN + (size_t)MPAD * DM * 2 <= WS_Z && WS_Z + (size_t)MPAD * DIN * 2 <= WS_OA && WS_OA + (size_t)MPAD * DM * 2 <= WS_MIX && WS_MIX + (size_t)MPAD * DM * 2 <= WS_KRT, "ws map 1");
static_assert(WS_X1 + (size_t)MPAD * DM * 4 <= WS_X1B && WS_H + (size_t)MPAD * FF * 2 <= WS_X3 && WS_X3 + (size_t)MPAD * DM * 4 <= WS_END && WS_SSQ1 + (size_t)MPAD * 16 * 4 <= WS_SSQ2, "ws map 2");
constexpr int CW_TMO = 0, CW_CODE = 1, CW_BAR = 4096;

constexpr int RING_OFF = 0, RING_BYTES = 131072;
constexpr int LDSCTL_OFF = RING_BYTES, MISC_OFF = LDSCTL_OFF + 320;
constexpr int TAB_OFF = RING_BYTES + 1024;
constexpr int LDS_BYTES = 147456;
static_assert(MISC_OFF + 128 <= TAB_OFF && TAB_OFF + 2048 <= LDS_BYTES, "LDS map");

#define GAS __attribute__((address_space(1)))
#define LAS __attribute__((address_space(3)))
typedef unsigned short bf16;
typedef unsigned v4u __attribute__((ext_vector_type(4)));
typedef float f32x4 __attribute__((ext_vector_type(4)));
typedef short bf16x8 __attribute__((ext_vector_type(8)));
typedef GAS unsigned gu32;
typedef GAS unsigned long long gu64;
#define RLX_AGENT __ATOMIC_RELAXED, __HIP_MEMORY_SCOPE_AGENT
#define LDS_WAIT() asm volatile("s_waitcnt lgkmcnt(0)" ::: "memory")
#define VM_WAIT() asm volatile("s_waitcnt vmcnt(0)" ::: "memory")
__device__ __forceinline__ unsigned long long rt() { return __builtin_amdgcn_s_memrealtime(); }
__device__ __forceinline__ unsigned f2bf(float f) { unsigned u = __builtin_bit_cast(unsigned, f); return (u + 0x7fffu + ((u >> 16) & 1u)) >> 16; }
__device__ __forceinline__ unsigned pk2(float lo, float hi) { return f2bf(lo) | (f2bf(hi) << 16); }

#define XB_TMO      128
#define XB_XCNT(j)  (256  + 64 * (j))
#define XB_XSUB(j)  (1280 + 64 * (j))
#define XB_XGEN(j)  (2304 + 64 * (j))
#define XB_TOP      3328
#define XB_TOPGEN   3392
#define XCD_BAR_WORDS 3456
#define XB_SPIN_CAP (1u << 18)

__device__ __forceinline__ unsigned xb_ld(unsigned* p)              { return __hip_atomic_load(p, __ATOMIC_RELAXED, __HIP_MEMORY_SCOPE_AGENT); }
__device__ __forceinline__ unsigned xb_add(unsigned* p, unsigned v) { return __hip_atomic_fetch_add(p, v, __ATOMIC_RELAXED, __HIP_MEMORY_SCOPE_AGENT); }
__device__ __forceinline__ unsigned xb_xcc_id() { return (unsigned)__builtin_amdgcn_s_getreg((3 << 11) | 20) & 0xFu; }
#define XB_SPIN(cond, bar) do { unsigned _sp = 0; while (cond) { __builtin_amdgcn_s_sleep(1); \
    if ((++_sp & 255u) == 0u) { if (xb_ld(&(bar)[XB_TMO])) break; if (_sp > XB_SPIN_CAP) { atomicAdd(&(bar)[XB_TMO], 1u); break; } } } } while (0)

struct XcdBarrier {
    unsigned* bar; unsigned x;
    volatile LAS unsigned* st;
};

__device__ __forceinline__ XcdBarrier xcd_barrier_post(unsigned* bar, volatile LAS unsigned* st) {
    XcdBarrier b; b.bar = bar; b.x = xb_xcc_id(); b.st = st;
    if (threadIdx.x == 0) (void)xb_add(&bar[XB_XCNT(b.x)], 1u);
    return b;
}
__device__ __forceinline__ void xcd_barrier_complete(unsigned* bar, unsigned x, unsigned& nloc, unsigned& nx) {
    const unsigned G = gridDim.x * gridDim.y * gridDim.z;
    unsigned sum, cnt, mine, sp = 0u;
    for (;;) {
        sum = 0u; cnt = 0u; mine = 0u;
#pragma unroll
        for (unsigned j = 0; j < 16; ++j) { const unsigned c = xb_ld(&bar[XB_XCNT(j)]); sum += c; cnt += (c > 0u) ? 1u : 0u; mine = (j == x) ? c : mine; }
        if (sum == G) break;
        __builtin_amdgcn_s_sleep(1);
        if ((++sp & 255u) == 0u) { if (xb_ld(&bar[XB_TMO])) break; if (sp > XB_SPIN_CAP) { atomicAdd(&bar[XB_TMO], 1u); break; } }
    }
    nloc = mine > 0u ? mine : 1u; nx = cnt > 0u ? cnt : 1u;
}

__device__ __forceinline__ void xcd_barrier(const XcdBarrier& b) {
    asm volatile("s_waitcnt vmcnt(0)" ::: "memory");
    __syncthreads();
    if (threadIdx.x == 0) {
        unsigned* bar = b.bar;
        __builtin_amdgcn_s_waitcnt(0);
        unsigned nloc = b.st[0], nx = b.st[1];
        if (nloc == 0u) { xcd_barrier_complete(bar, b.x, nloc, nx); b.st[0] = nloc; b.st[1] = nx; }
        const unsigned old = xb_add(&bar[XB_XSUB(b.x)], 1u);
        const unsigned gen = old / nloc;
        if (old + 1u == (gen + 1u) * nloc) {
            __builtin_amdgcn_fence(__ATOMIC_RELEASE, "agent");
            asm volatile("s_waitcnt vmcnt(0)" ::: "memory");
            const unsigned og = xb_add(&bar[XB_TOP], 1u);
            const unsigned tg = og / nx;
            if (og + 1u == (tg + 1u) * nx) xb_add(&bar[XB_TOPGEN], 1u);
            else XB_SPIN(xb_ld(&bar[XB_TOPGEN]) == tg, bar);
            __builtin_amdgcn_fence(__ATOMIC_ACQUIRE, "agent");
            xb_add(&bar[XB_XGEN(b.x)], 1u);
            asm volatile("s_waitcnt vmcnt(0)" ::: "memory");
        } else {
            XB_SPIN(xb_ld(&bar[XB_XGEN(b.x)]) == gen, bar);
            __builtin_amdgcn_fence(__ATOMIC_ACQUIRE, "agent");
            asm volatile("s_waitcnt vmcnt(0)" ::: "memory");
        }
    }
    __syncthreads();
}

typedef unsigned u32x2 __attribute__((ext_vector_type(2)));
typedef float f32x16 __attribute__((ext_vector_type(16)));
typedef short s16x4 __attribute__((ext_vector_type(4)));
struct Frame {
    LAS unsigned char* lds;
    volatile LAS unsigned* MISC;
    gu32* ctl;
    int wave, vcu, G;
    const float* const* in;
    float* out; unsigned char* ws;
};
#define WSP(T, off) ((T*)(F.ws + (off)))
__device__ __forceinline__ int fresh_tid() { int t = threadIdx.x; asm volatile("" : "+v"(t)); return t; }

__device__ __forceinline__ float bf2f(unsigned short b) { return __uint_as_float((unsigned)b << 16); }
__device__ __forceinline__ float bflo(unsigned w) { return __uint_as_float(w << 16); }
__device__ __forceinline__ float bfhi(unsigned w) { return __uint_as_float(w & 0xffff0000u); }
__device__ __forceinline__ v4u pack8(const f32x4 a, const f32x4 b) { v4u w; w.x = pg8::cvt_pk_bf16(a.x, a.y); w.y = pg8::cvt_pk_bf16(a.z, a.w); w.z = pg8::cvt_pk_bf16(b.x, b.y); w.w = pg8::cvt_pk_bf16(b.z, b.w); return w; }
template <int CTRL> __device__ __forceinline__ float dpp_mov(float v) { return __builtin_bit_cast(float, __builtin_amdgcn_update_dpp(0, __builtin_bit_cast(int, v), CTRL, 0xF, 0xF, true)); }
__device__ __forceinline__ float row16_sum(float v) {
    v += dpp_mov<0xB1>(v);
    v += dpp_mov<0x4E>(v);
    v += dpp_mov<0x141>(v);
    v += dpp_mov<0x140>(v);
    return v;
}
__device__ __forceinline__ float wave_sum(float v) { v = row16_sum(v); v += __shfl_xor(v, 16); v += __shfl_xor(v, 32); return v; }
__device__ __forceinline__ float wave_max(float v) {
#pragma unroll
    for (int o = 1; o < 64; o <<= 1) v = fmaxf(v, __shfl_xor(v, o));
    return v;
}
__device__ __forceinline__ float log2gamma(int h) { return log2f(1.0f - exp2f(-(float)(5 + h))); }
__device__ __forceinline__ int t5_bucket(int n) {
    if (n < 16) return n;
    return 16 + (n >= 19) + (n >= 21) + (n >= 24) + (n >= 27) + (n >= 31) + (n >= 35) + (n >= 40) + (n >= 46) + (n >= 52) + (n >= 59) + (n >= 67) + (n >= 77) + (n >= 87) + (n >= 99) + (n >= 113);
}
__device__ __forceinline__ float lam_value(Frame& F, int lane) {
    const float a = F.in[I_LQ1][lane] * F.in[I_LK1][lane], b = F.in[I_LQ2][lane] * F.in[I_LK2][lane];
    return expf(wave_sum(a)) - expf(wave_sum(b)) + LAMINIT;
}

__device__ __forceinline__ int win_src_col(int n) {
    if (n < ZQR || n >= ZVR) return n;
    const int p = (n - ZQR) & 63;
    return (n - p) + (p >> 1) + 32 * (p & 1);
}
__device__ __forceinline__ void p0_transpose_item(const float* W, int K, int N, bf16* WT, int row_off, LAS float* scr, int item, int lane, const float* gk, bool perm) {
    const int nblk = N / 32, kb = item / nblk, nb = item % nblk, k0 = 64 * kb, n0 = 32 * nb;
    const int sc = perm ? win_src_col(n0 + (lane & 31)) : n0 + (lane & 31);
#pragma unroll 8
    for (int i = 0; i < 32; ++i) { const int kk = 2 * i + (lane >> 5); float v = W[(size_t)(k0 + kk) * N + sc]; if (gk) v *= gk[k0 + kk]; scr[kk * 33 + (lane & 31)] = v; }
    LDS_WAIT(); asm volatile("" ::: "memory");
    const int c = lane & 7;
#pragma unroll
    for (int j = 0; j < 4; ++j) { const int n = (lane >> 3) + 8 * j; const LAS float* s = scr + (8 * c) * 33 + n;
        v4u o; o.x = pk2(s[0 * 33], s[1 * 33]); o.y = pk2(s[2 * 33], s[3 * 33]); o.z = pk2(s[4 * 33], s[5 * 33]); o.w = pk2(s[6 * 33], s[7 * 33]);
        *(GAS v4u*)(WT + (size_t)(row_off + n0 + n) * K + k0 + 8 * c) = o; }
    LDS_WAIT(); asm volatile("" ::: "memory");
}
__device__ __forceinline__ void rms_row_to_bf16(int lane, const float* xrow, const float* g, bf16* orow) {
    const GAS f32x4* xr = (const GAS f32x4*)xrow + lane; const GAS f32x4* gr = (const GAS f32x4*)g + lane;
    f32x4 v[4]; float s = 0.f;
#pragma unroll
    for (int j = 0; j < 4; ++j) { v[j] = xr[64 * j]; s += (v[j].x * v[j].x + v[j].y * v[j].y) + (v[j].z * v[j].z + v[j].w * v[j].w); }
    const float rstd = 1.f / sqrtf(wave_sum(s) * (1.f / DM) + EPS);
    GAS unsigned long long* o8 = (GAS unsigned long long*)orow + lane;
#pragma unroll
    for (int j = 0; j < 4; ++j) { const f32x4 gv = gr[64 * j];
        o8[64 * j] = (unsigned long long)pk2(v[j].x * rstd * gv.x, v[j].y * rstd * gv.y) | ((unsigned long long)pk2(v[j].z * rstd * gv.z, v[j].w * rstd * gv.w) << 32); }
}
__device__ __forceinline__ void p0_prologue(Frame& F) {
    const int lane = fresh_tid() & 63;
    LAS float* scr = (LAS float*)(F.lds + RING_OFF + F.wave * 16384);
    const int gw = F.vcu * NWAVES + F.wave, NGW = F.G * NWAVES;
    constexpr int I_IN = 16 * 96, I_SQ = 16 * 32, I_UP = 16 * 128, I_DN = 64 * 32;
    constexpr int NITEMS = I_IN + 5 * I_SQ + I_UP + I_DN;
    for (int it = gw; it < NITEMS; it += NGW) {
        int r = it;
        if (r < I_IN) { p0_transpose_item(F.in[I_WIN], DM, DIN, WSP(bf16, WS_WIN), 0, scr, r, lane, nullptr, true); continue; } r -= I_IN;
        if (r < I_SQ) { p0_transpose_item(F.in[I_WOUT], DM, DM, WSP(bf16, WS_WOUT), 0, scr, r, lane, nullptr, false); continue; } r -= I_SQ;
        if (r < I_SQ) { p0_transpose_item(F.in[I_WMQ], DM, DM, WSP(bf16, WS_WMQ), 0, scr, r, lane, F.in[I_NMEMQ], false); continue; } r -= I_SQ;
        if (r < I_SQ) { p0_transpose_item(F.in[I_WMK], DM, DM, WSP(bf16, WS_WMKV), 0, scr, r, lane, nullptr, false); continue; } r -= I_SQ;
        if (r < I_SQ) { p0_transpose_item(F.in[I_WMV], DM, DM, WSP(bf16, WS_WMKV), DM, scr, r, lane, nullptr, false); continue; } r -= I_SQ;
        if (r < I_SQ) { p0_transpose_item(F.in[I_WMO], DM, DM, WSP(bf16, WS_WMO), 0, scr, r, lane, nullptr, false); continue; } r -= I_SQ;
        if (r < I_UP) { p0_transpose_item(F.in[I_WUP], DM, FF, WSP(bf16, WS_WUP), 0, scr, r, lane, F.in[I_NMLP], false); continue; } r -= I_UP;
        p0_transpose_item(F.in[I_WDN], FF, DM, WSP(bf16, WS_WDN), 0, scr, r, lane, nullptr, false);
    }
    bf16* XN = WSP(bf16, WS_XN); bf16* MEMN = WSP(bf16, WS_MEMN);
    for (int m = gw; m < MPAD + 2 * NMEM; m += NGW) {
        if (m < MP) rms_row_to_bf16(lane, F.in[I_XP] + (size_t)m * DM, F.in[I_NMIX], XN + (size_t)m * DM);
        else if (m < MV) rms_row_to_bf16(lane, F.in[I_XS] + (size_t)(m - MP) * DM, F.in[I_NMIX], XN + (size_t)m * DM);
        else if (m < MPAD) { GAS v4u* o = (GAS v4u*)(XN + (size_t)m * DM) + lane; o[0] = (v4u){0u, 0u, 0u, 0u}; o[64] = (v4u){0u, 0u, 0u, 0u}; }
        else rms_row_to_bf16(lane, F.in[I_MEMP] + (size_t)(m - MPAD) * DM, F.in[I_NMEMKV], MEMN + (size_t)(m - MPAD) * DM);
    }
}

__device__ __forceinline__ f32x4 silu4(f32x4 x) {
    f32x4 r;
    r.x = x.x * __builtin_amdgcn_rcpf(1.f + __builtin_amdgcn_exp2f(-x.x * LOG2E)); r.y = x.y * __builtin_amdgcn_rcpf(1.f + __builtin_amdgcn_exp2f(-x.y * LOG2E));
    r.z = x.z * __builtin_amdgcn_rcpf(1.f + __builtin_amdgcn_exp2f(-x.z * LOG2E)); r.w = x.w * __builtin_amdgcn_rcpf(1.f + __builtin_amdgcn_exp2f(-x.w * LOG2E));
    return r;
}
__device__ __forceinline__ void st_bf16(bf16* p, float v) { *(GAS unsigned short*)p = (unsigned short)f2bf(v); }

struct EpiZ {
    static constexpr bool PERM = true, AFTER_DRAIN = false;
    bf16* Z; float* out; bf16* KRT; bf16* VRT;
    __device__ __forceinline__ void operator()(const pg8::f32x4 (&acc)[2][2][4][2], const pg8::Unit& u, int wr, int wc, int fr, int fq) const {
        const int pn = u.pn, row0 = u.pm * 256 + wr * 64 + fr, colw = wc * 32 + 8 * fq;
        if (pn < 2 || pn >= 10) {
#pragma unroll
            for (int ai = 0; ai < 2; ++ai)
#pragma unroll
                for (int m = 0; m < 4; ++m) { const int row = row0 + ai * 128 + m * 16; bf16* zp = Z + (size_t)row * DIN + pn * 256 + colw;
#pragma unroll
                    for (int bj = 0; bj < 2; ++bj) { f32x4 v0 = acc[ai][bj][m][0], v1 = acc[ai][bj][m][1];
                        if (pn < 2) { v0 = v0 * C2A; v1 = v1 * C2A; } else { v0 = silu4(v0); v1 = silu4(v1); }
                        *(GAS v4u*)(zp + bj * 128) = pack8(v0, v1); } }
        } else if (pn < 6) {
            const bool isK = pn < 4; const int cb = (pn & 1) * 256;
#pragma unroll
            for (int ai = 0; ai < 2; ++ai)
#pragma unroll
                for (int m = 0; m < 4; ++m) { const int row = row0 + ai * 128 + m * 16; bf16* zp = Z + (size_t)row * DIN + pn * 256 + colw;
                    float* dst = nullptr;
                    if (row < MP) dst = out + (isK ? OK_P : OV_P) + (size_t)row * 512; else if (row < MV) dst = out + (isK ? OK_S : OV_S) + (size_t)(row - MP) * 512;
#pragma unroll
                    for (int bj = 0; bj < 2; ++bj) { const f32x4 v0 = acc[ai][bj][m][0], v1 = acc[ai][bj][m][1]; const int c = cb + bj * 128 + colw;
                        if (dst) { *(GAS f32x4*)(dst + c) = v0; *(GAS f32x4*)(dst + c + 4) = v1; }
                        *(GAS v4u*)(zp + bj * 128) = pack8(v0, v1); } }
        } else if (pn < 8) {
            const bool isKr = pn == 7; const int j0 = 16 * (wc & 1) + 4 * fq, p0 = colw & 63;
            float invf[4];
#pragma unroll
            for (int i = 0; i < 4; ++i) invf[i] = exp2f(-(float)(j0 + i) * (13.287712379549449f / 31.0f));
            const float l2g0 = log2gamma(wc >> 1), l2g1 = log2gamma(2 + (wc >> 1));
#pragma unroll
            for (int ai = 0; ai < 2; ++ai)
#pragma unroll
                for (int m = 0; m < 4; ++m) { const int row = row0 + ai * 128 + m * 16; const int pos = row < MP ? (row & (TSEQ - 1)) : PASTLEN;
                    float cs[4], sn[4];
#pragma unroll
                    for (int i = 0; i < 4; ++i) { const float ang = (float)pos * invf[i]; double rv = (double)ang * 0.15915494309189535; rv -= floor(rv); const float rf = (float)rv;
                        sn[i] = __builtin_amdgcn_sinf(rf); cs[i] = __builtin_amdgcn_cosf(rf); }
                    const int t = row & (TSEQ - 1), b = row >> 13;
#pragma unroll
                    for (int bj = 0; bj < 2; ++bj) { const f32x4 v0 = acc[ai][bj][m][0], v1 = acc[ai][bj][m][1]; const int head = 2 * bj + (wc >> 1);
                        float y[8];
                        y[0] = v0.x * cs[0] - v0.y * sn[0]; y[1] = v0.y * cs[0] + v0.x * sn[0]; y[2] = v0.z * cs[1] - v0.w * sn[1]; y[3] = v0.w * cs[1] + v0.z * sn[1];
                        y[4] = v1.x * cs[2] - v1.y * sn[2]; y[5] = v1.y * cs[2] + v1.x * sn[2]; y[6] = v1.z * cs[3] - v1.w * sn[3]; y[7] = v1.w * cs[3] + v1.z * sn[3];
                        if (isKr) {
#pragma unroll
                            for (int e = 0; e < 8; ++e) y[e] *= 0.125f; }
                        *(GAS v4u*)(Z + (size_t)row * DIN + pn * 256 + bj * 128 + colw) = pack8((f32x4){y[0], y[1], y[2], y[3]}, (f32x4){y[4], y[5], y[6], y[7]});
                        if (isKr && row < MP) { const float dec = exp2f((float)(127 - (t & 127)) * (bj ? l2g1 : l2g0));
                            bf16* kp = KRT + ((size_t)((b * 4 + head) * 64 + p0)) * TSEQ + t;
#pragma unroll
                            for (int e = 0; e < 8; ++e) st_bf16(kp + (size_t)e * TSEQ, y[e] * dec); } } }
        } else {
#pragma unroll
            for (int ai = 0; ai < 2; ++ai)
#pragma unroll
                for (int m = 0; m < 4; ++m) { const int row = row0 + ai * 128 + m * 16; const int t = row & (TSEQ - 1), b = row >> 13;
#pragma unroll
                    for (int bj = 0; bj < 2; ++bj) { const f32x4 v0 = acc[ai][bj][m][0], v1 = acc[ai][bj][m][1]; const int head = (pn - 8) * 2 + bj;
                        *(GAS v4u*)(Z + (size_t)row * DIN + pn * 256 + bj * 128 + colw) = pack8(v0, v1);
                        if (row < MP) { bf16* vp = VRT + ((size_t)((b * 4 + head) * 128 + colw)) * TSEQ + t;
                            st_bf16(vp, v0.x); st_bf16(vp + (size_t)TSEQ, v0.y); st_bf16(vp + (size_t)2 * TSEQ, v0.z); st_bf16(vp + (size_t)3 * TSEQ, v0.w);
                            st_bf16(vp + (size_t)4 * TSEQ, v1.x); st_bf16(vp + (size_t)5 * TSEQ, v1.y); st_bf16(vp + (size_t)6 * TSEQ, v1.z); st_bf16(vp + (size_t)7 * TSEQ, v1.w); } } }
        }
    }
};
struct EpiMemKV {
    static constexpr bool PERM = true, AFTER_DRAIN = false;
    float* out; bf16* MKB; bf16* MVT;
    __device__ __forceinline__ void operator()(const pg8::f32x4 (&acc)[2][2][4][2], const pg8::Unit& u, int wr, int wc, int fr, int fq) const {
        const int pn = u.pn, row0 = u.pm * 256 + wr * 64 + fr, colw = wc * 32 + 8 * fq; const bool isK = pn < 4;
#pragma unroll
        for (int ai = 0; ai < 2; ++ai)
#pragma unroll
            for (int m = 0; m < 4; ++m) { const int row = row0 + ai * 128 + m * 16;
#pragma unroll
                for (int bj = 0; bj < 2; ++bj) { const f32x4 v0 = acc[ai][bj][m][0], v1 = acc[ai][bj][m][1]; const int c = (pn & 3) * 256 + bj * 128 + colw;
                    float* dst = out + (isK ? OMK : OMV) + (size_t)row * DM + c;
                    *(GAS f32x4*)dst = v0; *(GAS f32x4*)(dst + 4) = v1;
                    if (isK) *(GAS v4u*)(MKB + (size_t)row * DM + c) = pack8(v0, v1);
                    else { bf16* vp = MVT + (size_t)c * 512 + row;
                        st_bf16(vp, v0.x); st_bf16(vp + 512, v0.y); st_bf16(vp + 1024, v0.z); st_bf16(vp + 1536, v0.w); st_bf16(vp + 2048, v1.x); st_bf16(vp + 2560, v1.y); st_bf16(vp + 3072, v1.z); st_bf16(vp + 3584, v1.w); } } }
    }
};
struct EpiRes {
    static constexpr bool PERM = false, AFTER_DRAIN = false;
    const float* baseP; const float* baseS; float* out; bf16* outb; float* ssq;
    __device__ __forceinline__ void operator()(const pg8::f32x4 (&acc)[2][2][4][2], const pg8::Unit& u, int wr, int wc, int fr, int fq) const {
#pragma unroll
        for (int ai = 0; ai < 2; ++ai) {
            if (u.pm * 256 + ai * 128 >= MV) continue;
#pragma unroll
            for (int m = 0; m < 4; ++m) { const int row = u.pm * 256 + ai * 128 + wr * 64 + m * 16 + fr;
                const float* bp = row < MP ? baseP + (size_t)row * DM : baseS + (size_t)(row - MP) * DM; float ss = 0.f;
#pragma unroll
                for (int bj = 0; bj < 2; ++bj)
#pragma unroll
                    for (int n = 0; n < 2; ++n) { const int c = u.pn * 256 + bj * 128 + wc * 32 + n * 16 + 4 * fq;
                        const f32x4 o = *(const GAS f32x4*)(bp + c) + acc[ai][bj][m][n];
                        *(GAS f32x4*)(out + (size_t)row * DM + c) = o;
                        if (outb) { u32x2 w; w.x = pg8::cvt_pk_bf16(o.x, o.y); w.y = pg8::cvt_pk_bf16(o.z, o.w); *(GAS u32x2*)(outb + (size_t)row * DM + c) = w; }
                        ss += (o.x * o.x + o.y * o.y) + (o.z * o.z + o.w * o.w); }
                ss += __shfl_xor(ss, 16); ss += __shfl_xor(ss, 32);
                if (fq == 0) ssq[(size_t)row * 16 + u.pn * 4 + wc] = ss; }
        }
    }
};
__device__ __forceinline__ float rstd_from_ssq(const float* ssq, int row) {
    const GAS f32x4* p = (const GAS f32x4*)(ssq + (size_t)row * 16); const f32x4 a = p[0], b = p[1], c = p[2], d = p[3];
    const float s = ((a.x + a.y) + (a.z + a.w)) + ((b.x + b.y) + (b.z + b.w)) + ((c.x + c.y) + (c.z + c.w)) + ((d.x + d.y) + (d.z + d.w));
    return 1.f / sqrtf(s * (1.f / DM) + EPS);
}
template <int ACT  > struct EpiScale {
    static constexpr bool PERM = true, AFTER_DRAIN = false;
    bf16* O; int ldc; const float* ssq; float scale;
    __device__ __forceinline__ void operator()(const pg8::f32x4 (&acc)[2][2][4][2], const pg8::Unit& u, int wr, int wc, int fr, int fq) const {
        const int row0 = u.pm * 256 + wr * 64 + fr, colw = u.pn * 256 + wc * 32 + 8 * fq;
#pragma unroll
        for (int ai = 0; ai < 2; ++ai)
#pragma unroll
            for (int m = 0; m < 4; ++m) { const int row = row0 + ai * 128 + m * 16; const float rs = rstd_from_ssq(ssq, row) * scale;
#pragma unroll
                for (int bj = 0; bj < 2; ++bj) { f32x4 v0 = acc[ai][bj][m][0] * rs, v1 = acc[ai][bj][m][1] * rs;
                    if (ACT == 1) { v0.x = fmaxf(v0.x, 0.f); v0.y = fmaxf(v0.y, 0.f); v0.z = fmaxf(v0.z, 0.f); v0.w = fmaxf(v0.w, 0.f); v1.x = fmaxf(v1.x, 0.f); v1.y = fmaxf(v1.y, 0.f); v1.z = fmaxf(v1.z, 0.f); v1.w = fmaxf(v1.w, 0.f);
                        v0 = v0 * v0; v1 = v1 * v1; }
                    *(GAS v4u*)(O + (size_t)row * ldc + bj * 128 + colw) = pack8(v0, v1); } }
    }
};
struct EpiPlain {
    static constexpr bool PERM = true, AFTER_DRAIN = false;
    bf16* O; int ldc;
    __device__ __forceinline__ void operator()(const pg8::f32x4 (&acc)[2][2][4][2], const pg8::Unit& u, int wr, int wc, int fr, int fq) const {
        const int row0 = u.pm * 256 + wr * 64 + fr, colw = u.pn * 256 + wc * 32 + 8 * fq;
#pragma unroll
        for (int ai = 0; ai < 2; ++ai)
#pragma unroll
            for (int m = 0; m < 4; ++m) { const int row = row0 + ai * 128 + m * 16;
#pragma unroll
                for (int bj = 0; bj < 2; ++bj) *(GAS v4u*)(O + (size_t)row * ldc + bj * 128 + colw) = pack8(acc[ai][bj][m][0], acc[ai][bj][m][1]); }
    }
};
struct EpiSoftmax {
    static constexpr bool PERM = true, AFTER_DRAIN = true;
    bf16* O; int ldc;
    __device__ __forceinline__ void fused(pg8::f32x4 (&acc)[2][2][4][2], const pg8::Unit& u, int wr, int wc, int fr, int fq, PG8_LAS unsigned char* lds, int wid, int lane) const {
        PG8_LAS float* PMX = (PG8_LAS float*)lds;
        PG8_LAS float* PSM = (PG8_LAS float*)(lds + 4096);
#pragma unroll
        for (int ai = 0; ai < 2; ++ai)
#pragma unroll
            for (int m = 0; m < 4; ++m) { float mx = -INFINITY;
#pragma unroll
                for (int bj = 0; bj < 2; ++bj)
#pragma unroll
                    for (int n = 0; n < 2; ++n) { const pg8::f32x4 x = acc[ai][bj][m][n]; mx = fmaxf(mx, fmaxf(fmaxf(x.x, x.y), fmaxf(x.z, x.w))); }
                mx = fmaxf(mx, __shfl_xor(mx, 16)); mx = fmaxf(mx, __shfl_xor(mx, 32));
                if (fq == 0) PMX[(ai * 128 + wr * 64 + m * 16 + fr) * 4 + wc] = mx; }
        asm volatile("s_waitcnt lgkmcnt(0)" ::: "memory"); __builtin_amdgcn_s_barrier(); asm volatile("" ::: "memory");
#pragma unroll
        for (int ai = 0; ai < 2; ++ai)
#pragma unroll
            for (int m = 0; m < 4; ++m) { const int r = ai * 128 + wr * 64 + m * 16 + fr; const pg8::f32x4 q = *(const PG8_LAS pg8::f32x4*)(PMX + r * 4);
                const float mx = fmaxf(fmaxf(q.x, q.y), fmaxf(q.z, q.w)); float s = 0.f;
#pragma unroll
                for (int bj = 0; bj < 2; ++bj)
#pragma unroll
                    for (int n = 0; n < 2; ++n) { pg8::f32x4 x = acc[ai][bj][m][n];
                        x.x = __builtin_amdgcn_exp2f(x.x - mx); x.y = __builtin_amdgcn_exp2f(x.y - mx); x.z = __builtin_amdgcn_exp2f(x.z - mx); x.w = __builtin_amdgcn_exp2f(x.w - mx);
                        acc[ai][bj][m][n] = x; s += (x.x + x.y) + (x.z + x.w); }
                s += __shfl_xor(s, 16); s += __shfl_xor(s, 32);
                if (fq == 0) PSM[r * 4 + wc] = s; }
        asm volatile("s_waitcnt lgkmcnt(0)" ::: "memory"); __builtin_amdgcn_s_barrier(); asm volatile("" ::: "memory");
        const int colw = wc * 32 + 8 * fq;
#pragma unroll
        for (int ai = 0; ai < 2; ++ai)
#pragma unroll
            for (int m = 0; m < 4; ++m) { const int r = ai * 128 + wr * 64 + m * 16 + fr; const pg8::f32x4 q = *(const PG8_LAS pg8::f32x4*)(PSM + r * 4);
                const float inv = 1.f / ((q.x + q.y) + (q.z + q.w));
#pragma unroll
                for (int bj = 0; bj < 2; ++bj) *(GAS v4u*)(O + (size_t)(u.pm * 256 + r) * ldc + bj * 128 + colw) = pack8(acc[ai][bj][m][0] * inv, acc[ai][bj][m][1] * inv); }
    }
};

__device__ __forceinline__ f32x16 mfma32(bf16x8 a, bf16x8 b, f32x16 c) { return __builtin_amdgcn_mfma_f32_32x32x16_bf16(a, b, c, 0, 0, 0); }
__device__ __forceinline__ int crow16(int r, int hh) { return (r & 3) + 8 * (r >> 2) + 4 * hh; }

__device__ __forceinline__ void ret_stepA(Frame& F, int bh, int c) {
    const int tid = fresh_tid(), lane = tid & 63; (void)tid; (void)lane;
    const int w = F.wave, r = lane & 31, hh = lane >> 5, db = w >> 2, eb = w & 3;
    const bf16* ka = WSP(bf16, WS_KRT) + ((size_t)(bh * 64 + 32 * db + r)) * TSEQ + c * 128 + 8 * hh;
    const bf16* va = WSP(bf16, WS_VRT) + ((size_t)(bh * 128 + 32 * eb + r)) * TSEQ + c * 128 + 8 * hh;
    bf16x8 af[8], bfr[8];
#pragma unroll
    for (int ks = 0; ks < 8; ++ks) { af[ks] = *(const GAS bf16x8*)(ka + 16 * ks); bfr[ks] = *(const GAS bf16x8*)(va + 16 * ks); }
    f32x16 acc = {};
#pragma unroll
    for (int ks = 0; ks < 8; ++ks) acc = mfma32(af[ks], bfr[ks], acc);
    float* up = WSP(float, WS_U) + ((size_t)(bh * 64 + c) * 64 + 32 * db) * 128 + 32 * eb + r;
#pragma unroll
    for (int q = 0; q < 16; ++q) up[(size_t)crow16(q, hh) * 128] = acc[q];
}

__device__ __forceinline__ void dec_attn_unit(Frame& F, int s, int hp) {
    const int tid = fresh_tid(), lane = tid & 63; (void)tid; (void)lane;
    LAS float* sc = (LAS float*)(F.lds);
    LAS float* wm = (LAS float*)(F.lds + 36864);
    LAS float* wo = (LAS float*)(F.lds + 40960);
    const LAS float* tab = (const LAS float*)(F.lds + TAB_OFF);
    const int w = F.wave, l = lane, hsel = l >> 5, f = l & 31, g = l >> 4, h = 2 * hp + hsel, row = MP + s;
    const bf16* Z = WSP(bf16, WS_Z);
    const u32x2 qq = *(const GAS u32x2*)(Z + (size_t)row * DIN + ZQA + h * 128 + 4 * f);
    const f32x4 q4 = {bflo(qq.x), bfhi(qq.x), bflo(qq.y), bfhi(qq.y)};
    const int* pt = (const int*)F.in[I_PT] + s * 16;
    const int pg0 = __builtin_amdgcn_readfirstlane(pt[2 * w]), pg1 = __builtin_amdgcn_readfirstlane(pt[2 * w + 1]);
    LAS float* scw = sc + w * 1040;
    const LAS float* tabh = tab + h * 128;
    const float* ck = F.in[I_CK]; const float* cv = F.in[I_CV];
    for (int kk0 = 0; kk0 < 256; kk0 += 8) {
        const int page = kk0 < 128 ? pg0 : pg1; f32x4 kv[8];
#pragma unroll
        for (int i = 0; i < 8; ++i) kv[i] = *(const GAS f32x4*)(ck + ((size_t)(page * 128 + ((kk0 + i) & 127)) * 4 + 2 * hp) * 128 + 4 * l);
#pragma unroll
        for (int i = 0; i < 8; ++i) { float p = (kv[i].x * q4.x + kv[i].y * q4.y) + (kv[i].z * q4.z + kv[i].w * q4.w); p = row16_sum(p);
            const int rel = PASTLEN - (w * 256 + kk0 + i); const float bsv = tabh[rel < 127 ? rel : 127];
            if ((l & 15) == 0) scw[(kk0 + i) * 4 + g] = p + bsv; }
    }
    const int nk = (w == 0) ? 257 : 256;
    if (w == 0) { const f32x4 kn = *(const GAS f32x4*)(F.out + OK_S + (size_t)s * 512 + h * 128 + 4 * f);
        float p = (kn.x * q4.x + kn.y * q4.y) + (kn.z * q4.z + kn.w * q4.w); p = row16_sum(p);
        if ((l & 15) == 0) scw[256 * 4 + g] = p + tabh[0]; }
    LDS_WAIT(); asm volatile("" ::: "memory");
    float mg0, mg1, mg2, mg3, lg0, lg1, lg2, lg3;
    { float m0 = -INFINITY, m1 = -INFINITY, m2 = -INFINITY, m3 = -INFINITY;
      for (int kk = l; kk < nk; kk += 64) { const f32x4 v = *(const LAS f32x4*)(scw + kk * 4); m0 = fmaxf(m0, v.x); m1 = fmaxf(m1, v.y); m2 = fmaxf(m2, v.z); m3 = fmaxf(m3, v.w); }
      mg0 = wave_max(m0); mg1 = wave_max(m1); mg2 = wave_max(m2); mg3 = wave_max(m3);
      float s0 = 0.f, s1 = 0.f, s2 = 0.f, s3 = 0.f;
      for (int kk = l; kk < nk; kk += 64) { f32x4 v = *(const LAS f32x4*)(scw + kk * 4);
          v.x = __builtin_amdgcn_exp2f(v.x - mg0); v.y = __builtin_amdgcn_exp2f(v.y - mg1); v.z = __builtin_amdgcn_exp2f(v.z - mg2); v.w = __builtin_amdgcn_exp2f(v.w - mg3);
          *(LAS f32x4*)(scw + kk * 4) = v; s0 += v.x; s1 += v.y; s2 += v.z; s3 += v.w; }
      lg0 = wave_sum(s0); lg1 = wave_sum(s1); lg2 = wave_sum(s2); lg3 = wave_sum(s3); }
    LDS_WAIT(); asm volatile("" ::: "memory");
    f32x4 o1 = {0.f, 0.f, 0.f, 0.f}, o2 = {0.f, 0.f, 0.f, 0.f};
    for (int kk0 = 0; kk0 < 256; kk0 += 8) {
        const int page = kk0 < 128 ? pg0 : pg1; f32x4 vv[8];
#pragma unroll
        for (int i = 0; i < 8; ++i) vv[i] = *(const GAS f32x4*)(cv + ((size_t)(page * 128 + ((kk0 + i) & 127)) * 4 + 2 * hp) * 128 + 4 * l);
#pragma unroll
        for (int i = 0; i < 8; ++i) { const float p1 = scw[(kk0 + i) * 4 + hsel * 2], p2 = scw[(kk0 + i) * 4 + hsel * 2 + 1]; o1 = o1 + vv[i] * p1; o2 = o2 + vv[i] * p2; }
    }
    if (w == 0) { const f32x4 vn = *(const GAS f32x4*)(F.out + OV_S + (size_t)s * 512 + h * 128 + 4 * f);
        const float p1 = scw[256 * 4 + hsel * 2], p2 = scw[256 * 4 + hsel * 2 + 1]; o1 = o1 + vn * p1; o2 = o2 + vn * p2; }
    if (l < 4) { const float mv = l == 0 ? mg0 : l == 1 ? mg1 : l == 2 ? mg2 : mg3, lv = l == 0 ? lg0 : l == 1 ? lg1 : l == 2 ? lg2 : lg3; wm[w * 4 + l] = mv; wm[32 + w * 4 + l] = lv; }
    *(LAS f32x4*)(wo + ((w * 2 + 0) * 64 + l) * 4) = o1; *(LAS f32x4*)(wo + ((w * 2 + 1) * 64 + l) * 4) = o2;
    LDS_WAIT(); __syncthreads();
    if (tid < 128) { const int map = tid >> 6, ll = tid & 63, gg = (ll >> 5) * 2 + map;
        float M = -INFINITY;
#pragma unroll
        for (int ww = 0; ww < 8; ++ww) M = fmaxf(M, wm[ww * 4 + gg]);
        float L = 0.f; f32x4 o = {0.f, 0.f, 0.f, 0.f};
#pragma unroll
        for (int ww = 0; ww < 8; ++ww) { const float e = __builtin_amdgcn_exp2f(wm[ww * 4 + gg] - M); L += wm[32 + ww * 4 + gg] * e; o = o + *(const LAS f32x4*)(wo + ((ww * 2 + map) * 64 + ll) * 4) * e; }
        const float inv = 1.f / L; u32x2 ov; ov.x = pk2(o.x * inv, o.y * inv); ov.y = pk2(o.z * inv, o.w * inv);
        *(GAS u32x2*)(WSP(bf16, WS_OA) + (size_t)row * DM + map * 512 + (2 * hp + (ll >> 5)) * 128 + 4 * (ll & 31)) = ov; }
    LDS_WAIT(); __syncthreads();
}

__device__ __forceinline__ void dec_ret_unit(Frame& F, int s, int h) {
    const int tid = fresh_tid(), lane = tid & 63; (void)tid; (void)lane;
    LAS float* part = (LAS float*)(F.lds);
    LAS float* half = (LAS float*)(F.lds + 2048);
    const int e = tid & 127, dg = tid >> 7, row = MP + s;
    const bf16* Zr = WSP(bf16, WS_Z) + (size_t)row * DIN;
    const float gam = 1.0f - exp2f(-(float)(5 + h));
    const float v = bf2f(Zr[ZVR + h * 128 + e]);
    const float* Sin = F.in[I_SRET] + ((size_t)(s * 4 + h) * 64) * 128 + e; float* Sout = F.out + OS_S + ((size_t)(s * 4 + h) * 64) * 128 + e;
    float op = 0.f;
#pragma unroll 4
    for (int i = 0; i < 16; ++i) { const int d = dg * 16 + i, p = 2 * (d & 31) + (d >> 5);
        const float kq = bf2f(Zr[ZKR + h * 64 + p]), qq = bf2f(Zr[ZQR + h * 64 + p]);
        const float sn = gam * Sin[(size_t)d * 128] + kq * v; Sout[(size_t)d * 128] = sn; op += qq * sn; }
    part[dg * 128 + e] = op;
    LDS_WAIT(); __syncthreads();
    float o = 0.f;
    if (tid < 128) { o = (part[e] + part[128 + e]) + (part[256 + e] + part[384 + e]); const float ss = wave_sum(o * o); if (lane == 0) half[F.wave] = ss; }
    LDS_WAIT(); __syncthreads();
    if (tid < 128) { const float rs = 1.f / sqrtf((half[0] + half[1]) * (1.f / 128.f) + EPS);
        st_bf16(WSP(bf16, WS_MIX) + (size_t)row * DM + 512 + h * 128 + e, o * rs * bf2f(Zr[ZGR + h * 128 + e])); }
    LDS_WAIT(); __syncthreads();
}

__device__ __forceinline__ void ret_scan(Frame& F, int wgi) {
    const int tid = fresh_tid(), lane = tid & 63; (void)tid; (void)lane;
    const int bh = wgi >> 4, p = (wgi & 15) * 4 + (tid >> 7), e = tid & 127, h = bh & 3;
    const float g = exp2f(128.f * log2gamma(h));
    const float* up = WSP(float, WS_U) + ((size_t)(bh * 64) * 64 + p) * 128 + e;
    bf16* sp = WSP(bf16, WS_SPT) + ((size_t)(bh * 64) * 128 + e) * 64 + p;
    float st = 0.f;
    for (int c0 = 0; c0 < 64; c0 += 8) { float uu[8];
#pragma unroll
        for (int i = 0; i < 8; ++i) uu[i] = up[(size_t)(c0 + i) * 8192];
#pragma unroll
        for (int i = 0; i < 8; ++i) { st_bf16(sp + (size_t)(c0 + i) * 8192, st); st = g * st + uu[i]; } }
    const int dn = (p >> 1) + 32 * (p & 1);
    F.out[OS_P + ((size_t)(bh * 64 + dn)) * 128 + e] = st;
}
__device__ __forceinline__ void merge_a_rows(Frame& F) {
    const int tid = fresh_tid(), lane = tid & 63; (void)tid; (void)lane;
    const int gw = F.vcu * NWAVES + F.wave, NGW = F.G * NWAVES, l = lane;
    const float lam = lam_value(F, lane);
    const f32x4 g0 = *(const GAS f32x4*)(F.in[I_SUBLN] + (8 * l & 127)), g1 = *(const GAS f32x4*)(F.in[I_SUBLN] + (8 * l & 127) + 4);
    const bf16* OA = WSP(bf16, WS_OA); bf16* MIX = WSP(bf16, WS_MIX);
    for (int m = gw; m < MV; m += NGW) {
        const v4u a = *(const GAS v4u*)(OA + (size_t)m * DM + 8 * l), b = *(const GAS v4u*)(OA + (size_t)m * DM + 512 + 8 * l);
        float x[8];
        x[0] = bflo(a.x) - lam * bflo(b.x); x[1] = bfhi(a.x) - lam * bfhi(b.x); x[2] = bflo(a.y) - lam * bflo(b.y); x[3] = bfhi(a.y) - lam * bfhi(b.y);
        x[4] = bflo(a.z) - lam * bflo(b.z); x[5] = bfhi(a.z) - lam * bfhi(b.z); x[6] = bflo(a.w) - lam * bflo(b.w); x[7] = bfhi(a.w) - lam * bfhi(b.w);
        float ss = 0.f;
#pragma unroll
        for (int i = 0; i < 8; ++i) ss += x[i] * x[i];
        ss = row16_sum(ss);
        const float rs = ONE_M_LAMINIT / sqrtf(ss * (1.f / 128.f) + EPS);
        v4u o; o.x = pk2(x[0] * rs * g0.x, x[1] * rs * g0.y); o.y = pk2(x[2] * rs * g0.z, x[3] * rs * g0.w); o.z = pk2(x[4] * rs * g1.x, x[5] * rs * g1.y); o.w = pk2(x[6] * rs * g1.z, x[7] * rs * g1.w);
        *(GAS v4u*)(MIX + (size_t)m * DM + 8 * l) = o;
    }
}

__device__ __forceinline__ void ret_stepC(Frame& F, int bh, int c) {
    const int tid = fresh_tid(), lane = tid & 63; (void)tid; (void)lane;
    LAS float* psum = (LAS float*)(F.lds);
    const int w = F.wave, r = lane & 31, hh = lane >> 5, rb = w >> 1, ch = w & 1, b = bh >> 2, h = bh & 3;
    const size_t row0 = (size_t)b * TSEQ + c * 128;
    const bf16* Z = WSP(bf16, WS_Z);
    const float l2g = log2gamma(h);
    bf16x8 qf[4];
#pragma unroll
    for (int ks = 0; ks < 4; ++ks) qf[ks] = *(const GAS bf16x8*)(Z + (row0 + 32 * rb + r) * DIN + ZQR + h * 64 + 16 * ks + 8 * hh);
    f32x16 o[2], oc[2];
    o[0] = (f32x16){}; o[1] = (f32x16){}; oc[0] = (f32x16){}; oc[1] = (f32x16){};
    const bf16* spt = WSP(bf16, WS_SPT) + ((size_t)(bh * 64 + c) * 128 + 64 * ch + r) * 64 + 8 * hh;
#pragma unroll
    for (int eb = 0; eb < 2; ++eb)
#pragma unroll
        for (int ks = 0; ks < 4; ++ks) { const bf16x8 sb = *(const GAS bf16x8*)(spt + (size_t)(32 * eb) * 64 + 16 * ks); oc[eb] = mfma32(qf[ks], sb, oc[eb]); }
    const bf16* vt = WSP(bf16, WS_VRT) + ((size_t)(bh * 128 + 64 * ch + r)) * TSEQ + c * 128 + 4 * hh;
    for (int jb = 0; jb <= rb; ++jb) {
        f32x16 st = {};
#pragma unroll
        for (int ks = 0; ks < 4; ++ks) { const bf16x8 kf = *(const GAS bf16x8*)(Z + (row0 + 32 * jb + r) * DIN + ZKR + h * 64 + 16 * ks + 8 * hh); st = mfma32(kf, qf[ks], st); }
        const int irel = 32 * (rb - jb) + r;
#pragma unroll
        for (int q = 0; q < 16; ++q) { const int d = irel - crow16(q, hh); st[q] = d >= 0 ? st[q] * exp2f((float)d * l2g) : 0.f; }
#pragma unroll
        for (int s2 = 0; s2 < 2; ++s2) {
            v4u pw; pw.x = pg8::cvt_pk_bf16(st[8 * s2 + 0], st[8 * s2 + 1]); pw.y = pg8::cvt_pk_bf16(st[8 * s2 + 2], st[8 * s2 + 3]); pw.z = pg8::cvt_pk_bf16(st[8 * s2 + 4], st[8 * s2 + 5]); pw.w = pg8::cvt_pk_bf16(st[8 * s2 + 6], st[8 * s2 + 7]);
            const bf16x8 pa = __builtin_bit_cast(bf16x8, pw);
#pragma unroll
            for (int eb = 0; eb < 2; ++eb) { const bf16* vp = vt + (size_t)(32 * eb) * TSEQ + 32 * jb + 16 * s2;
                const u32x2 lo = *(const GAS u32x2*)vp, hi2 = *(const GAS u32x2*)(vp + 8);
                v4u vb; vb.x = lo.x; vb.y = lo.y; vb.z = hi2.x; vb.w = hi2.y;
                o[eb] = mfma32(pa, __builtin_bit_cast(bf16x8, vb), o[eb]); }
        }
    }
    float ssr[16];
#pragma unroll
    for (int q = 0; q < 16; ++q) { const float sc = exp2f((float)(32 * rb + crow16(q, hh) + 1) * l2g);
        o[0][q] += sc * oc[0][q]; o[1][q] += sc * oc[1][q];
        float ss = o[0][q] * o[0][q] + o[1][q] * o[1][q]; ss = row16_sum(ss); ss += __shfl_xor(ss, 16); ssr[q] = ss; }
    if (r == 0) {
#pragma unroll
        for (int q = 0; q < 16; ++q) psum[ch * 128 + 32 * rb + crow16(q, hh)] = ssr[q]; }
    LDS_WAIT(); __syncthreads();
    bf16* MIX = WSP(bf16, WS_MIX);
#pragma unroll
    for (int q = 0; q < 16; ++q) { const int i = 32 * rb + crow16(q, hh); const float rs = 1.f / sqrtf((psum[i] + psum[128 + i]) * (1.f / 128.f) + EPS);
#pragma unroll
        for (int eb = 0; eb < 2; ++eb) { const int e = 64 * ch + 32 * eb + r; const float gt = bf2f(Z[(row0 + i) * DIN + ZGR + h * 128 + e]);
            st_bf16(MIX + (row0 + i) * DM + 512 + h * 128 + e, o[eb][q] * rs * gt); } }
    LDS_WAIT(); __syncthreads();
}

__device__ __forceinline__ void dec_mem_unit(Frame& F, int s, int hp) {
    const int tid = fresh_tid(), lane = tid & 63; (void)tid; (void)lane;
    LAS float* sc = (LAS float*)(F.lds);
    LAS float* wo = (LAS float*)(F.lds + 4096);
    const int w = F.wave, l = lane, row = MP + s;
    const bf16* QM = WSP(bf16, WS_QM);
    f32x4 q4[2];
#pragma unroll
    for (int hs = 0; hs < 2; ++hs) { const u32x2 qq = *(const GAS u32x2*)(QM + (size_t)row * DM + (2 * hp + hs) * 256 + 4 * l); q4[hs] = (f32x4){bflo(qq.x), bfhi(qq.x), bflo(qq.y), bfhi(qq.y)}; }
    const float* ck = F.in[I_CMK] + ((size_t)s * NMEM * 4 + 2 * hp) * 256 + 4 * l; const float* cv = F.in[I_CMV] + ((size_t)s * NMEM * 4 + 2 * hp) * 256 + 4 * l;
    for (int m0 = 0; m0 < 32; m0 += 4) { f32x4 kv[8];
#pragma unroll
        for (int i = 0; i < 8; ++i) kv[i] = *(const GAS f32x4*)(ck + (size_t)(32 * w + m0 + (i >> 1)) * 1024 + (i & 1) * 256);
#pragma unroll
        for (int i = 0; i < 8; ++i) { const f32x4 q = q4[i & 1]; float p = (kv[i].x * q.x + kv[i].y * q.y) + (kv[i].z * q.z + kv[i].w * q.w); p = wave_sum(p);
            if (l == 0) sc[(i & 1) * 256 + 32 * w + m0 + (i >> 1)] = p; } }
    LDS_WAIT(); __syncthreads();
    float M[2], IL[2];
#pragma unroll
    for (int hs = 0; hs < 2; ++hs) { const f32x4 v = *(const LAS f32x4*)(sc + hs * 256 + 4 * l); const float mx = wave_max(fmaxf(fmaxf(v.x, v.y), fmaxf(v.z, v.w)));
        const float sm = (__builtin_amdgcn_exp2f(v.x - mx) + __builtin_amdgcn_exp2f(v.y - mx)) + (__builtin_amdgcn_exp2f(v.z - mx) + __builtin_amdgcn_exp2f(v.w - mx));
        M[hs] = mx; IL[hs] = 1.f / wave_sum(sm); }
    f32x4 o[2]; o[0] = (f32x4){0.f, 0.f, 0.f, 0.f}; o[1] = (f32x4){0.f, 0.f, 0.f, 0.f};
    for (int m0 = 0; m0 < 32; m0 += 4) { f32x4 vv[8];
#pragma unroll
        for (int i = 0; i < 8; ++i) vv[i] = *(const GAS f32x4*)(cv + (size_t)(32 * w + m0 + (i >> 1)) * 1024 + (i & 1) * 256);
#pragma unroll
        for (int i = 0; i < 8; ++i) { const int hs = i & 1; const float p = __builtin_amdgcn_exp2f(sc[hs * 256 + 32 * w + m0 + (i >> 1)] - M[hs]) * IL[hs]; o[hs] = o[hs] + vv[i] * p; } }
    *(LAS f32x4*)(wo + ((w * 2 + 0) * 64 + l) * 4) = o[0]; *(LAS f32x4*)(wo + ((w * 2 + 1) * 64 + l) * 4) = o[1];
    LDS_WAIT(); __syncthreads();
    if (tid < 128) { const int hs = tid >> 6, ll = tid & 63; f32x4 a = {0.f, 0.f, 0.f, 0.f};
#pragma unroll
        for (int ww = 0; ww < 8; ++ww) a = a + *(const LAS f32x4*)(wo + ((ww * 2 + hs) * 64 + ll) * 4);
        u32x2 ov; ov.x = pk2(a.x, a.y); ov.y = pk2(a.z, a.w);
        *(GAS u32x2*)(WSP(bf16, WS_OM) + (size_t)row * DM + (2 * hp + hs) * 256 + 4 * ll) = ov; }
    LDS_WAIT(); __syncthreads();
}

__device__ __forceinline__ void final_norm_rows(Frame& F) {
    const int tid = fresh_tid(), lane = tid & 63; (void)tid; (void)lane;
    const int gw = F.vcu * NWAVES + F.wave, NGW = F.G * NWAVES, l = lane;
    const float* X3 = WSP(float, WS_X3); const float* ssq = WSP(float, WS_SSQ3);
    for (int m = gw; m < MV; m += NGW) {
        const float s = row16_sum(ssq[(size_t)m * 16 + (l & 15)]); const float rs = 1.f / sqrtf(s * (1.f / DM) + EPS);
        float* dst = m < MP ? F.out + OY_P + (size_t)m * DM : F.out + OY_S + (size_t)(m - MP) * DM;
#pragma unroll
        for (int j = 0; j < 4; ++j) { const f32x4 x = *(const GAS f32x4*)(X3 + (size_t)m * DM + 256 * j + 4 * l), g = *(const GAS f32x4*)(F.in[I_NFIN] + 256 * j + 4 * l);
            *(GAS f32x4*)(dst + 256 * j + 4 * l) = x * rs * g; }
    }
}

#ifndef PG8_SP2
#define PG8_SP2 true
#endif
#ifndef PG8_ALIGN
#define PG8_ALIGN true
#endif
struct Args { const float* in[N_IN]; float* out; unsigned char* ws; int ph_lo, ph_hi; };
__global__ void __launch_bounds__(NWAVES * 64, 2) fwd(Args args) {
    extern __shared__ __attribute__((aligned(16))) unsigned char lds[];
    Frame F;
    F.lds = (LAS unsigned char*)lds;
    F.MISC = (volatile LAS unsigned*)(F.lds + MISC_OFF);
    const int tid0 = threadIdx.x; F.wave = __builtin_amdgcn_readfirstlane(tid0 >> 6);
    F.G = gridDim.x; { const int bx = blockIdx.x; F.vcu = (F.G % 8 == 0) ? (bx % 8) * (F.G / 8) + bx / 8 : bx; }
    F.in = args.in; F.out = args.out; F.ws = args.ws;
    F.ctl = (gu32*)(args.ws + WS_CTL);
    for (int u = tid0; u < (TAB_OFF - LDSCTL_OFF) / 4; u += NWAVES * 64) ((LAS unsigned*)(F.lds + LDSCTL_OFF))[u] = 0u;
    { const int h = tid0 >> 7, rel = tid0 & 127; const float* rb = args.in[I_RELB];
      ((LAS float*)(F.lds + TAB_OFF))[tid0] = (rb[t5_bucket(rel) * 4 + h] - rb[31 * 4 + h]) * LOG2E; }
    __syncthreads();
#if MK_PER_PHASE
#define GRID_BAR() do { } while (0)
#else
    XcdBarrier bar = xcd_barrier_post((unsigned*)(F.ctl + CW_BAR), F.MISC + 8);
#define GRID_BAR() xcd_barrier(bar)
#endif
    const int lo = args.ph_lo, hi = args.ph_hi, bx = blockIdx.x;
#define IN(k) (lo <= (k) && (k) < hi)
#define BOTH(k) (IN(k) && IN((k) + 1))
    bf16* const Zb = WSP(bf16, WS_Z);

    if (IN(0)) { p0_prologue(F); if (BOTH(0)) GRID_BAR(); }

    if (IN(1)) {
        { pg8::Gemm g{WSP(bf16, WS_XN), WSP(bf16, WS_WIN), MPAD, DIN, DM, DM, DM}; pg8::StaticOrder S; S.init(MPAD, DIN, F.G, bx);
          EpiZ E{Zb, F.out, WSP(bf16, WS_KRT), WSP(bf16, WS_VRT)};
          pg8::gemm_phase<EpiZ, pg8::StaticOrder, PG8_ALIGN, PG8_SP2>(F.lds + RING_OFF, g, S, E); }
        { pg8::Gemm g{WSP(bf16, WS_MEMN), WSP(bf16, WS_WMKV), 2 * NMEM, 2 * DM, DM, DM, DM}; pg8::StaticOrder S; S.init(2 * NMEM, 2 * DM, F.G, (bx + 16) % F.G);
          EpiMemKV E{F.out, WSP(bf16, WS_MKB), WSP(bf16, WS_MVT)};
          pg8::gemm_phase<EpiMemKV, pg8::StaticOrder, PG8_ALIGN, PG8_SP2>(F.lds + RING_OFF, g, S, E); }
        if (BOTH(1)) GRID_BAR();
    }

    if (IN(2)) {
        const attn_body::StaticOrder S((int)F.G, bx); const int slot = F.vcu % 5;
        { attn_body::AttnUnit au;
          for (int i = 0; i < slot && S.next(i, au); ++i) attn_body::attn_one<8>((char*)lds + RING_OFF, (const attn_body::bf16*)Zb, (attn_body::bf16*)WSP(bf16, WS_OA), (attn_body::lds_cfp)(F.lds + TAB_OFF), au); }
        __syncthreads();
        for (int u = bx; u < 512; u += F.G) ret_stepA(F, u >> 6, u & 63);
        for (int u = bx; u < 256; u += F.G) dec_attn_unit(F, u >> 1, u & 1);
        for (int u = bx; u < 512; u += F.G) dec_ret_unit(F, u >> 2, u & 3);
        { attn_body::AttnUnit au;
          for (int i = slot; S.next(i, au); ++i) attn_body::attn_one<8>((char*)lds + RING_OFF, (const attn_body::bf16*)Zb, (attn_body::bf16*)WSP(bf16, WS_OA), (attn_body::lds_cfp)(F.lds + TAB_OFF), au); }
        if (BOTH(2)) GRID_BAR();
    }

    if (IN(3)) { if (bx < 128) ret_scan(F, bx); merge_a_rows(F); if (BOTH(3)) GRID_BAR(); }

    if (IN(4)) { for (int u = bx; u < 512; u += F.G) ret_stepC(F, u >> 6, u & 63); if (BOTH(4)) GRID_BAR(); }

    if (IN(5)) {
        pg8::Gemm g{WSP(bf16, WS_MIX), WSP(bf16, WS_WOUT), MPAD, DM, DM, DM, DM}; pg8::StaticOrder S; S.init(MPAD, DM, F.G, bx);
        EpiRes E{args.in[I_XP], args.in[I_XS], WSP(float, WS_X1), WSP(bf16, WS_X1B), WSP(float, WS_SSQ1)};
        pg8::gemm_phase<EpiRes, pg8::StaticOrder, PG8_ALIGN, PG8_SP2>(F.lds + RING_OFF, g, S, E);
        if (BOTH(5)) GRID_BAR();
    }

    if (IN(6)) {
        pg8::Gemm g{WSP(bf16, WS_X1B), WSP(bf16, WS_WMQ), MPAD, DM, DM, DM, DM}; pg8::StaticOrder S; S.init(MPAD, DM, F.G, bx);
        EpiScale<0> E{WSP(bf16, WS_QM), DM, WSP(float, WS_SSQ1), C2M};
        pg8::gemm_phase<EpiScale<0>, pg8::StaticOrder, PG8_ALIGN, PG8_SP2>(F.lds + RING_OFF, g, S, E);
        if (BOTH(6)) GRID_BAR();
    }

    if (IN(7)) {
        if (bx < 256) {
            const int panel = bx >> 2, h = bx & 3, b = panel >> 5;
            { pg8::Gemm g{WSP(bf16, WS_QM) + h * 256, WSP(bf16, WS_MKB) + (size_t)b * NMEM * DM + h * 256, MP, 256, 256, DM, DM}; pg8::OneUnit S{{panel, 0}, true};
              EpiSoftmax E{WSP(bf16, WS_PM) + h * 256, DM};
              pg8::gemm_phase<EpiSoftmax, pg8::OneUnit, false, PG8_SP2>(F.lds + RING_OFF, g, S, E); }
            VM_WAIT(); __syncthreads();
            { pg8::Gemm g{WSP(bf16, WS_PM) + h * 256, WSP(bf16, WS_MVT) + (size_t)h * 256 * 512 + b * NMEM, MP, 256, 256, DM, 512}; pg8::OneUnit S{{panel, 0}, true};
              EpiPlain E{WSP(bf16, WS_OM) + h * 256, DM};
              pg8::gemm_phase<EpiPlain, pg8::OneUnit, false, PG8_SP2>(F.lds + RING_OFF, g, S, E); }
            __syncthreads();
            dec_mem_unit(F, bx >> 1, bx & 1);
        }
        if (BOTH(7)) GRID_BAR();
    }

    if (IN(8)) {
        pg8::Gemm g{WSP(bf16, WS_OM), WSP(bf16, WS_WMO), MPAD, DM, DM, DM, DM}; pg8::StaticOrder S; S.init(MPAD, DM, F.G, bx);
        EpiRes E{WSP(float, WS_X1), WSP(float, WS_X1) + (size_t)MP * DM, WSP(float, WS_X2), WSP(bf16, WS_X2B), WSP(float, WS_SSQ2)};
        pg8::gemm_phase<EpiRes, pg8::StaticOrder, PG8_ALIGN, PG8_SP2>(F.lds + RING_OFF, g, S, E);
        if (BOTH(8)) GRID_BAR();
    }

    if (IN(9)) {
        pg8::Gemm g{WSP(bf16, WS_X2B), WSP(bf16, WS_WUP), MPAD, FF, DM, DM, DM}; pg8::StaticOrder S; S.init(MPAD, FF, F.G, bx);
        EpiScale<1> E{WSP(bf16, WS_H), FF, WSP(float, WS_SSQ2), 1.0f};
        pg8::gemm_phase<EpiScale<1>, pg8::StaticOrder, PG8_ALIGN, PG8_SP2>(F.lds + RING_OFF, g, S, E);
        if (BOTH(9)) GRID_BAR();
    }

    if (IN(10)) {
        pg8::Gemm g{WSP(bf16, WS_H), WSP(bf16, WS_WDN), MPAD, DM, FF, FF, FF}; pg8::StaticOrder S; S.init(MPAD, DM, F.G, bx);
        EpiRes E{WSP(float, WS_X2), WSP(float, WS_X2) + (size_t)MP * DM, WSP(float, WS_X3), nullptr, WSP(float, WS_SSQ3)};
        pg8::gemm_phase<EpiRes, pg8::StaticOrder, PG8_ALIGN, PG8_SP2>(F.lds + RING_OFF, g, S, E);
        if (BOTH(10)) GRID_BAR();
    }

    if (IN(11)) final_norm_rows(F);
#undef IN
#undef BOTH
}

extern "C" void kernel_launch(void* const* d_in, const int* in_sizes, int n_in, void* d_out, int out_size, void* d_ws, size_t ws_size, hipStream_t stream) {
    static int grid = 0;
    if (grid == 0) {
        if (n_in != N_IN || in_sizes[0] != MP * DM || (size_t)out_size != OUT_TOTAL || ws_size < WS_END) { fprintf(stderr, "kernel_launch: unexpected shapes (n_in %d, in0 %d, out %d, ws %zu); nothing launched\n", n_in, n_in > 0 ? in_sizes[0] : -1, out_size, ws_size); grid = -1; return; }
        int dev = 0, cus = 0, per_cu = 0;
        if (hipGetDevice(&dev) != hipSuccess || hipDeviceGetAttribute(&cus, hipDeviceAttributeMultiprocessorCount, dev) != hipSuccess) { fprintf(stderr, "kernel_launch: device query failed\n"); grid = -1; return; }
        if (hipFuncSetAttribute((const void*)fwd, hipFuncAttributeMaxDynamicSharedMemorySize, LDS_BYTES) != hipSuccess) { fprintf(stderr, "kernel_launch: hipFuncSetAttribute failed\n"); grid = -1; return; }
        if (hipOccupancyMaxActiveBlocksPerMultiprocessor(&per_cu, (const void*)fwd, NWAVES * 64, LDS_BYTES) != hipSuccess || per_cu < 1)
            fprintf(stderr, "kernel_launch: note: occupancy query reports %d workgroups per CU\n", per_cu);
        (void)hipGetLastError();
        grid = cus;
        if (grid != 256) fprintf(stderr, "kernel_launch: this kernel's static work split expects 256 CUs, found %d\n", grid);
    }
    if (grid < 0) return;
    if (hipMemsetAsync((char*)d_ws + WS_CTL, 0, CTL_ZERO_BYTES, stream) != hipSuccess) { fprintf(stderr, "kernel_launch: memset failed\n"); return; }
    Args a{};
    for (int i = 0; i < N_IN; ++i) a.in[i] = (const float*)d_in[i];
    a.out = (float*)d_out; a.ws = (unsigned char*)d_ws;
#if MK_PER_PHASE
    for (int p = 0; p < NPH; ++p) { a.ph_lo = p; a.ph_hi = p + 1; hipLaunchKernelGGL(fwd, dim3(grid), dim3(NWAVES * 64), LDS_BYTES, stream, a); }
#else
    a.ph_lo = 0; a.ph_hi = NPH; hipLaunchKernelGGL(fwd, dim3(grid), dim3(NWAVES * 64), LDS_BYTES, stream, a);
#endif
    const hipError_t le = hipPeekAtLastError();
    if (le != hipSuccess) fprintf(stderr, "kernel_launch: launch failed: %s\n", hipGetErrorName(le));
}
```

```cpp
#include <hip/hip_runtime.h>
#include <hip/hip_bf16.h>
#include <cstdio>
#include <cstdint>
#include <cmath>
#ifndef MK_PER_PHASE
#define MK_PER_PHASE 0
#endif
namespace pg8 {
#define PG8_LAS __attribute__((address_space(3)))
typedef unsigned short bf16_t;
typedef short bf16x8 __attribute__((ext_vector_type(8)));
typedef float f32x4 __attribute__((ext_vector_type(4)));
typedef unsigned u32x4 __attribute__((ext_vector_type(4)));
constexpr int BM = 256, BK = 64, HALF = 128, HTB = HALF * BK * 2  , STAGE_BYTES = 8 * HTB, NXCD = 8, WGM = 8;

__host__ __device__ __forceinline__ int lds_byte(int r, int c) { const int st = (r >> 4) * 2 + (c >> 5), rr = r & 15, cc = c & 31, ob = rr * 64 + cc * 2; return st * 1024 + (ob ^ (((ob >> 9) & 1) << 5)); }
__host__ __device__ __forceinline__ void stage_rc(int b, int& R, int& C) { const int st = b / 1024, sb = b % 1024, swz = sb ^ (((sb >> 9) & 1) << 5); R = (st >> 1) * 16 + swz / 64; C = (st & 1) * 32 + (swz % 64) / 2; }
__host__ __device__ __forceinline__ int perm32(int rho) { const int n = rho >> 4, i = rho & 15; return 8 * (i >> 2) + 4 * n + (i & 3); }

struct Unit { int pm, pn; };
struct Gemm { const bf16_t* A; const bf16_t* Bt; int M, N, K, lda, ldb; };

struct StaticOrder {
    int nM, nN, nwg, G, c;
    __host__ __device__ void init(int M, int N, int G_, int c_) { nM = M / BM; nN = N / BM; nwg = nM * nN; G = G_; c = c_; }
    __host__ __device__ bool next(int i, Unit& u) const {
        const long L = (long)i * G + c; if (L >= nwg) return false;
        int wgid = (int)L; { const int q = nwg / NXCD, r = nwg % NXCD, xcd = wgid % NXCD, off = wgid / NXCD; wgid = (xcd < r ? xcd * (q + 1) : r * (q + 1) + (xcd - r) * q) + off; }
        const int nig = WGM * nN, gid = wgid / nig, fm = gid * WGM, gsz = (nM - fm) < WGM ? (nM - fm) : WGM;
        u.pm = fm + ((wgid % nig) % gsz); u.pn = (wgid % nig) / gsz; return true;
    }
    __device__ __forceinline__ void a_ready(const Unit&) const {}
    __device__ __forceinline__ void done(const Unit&) const {}
};
struct OneUnit {
    Unit u0; bool has;
    __device__ __forceinline__ bool next(int i, Unit& u) const { if (i != 0 || !has) return false; u = u0; return true; }
    __device__ __forceinline__ void a_ready(const Unit&) const {}
    __device__ __forceinline__ void done(const Unit&) const {}
};
__device__ __forceinline__ unsigned cvt_pk_bf16(float lo, float hi) { unsigned r; asm volatile("v_cvt_pk_bf16_f32 %0, %1, %2" : "=v"(r) : "v"(lo), "v"(hi)); return r; }
template <class Epi, class Sched, bool ALIGN_EPI = false, bool SP2 = false>
__device__ __forceinline__ void gemm_phase(PG8_LAS unsigned char* lds, const Gemm g, const Sched& S, const Epi& E) {
    int tid_ = threadIdx.x; asm volatile("" : "+v"(tid_));
    const int tid = tid_, wid = __builtin_amdgcn_readfirstlane(tid >> 6), lane = tid & 63, wr = wid >> 2, wc = wid & 3, fr = lane & 15, fq = lane >> 4;
    const int K = g.K, nt = K / BK;
    unsigned voffA[2], voffB[2];
#pragma unroll
    for (int i = 0; i < 2; ++i) { int R, C; stage_rc(tid * 16 + i * 8192, R, C); const int Rb = Epi::PERM ? ((R & ~31) + perm32(R & 31)) : R;
        voffA[i] = (unsigned)(R * g.lda + C) * 2u; voffB[i] = (unsigned)(Rb * g.ldb + C) * 2u; }
    const size_t kstep = (size_t)(BK * 2);
    const size_t hstepA = (size_t)HALF * g.lda * 2, hstepB = (size_t)HALF * g.ldb * 2;
    const size_t tstepA = 2 * hstepA, tstepB = 2 * hstepB;
    const unsigned ldsw = (unsigned)wid * 1024u;
    const int aoff = lds_byte(wr * 64 + fr, fq * 8), boff = lds_byte(wc * 32 + fr, fq * 8);
#define PG8_SA(b, h) (((b) * 2 + (h)) * HTB)
#define PG8_SB(b, h) ((4 + (b) * 2 + (h)) * HTB)
#define PG8_STAGE(bufoff, gbase, voff) do { _Pragma("unroll") for (int _i = 0; _i < 2; ++_i) \
        __builtin_amdgcn_global_load_lds((const unsigned*)((const char*)(gbase) + (voff)[_i]), (PG8_LAS unsigned*)(lds + (bufoff) + ldsw + _i * 8192), 16, 0, 0); } while (0)
#define PG8_LDA(dst, b, h) do { _Pragma("unroll") for (int m = 0; m < 4; ++m) _Pragma("unroll") for (int k = 0; k < 2; ++k) dst[m][k] = *(const PG8_LAS bf16x8*)(lds + PG8_SA(b, h) + aoff + m * 2048 + k * 1024); } while (0)
#define PG8_LDB(dst, b, h) do { _Pragma("unroll") for (int n = 0; n < 2; ++n) _Pragma("unroll") for (int k = 0; k < 2; ++k) dst[n][k] = *(const PG8_LAS bf16x8*)(lds + PG8_SB(b, h) + boff + n * 2048 + k * 1024); } while (0)
#define PG8_MMA(ai, bj, At, Bt) do { __builtin_amdgcn_s_setprio(1); _Pragma("unroll") for (int m = 0; m < 4; ++m) _Pragma("unroll") for (int n = 0; n < 2; ++n) _Pragma("unroll") for (int k = 0; k < 2; ++k) \
        acc[ai][bj][m][n] = __builtin_amdgcn_mfma_f32_16x16x32_bf16(Bt[n][k], At[m][k], acc[ai][bj][m][n], 0, 0, 0); __builtin_amdgcn_s_setprio(0); } while (0)
#define PG8_WAIT_V(n) asm volatile("s_waitcnt vmcnt(" #n ")" ::: "memory")
#define PG8_WAIT_L(n) asm volatile("s_waitcnt lgkmcnt(" #n ")" ::: "memory")
#define PG8_BAR __builtin_amdgcn_s_barrier()
#define PG8_SCHED __builtin_amdgcn_sched_barrier(0)
    Unit cur, nxt; int ui = 0;
    if (!S.next(0, cur)) return;
    f32x4 acc[2][2][4][2];
#pragma unroll
    for (int a = 0; a < 2; ++a)
#pragma unroll
        for (int b = 0; b < 2; ++b)
#pragma unroll
            for (int m = 0; m < 4; ++m)
#pragma unroll
                for (int n = 0; n < 2; ++n) acc[a][b][m][n] = (f32x4){0.f, 0.f, 0.f, 0.f};
    bf16x8 At[4][2], B0[2][2], B1[2][2];
    const char* cA = (const char*)g.A + (size_t)cur.pm * tstepA; const char* cB = (const char*)g.Bt + (size_t)cur.pn * tstepB;
    S.a_ready(cur);
    if constexpr (SP2) {
        PG8_STAGE(PG8_SB(0, 0), cB, voffB); PG8_STAGE(PG8_SB(0, 1), cB + hstepB, voffB); PG8_STAGE(PG8_SA(0, 0), cA, voffA); PG8_STAGE(PG8_SA(0, 1), cA + hstepA, voffA);
        if (wr == 1) PG8_BAR;
        PG8_WAIT_V(2); PG8_BAR;
        PG8_STAGE(PG8_SB(1, 0), cB + kstep, voffB); PG8_STAGE(PG8_SA(1, 0), cA + kstep, voffA); PG8_STAGE(PG8_SB(1, 1), cB + hstepB + kstep, voffB);
        PG8_WAIT_V(6); PG8_BAR;
    } else {
        PG8_STAGE(PG8_SB(0, 0), cB, voffB); PG8_STAGE(PG8_SA(0, 0), cA, voffA); PG8_STAGE(PG8_SB(0, 1), cB + hstepB, voffB); PG8_STAGE(PG8_SA(0, 1), cA + hstepA, voffA);
        if (wr == 1) PG8_BAR;
        PG8_WAIT_V(4); PG8_BAR;
        PG8_STAGE(PG8_SB(1, 0), cB + kstep, voffB); PG8_STAGE(PG8_SA(1, 0), cA + kstep, voffA); PG8_STAGE(PG8_SB(1, 1), cB + hstepB + kstep, voffB);
        PG8_WAIT_V(6); PG8_BAR;
    }
    for (;;) {
        const bool has_next = S.next(ui + 1, nxt);
        const char* nA = has_next ? (const char*)g.A + (size_t)nxt.pm * tstepA : cA; const char* nB = has_next ? (const char*)g.Bt + (size_t)nxt.pn * tstepB : cB;
        for (int t = 0; t < nt; t += 2) {
            const bool last = (t == nt - 2);
            const char* a1 = cA + (size_t)(t + 1) * kstep;
            const char* a2 = last ? nA : cA + (size_t)(t + 2) * kstep; const char* b2 = last ? nB : cB + (size_t)(t + 2) * kstep;
            const char* a3 = a2 + kstep; const char* b3 = b2 + kstep;
            if (last && has_next) S.a_ready(nxt);
            if constexpr (SP2) {
            PG8_LDB(B0, 0, 0); PG8_LDB(B1, 0, 1); PG8_SCHED; PG8_LDA(At, 0, 0); PG8_STAGE(PG8_SA(1, 1), a1 + hstepA, voffA);
            PG8_WAIT_V(8); PG8_WAIT_L(0); PG8_BAR; PG8_MMA(0, 0, At, B0); PG8_MMA(0, 1, At, B1); PG8_BAR; PG8_SCHED;
            PG8_LDA(At, 0, 1); PG8_STAGE(PG8_SB(0, 0), b2, voffB); PG8_STAGE(PG8_SB(0, 1), b2 + hstepB, voffB); PG8_STAGE(PG8_SA(0, 0), a2, voffA);
            PG8_WAIT_V(8); PG8_WAIT_L(0); PG8_BAR; PG8_MMA(1, 0, At, B0); PG8_MMA(1, 1, At, B1); PG8_BAR; PG8_SCHED;
            PG8_LDB(B0, 1, 0); PG8_LDB(B1, 1, 1); PG8_SCHED; PG8_LDA(At, 1, 0); PG8_STAGE(PG8_SA(0, 1), a2 + hstepA, voffA);
            PG8_WAIT_V(8); PG8_WAIT_L(0); PG8_BAR; PG8_MMA(0, 0, At, B0); PG8_MMA(0, 1, At, B1); PG8_BAR; PG8_SCHED;
            PG8_LDA(At, 1, 1); PG8_STAGE(PG8_SB(1, 0), b3, voffB); PG8_STAGE(PG8_SB(1, 1), b3 + hstepB, voffB); PG8_STAGE(PG8_SA(1, 0), a3, voffA);
            PG8_WAIT_V(8); PG8_WAIT_L(0); PG8_BAR; PG8_MMA(1, 0, At, B0); PG8_MMA(1, 1, At, B1); PG8_BAR; PG8_SCHED;
            } else {
            PG8_LDB(B0, 0, 0); PG8_SCHED; PG8_LDA(At, 0, 0); PG8_STAGE(PG8_SA(1, 1), a1 + hstepA, voffA);
            PG8_WAIT_L(8); PG8_BAR; PG8_WAIT_L(0); PG8_MMA(0, 0, At, B0); PG8_BAR; PG8_SCHED;
            PG8_LDB(B1, 0, 1); PG8_STAGE(PG8_SB(0, 0), b2, voffB);
            PG8_BAR; PG8_WAIT_L(0); PG8_MMA(0, 1, At, B1); PG8_BAR;
            PG8_LDA(At, 0, 1); PG8_STAGE(PG8_SA(0, 0), a2, voffA);
            PG8_BAR; PG8_WAIT_L(0); PG8_MMA(1, 0, At, B0); PG8_BAR; PG8_SCHED;
            PG8_STAGE(PG8_SB(0, 1), b2 + hstepB, voffB);
            PG8_WAIT_V(6); PG8_BAR; PG8_MMA(1, 1, At, B1); PG8_BAR;
            PG8_LDB(B0, 1, 0); PG8_SCHED; PG8_LDA(At, 1, 0); PG8_STAGE(PG8_SA(0, 1), a2 + hstepA, voffA);
            PG8_WAIT_L(8); PG8_BAR; PG8_WAIT_L(0); PG8_MMA(0, 0, At, B0); PG8_BAR; PG8_SCHED;
            PG8_LDB(B1, 1, 1); PG8_STAGE(PG8_SB(1, 0), b3, voffB);
            PG8_BAR; PG8_WAIT_L(0); PG8_MMA(0, 1, At, B1); PG8_BAR;
            PG8_LDA(At, 1, 1); PG8_STAGE(PG8_SA(1, 0), a3, voffA);
            PG8_BAR; PG8_WAIT_L(0); PG8_MMA(1, 0, At, B0); PG8_BAR; PG8_SCHED;
            PG8_STAGE(PG8_SB(1, 1), b3 + hstepB, voffB);
            PG8_WAIT_V(6); PG8_BAR; PG8_MMA(1, 1, At, B1); PG8_BAR;
            }
        }
        if constexpr (ALIGN_EPI) { if (wr == 0) PG8_BAR; }
        if constexpr (!Epi::AFTER_DRAIN) { E(acc, cur, wr, wc, fr, fq); S.done(cur); }
        if (!has_next) break;
#pragma unroll
        for (int a = 0; a < 2; ++a)
#pragma unroll
            for (int b = 0; b < 2; ++b)
#pragma unroll
                for (int m = 0; m < 4; ++m)
#pragma unroll
                    for (int n = 0; n < 2; ++n) acc[a][b][m][n] = (f32x4){0.f, 0.f, 0.f, 0.f};
        cur = nxt; cA = nA; cB = nB; ++ui;
        if constexpr (ALIGN_EPI) { if (wr == 1) PG8_BAR; }
    }
    PG8_WAIT_V(0);
    if constexpr (!ALIGN_EPI) { if (wr == 0) PG8_BAR; }
    PG8_BAR;
    if constexpr (Epi::AFTER_DRAIN) { E.fused(acc, cur, wr, wc, fr, fq, lds, wid, lane); S.done(cur); }
#undef PG8_SA
#undef PG8_SB
#undef PG8_STAGE
#undef PG8_LDA
#undef PG8_LDB
#undef PG8_MMA
#undef PG8_WAIT_V
#undef PG8_WAIT_L
#undef PG8_BAR
#undef PG8_SCHED
}
}
namespace attn_body {
using bf16=__hip_bfloat16;
using bf16x8=__attribute__((ext_vector_type(8)))short;
using s16x4=__attribute__((ext_vector_type(4)))short;
using f32x16=__attribute__((ext_vector_type(16)))float;
using u32x4=__attribute__((ext_vector_type(4)))unsigned;
constexpr int BATCH=2,NHEAD=16,SEQ=8192,D=64,ZP=3072,OP=1024;
constexpr int NW=8,QBLK=32,QB=QBLK*NW,KVBLK=64,NQB=SEQ/QB;
constexpr int ATTN_UNIT_ROWS=QB;
__device__ __forceinline__ int crow(int r,int hi){return (r&3)+8*(r>>2)+4*hi;}
#define SBAR() __builtin_amdgcn_sched_barrier(0)
typedef const __attribute__((address_space(3))) float* lds_cfp;
__device__ __forceinline__ void cmask(f32x16&p0,f32x16&p1,int jb,int qrel,int hi,lds_cfp tab){
  const float NEG=-INFINITY; const int kb=64*jb+4*hi;
  #pragma unroll
  for(int r=0;r<16;++r){ const int rel=qrel-(kb+(r&3)+8*(r>>2)); const int rel1=rel-32;
    int i0=rel<127?rel:127; i0=i0<0?0:i0; int i1=rel1<127?rel1:127; i1=i1<0?0:i1;
    const float b0=tab[i0], b1=tab[i1];
    p0[r]=rel<0?NEG:p0[r]+b0; p1[r]=rel1<0?NEG:p1[r]+b1; }
}

constexpr int NSLOT=3, SLOTB=8192;
constexpr int LDS_K=0, LDS_V=NSLOT*SLOTB, LDS_WS=2*NSLOT*SLOTB, LDS_OST=LDS_WS+NW*64*4, LDS_BYTES=LDS_OST+NW*4096;
constexpr float C2=0.125f*1.4426950408889634f;
__device__ __forceinline__ void glds16(const void*gsrc,unsigned lds_dst){unsigned keep;
  asm volatile("s_mov_b32 %0, m0\n\ts_mov_b32 m0, %2\n\ts_nop 0\n\tglobal_load_lds_dwordx4 %1, off\n\ts_mov_b32 m0, %0":"=&s"(keep):"v"(gsrc),"s"(lds_dst):"memory");}
__device__ __forceinline__ float max3f(float a,float b,float c){float r;asm("v_max3_f32 %0, %1, %2, %3":"=v"(r):"v"(a),"v"(b),"v"(c));return r;}
__device__ __forceinline__ float max2f(float a,float b){float r;asm("v_max_f32_e32 %0, %1, %2":"=v"(r):"v"(a),"v"(b));return r;}
__device__ __forceinline__ float fadd_s(float a,float b){float r;asm("v_add_f32_e32 %0, %1, %2":"=v"(r):"v"(a),"v"(b));return r;}
__device__ __forceinline__ float fsub_s(float a,float b){float r;asm("v_sub_f32_e32 %0, %1, %2":"=v"(r):"v"(a),"v"(b));return r;}
typedef float f32x2_t __attribute__((ext_vector_type(2))); typedef __bf16 bf16x2_t __attribute__((ext_vector_type(2)));
__device__ __forceinline__ unsigned cvtpk_s(float lo,float hi){f32x2_t v={lo,hi};bf16x2_t b=__builtin_convertvector(v,bf16x2_t);return __builtin_bit_cast(unsigned,b);}
#define WAIT_BAR(N) asm volatile("s_waitcnt vmcnt(" #N ") lgkmcnt(0)\n\ts_barrier":::"memory")

__device__ __forceinline__ void qkt(f32x16&p0,f32x16&p1,const char*Kslot,const bf16x8*qr,const f32x16&negm,int r32,int hi){
  const char*kb=Kslot+hi*1024+r32*16;
  #pragma unroll
  for(int d0=0;d0<4;++d0){
    const bf16x8 b0=*reinterpret_cast<const bf16x8*>(kb+d0*2048);
    const bf16x8 b1=*reinterpret_cast<const bf16x8*>(kb+d0*2048+512);
    if(d0==0){p0=__builtin_amdgcn_mfma_f32_32x32x16_bf16(b0,qr[0],negm,0,0,0);p1=__builtin_amdgcn_mfma_f32_32x32x16_bf16(b1,qr[0],negm,0,0,0);}
    else{p0=__builtin_amdgcn_mfma_f32_32x32x16_bf16(b0,qr[d0],p0,0,0,0);p1=__builtin_amdgcn_mfma_f32_32x32x16_bf16(b1,qr[d0],p1,0,0,0);}}
}
typedef __attribute__((address_space(3))) const char* lds_cptr;
typedef short v4i16_t __attribute__((ext_vector_type(4)));
__device__ __forceinline__ void kload8(bf16x8*kf,lds_cptr kp){
  kf[0]=*(const __attribute__((address_space(3))) bf16x8*)(kp);      kf[1]=*(const __attribute__((address_space(3))) bf16x8*)(kp+512);
  kf[2]=*(const __attribute__((address_space(3))) bf16x8*)(kp+2048); kf[3]=*(const __attribute__((address_space(3))) bf16x8*)(kp+2560);
  kf[4]=*(const __attribute__((address_space(3))) bf16x8*)(kp+4096); kf[5]=*(const __attribute__((address_space(3))) bf16x8*)(kp+4608);
  kf[6]=*(const __attribute__((address_space(3))) bf16x8*)(kp+6144); kf[7]=*(const __attribute__((address_space(3))) bf16x8*)(kp+6656);
}
__device__ __forceinline__ void kload2(bf16x8*kf,lds_cptr kp,int j){ kf[2*j]=*(const __attribute__((address_space(3))) bf16x8*)(kp+j*2048); kf[2*j+1]=*(const __attribute__((address_space(3))) bf16x8*)(kp+j*2048+512); }
__device__ __forceinline__ s16x4 vtr(lds_cptr p){ return __builtin_bit_cast(s16x4,__builtin_amdgcn_ds_read_tr16_b64_v4i16((__attribute__((address_space(3))) v4i16_t*)p)); }
__device__ __forceinline__ float rowmax(const f32x16&p0,const f32x16&p1){
  float a=max3f(p0[0],p0[1],p1[0]),b=max3f(p0[2],p0[3],p1[1]);a=max3f(a,p1[2],p1[3]);
  #pragma unroll
  for(int r=4;r<16;r+=4){a=max3f(a,p0[r],p0[r+1]);b=max3f(b,p0[r+2],p0[r+3]);a=max3f(a,p1[r],p1[r+1]);b=max3f(b,p1[r+2],p1[r+3]);}
  const float m=max2f(a,b);
  auto rr=__builtin_amdgcn_permlane32_swap(__float_as_uint(m),__float_as_uint(m),false,false);
  return max2f(__uint_as_float(rr[0]),__uint_as_float(rr[1]));
}
__device__ __forceinline__ void pv(f32x16*o,int vb,bf16x8 pa0,bf16x8 pa1,bf16x8 pa2,bf16x8 pa3){
  #pragma unroll
  for(int d0=0;d0<2;++d0){s16x4 lo[4],hi[4];
    #pragma unroll
    for(int ks=0;ks<4;++ks){
      asm volatile("ds_read_b64_tr_b16 %0,%1 offset:%c2":"=&v"(lo[ks]):"v"(vb),"i"(d0*4096+ks*1024):"memory");
      asm volatile("ds_read_b64_tr_b16 %0,%1 offset:%c2":"=&v"(hi[ks]):"v"(vb),"i"(d0*4096+ks*1024+512):"memory");}
    asm volatile("s_waitcnt lgkmcnt(0)":::"memory");SBAR();
    #define PK(k) (bf16x8){lo[k][0],lo[k][1],lo[k][2],lo[k][3],hi[k][0],hi[k][1],hi[k][2],hi[k][3]}
    o[d0]=__builtin_amdgcn_mfma_f32_32x32x16_bf16(pa0,PK(0),o[d0],0,0,0);
    o[d0]=__builtin_amdgcn_mfma_f32_32x32x16_bf16(pa1,PK(1),o[d0],0,0,0);
    o[d0]=__builtin_amdgcn_mfma_f32_32x32x16_bf16(pa2,PK(2),o[d0],0,0,0);
    o[d0]=__builtin_amdgcn_mfma_f32_32x32x16_bf16(pa3,PK(3),o[d0],0,0,0);
    #undef PK
  }
}

#ifndef ATTN_STORE16
#define ATTN_STORE16(p,v) (*(u32x4*)(p)=(v))
#endif
template<int THRL> __device__ __forceinline__ void attn_unit(int b,int qcol,int kcol,int vcol,int ocol,int qb,const bf16*__restrict__ Zb,bf16*O,char*shm,lds_cfp tab){
  int tid_=threadIdx.x; asm volatile("":"+v"(tid_));
  const int tid=tid_,lane=tid&63,r32=lane&31,hi=lane>>5; const int wid=__builtin_amdgcn_readfirstlane(tid>>6);
  const long rowbase=(long)b*SEQ; const int q0=qb*QB;
  const bf16*Qw=Zb+(rowbase+q0+wid*QBLK)*ZP+qcol;
  const bf16*Kh=Zb+rowbase*ZP+kcol,*Vh=Zb+rowbase*ZP+vcol;
  const unsigned lds0=(unsigned)(uintptr_t)shm;
  float*wsf=(float*)(shm+LDS_WS)+wid*64;
  const bf16*ksrc=Kh+(long)lane*ZP+wid*8;
  const bf16*vsrc=Vh+(long)(16*(wid&3)+(lane>>2))*ZP+(wid>>2)*32+(lane&3)*8;
  const unsigned kdst=lds0+LDS_K+wid*1024, vdst=lds0+LDS_V+wid*1024;
  #define DMA_K(t,slot) glds16(ksrc+(long)(t)*KVBLK*ZP,(unsigned)__builtin_amdgcn_readfirstlane(kdst+(slot)))
  #define DMA_V(t,slot) glds16(vsrc+(long)(t)*KVBLK*ZP,(unsigned)__builtin_amdgcn_readfirstlane(vdst+(slot)))
  const int vb0=(int)(lds0+LDS_V)+((lane>>4)&1)*32+(lane&3)*8+(4*hi+((lane&15)>>2))*64;
  const char*Kbase=shm+LDS_K; bf16x8 kf[8];
  const lds_cptr shm3=(lds_cptr)shm; const lds_cptr kp0=shm3+LDS_K+hi*1024+r32*16; const lds_cptr vp0=shm3+LDS_V+((lane>>4)&1)*32+(lane&3)*8+(4*hi+((lane&15)>>2))*64;
  const int NT=(q0+QB)/KVBLK;
  DMA_K(0,0);DMA_V(0,0);DMA_K(1,SLOTB);
  bf16x8 qr[4];
  #pragma unroll
  for(int d0=0;d0<4;++d0)qr[d0]=*reinterpret_cast<const bf16x8*>(&Qw[(long)r32*ZP+d0*16+hi*8]);
  float mhat=0.f,l_reg=0.f;f32x16 o[2];o[0]=f32x16{};o[1]=f32x16{};f32x16 negm=f32x16{};asm volatile("":"+v"(negm));
  const int qrel=wid*QBLK+r32;
  #define CMASK(P0,P1,t) do{int jb_=(t)-(NT-4); if(jb_>=-2)cmask(P0,P1,jb_,qrel,hi,tab);}while(0)
  bool resc=false;
  #define START(P0,P1) do{ const float rm=rowmax(P0,P1); resc=false; \
    { const float dl=rm; mhat=fadd_s(mhat,dl); \
      _Pragma("unroll") for(int r=0;r<16;++r){P0[r]=fsub_s(P0[r],dl);P1[r]=fsub_s(P1[r],dl);} \
      _Pragma("unroll") for(int r=0;r<16;++r)negm[r]=-mhat; asm volatile("":"+v"(negm)); } \
    _Pragma("unroll") for(int r=0;r<16;++r)P0[r]=__builtin_amdgcn_exp2f(P0[r]); }while(0)
  #define RESC() do{ if(resc){ asm volatile("s_waitcnt lgkmcnt(0)":::"memory"); \
      _Pragma("unroll") for(int d_=0;d_<2;++d_) _Pragma("unroll") for(int r=0;r<16;++r)o[d_][r]*=wsf[crow(r,hi)]; } }while(0)
  f32x16 pA0,pA1,pB0,pB1;
  int sl_prev=0,sl_cur=0,sl_next=SLOTB;
  #define ROT() do{sl_prev=sl_cur;sl_cur=sl_next;sl_next=(sl_next==(NSLOT-1)*SLOTB)?0:sl_next+SLOTB;}while(0)
  DMA_K(2,2*SLOTB);
  WAIT_BAR(3);
  qkt(pA0,pA1,Kbase,qr,negm,r32,hi);asm volatile("s_nop 15\n\ts_nop 7":"+v"(pA0),"+v"(pA1));CMASK(pA0,pA1,0);
  START(pA0,pA1);
  _Pragma("unroll") for(int r=0;r<16;++r)pA1[r]=__builtin_amdgcn_exp2f(pA1[r]);
  WAIT_BAR(0);
  DMA_K(3,0);DMA_V(1,SLOTB);
  ROT();
  kload8(kf,kp0+sl_cur);
  WAIT_BAR(2);
  s16x4 vlo[8],vhi[8]; u32x4 pw0,pw1,pw2,pw3;
  #define PKW(P,B) cvtpk_s(P[B],P[B+1])
  #define PAF(k) __builtin_bit_cast(bf16x8,pw##k)
  #define VFR(i) (bf16x8){vlo[i][0],vlo[i][1],vlo[i][2],vlo[i][3],vhi[i][0],vhi[i][1],vhi[i][2],vhi[i][3]}
  #define PIN(x) asm volatile("":"+v"(x))
  #define MX3(a,b,c) __builtin_fmaxf(__builtin_fmaxf((a),(b)),(c))
  #define GAPA(MF,A0,A1,A2,A3,W0,W1,PW) do{ MF; sacc+=A0; sacc+=A1; sacc+=A2; sacc+=A3; PIN(sacc); W0; W1; PIN(PW); SBAR(); }while(0)
  #define EX(v) __builtin_amdgcn_exp2f(v)
  #define GAPB(MF,X,B) do{ MF; X[B]=EX(X[B]); X[B+1]=EX(X[B+1]); X[B+2]=EX(X[B+2]); X[B+3]=EX(X[B+3]); PIN(X); SBAR(); }while(0)
  #define VRD(i) do{ vlo[i]=vtr(vp_+(((i)>>2)*4096+((i)&3)*1024)); vhi[i]=vtr(vp_+(((i)>>2)*4096+((i)&3)*1024+512)); }while(0)
  #define KRD(G,j) do{ if(G){ kload2(kf,kp0+sl_next,j); SBAR(); } }while(0)
  #define STEP(C0,C1,P0,P1,t,GK,GV,GL) do{ SBAR(); \
    const lds_cptr vp_=vp0+sl_prev; \
    VRD(0); SBAR(); float sacc=(P0[0]+P0[1]); \
    GAPA(C0=__builtin_amdgcn_mfma_f32_32x32x16_bf16(kf[0],qr[0],negm,0,0,0), P0[2],P0[3],P0[4],P0[5],     pw0[0]=PKW(P0,0), pw0[1]=PKW(P0,2), pw0); \
    VRD(4); SBAR(); GAPA(C1=__builtin_amdgcn_mfma_f32_32x32x16_bf16(kf[1],qr[0],negm,0,0,0), P0[6],P0[7],P0[8],P0[9],     pw0[2]=PKW(P0,4), pw0[3]=PKW(P0,6), pw0); \
    VRD(1); SBAR(); GAPA(C0=__builtin_amdgcn_mfma_f32_32x32x16_bf16(kf[2],qr[1],C0,0,0,0),   P0[10],P0[11],P0[12],P0[13], pw1[0]=PKW(P0,8), pw1[1]=PKW(P0,10), pw1); \
    VRD(5); SBAR(); GAPA(C1=__builtin_amdgcn_mfma_f32_32x32x16_bf16(kf[3],qr[1],C1,0,0,0),   P0[14],P0[15],P1[0],P1[1],   pw1[2]=PKW(P0,12),pw1[3]=PKW(P0,14), pw1); \
    VRD(2); SBAR(); GAPA(C0=__builtin_amdgcn_mfma_f32_32x32x16_bf16(kf[4],qr[2],C0,0,0,0),   P1[2],P1[3],P1[4],P1[5],     pw2[0]=PKW(P1,0), pw2[1]=PKW(P1,2), pw2); \
    VRD(6); SBAR(); GAPA(C1=__builtin_amdgcn_mfma_f32_32x32x16_bf16(kf[5],qr[2],C1,0,0,0),   P1[6],P1[7],P1[8],P1[9],     pw2[2]=PKW(P1,4), pw2[3]=PKW(P1,6), pw2); \
    VRD(3); SBAR(); GAPA(C0=__builtin_amdgcn_mfma_f32_32x32x16_bf16(kf[6],qr[3],C0,0,0,0),   P1[10],P1[11],P1[12],P1[13], pw3[0]=PKW(P1,8), pw3[1]=PKW(P1,10), pw3); \
    VRD(7); SBAR(); GAPA(C1=__builtin_amdgcn_mfma_f32_32x32x16_bf16(kf[7],qr[3],C1,0,0,0),   P1[14],P1[15],0.f,0.f,       pw3[2]=PKW(P1,12),pw3[3]=PKW(P1,14), pw3); \
    l_reg+=sacc; \
    if(GK){DMA_K((t)+3,sl_cur);} if(GV){DMA_V((t)+1,sl_next);} \
    CMASK(C0,C1,t); \
    { float a=MX3(C0[0],C0[1],C1[0]),b=MX3(C0[2],C0[3],C1[1]); a=MX3(a,C1[2],C1[3]); \
      _Pragma("unroll") for(int r=4;r<16;r+=4){a=MX3(a,C0[r],C0[r+1]);b=MX3(b,C0[r+2],C0[r+3]);a=MX3(a,C1[r],C1[r+1]);b=MX3(b,C1[r+2],C1[r+3]);} \
      float rm=__builtin_fmaxf(a,b); { auto rr=__builtin_amdgcn_permlane32_swap(__float_as_uint(rm),__float_as_uint(rm),false,false); rm=__builtin_fmaxf(__uint_as_float(rr[0]),__uint_as_float(rr[1])); } \
      resc=false; \
      if(__builtin_expect(__any(rm>(float)THRL),0)){ const float dl=__builtin_fmaxf(rm,0.f); mhat+=dl; \
        _Pragma("unroll") for(int r=0;r<16;++r){C0[r]-=dl;C1[r]-=dl;} \
        _Pragma("unroll") for(int r=0;r<16;++r)negm[r]=-mhat; asm volatile("":"+v"(negm)); \
        const float f=__builtin_amdgcn_exp2f(-dl); l_reg*=f; if(hi==0)wsf[r32]=f; resc=true; } } \
    SBAR(); \
    GAPB(o[0]=__builtin_amdgcn_mfma_f32_32x32x16_bf16(PAF(0),VFR(0),o[0],0,0,0), C0,0); \
    GAPB(o[1]=__builtin_amdgcn_mfma_f32_32x32x16_bf16(PAF(0),VFR(4),o[1],0,0,0), C0,4); \
    KRD(GL,0); GAPB(o[0]=__builtin_amdgcn_mfma_f32_32x32x16_bf16(PAF(1),VFR(1),o[0],0,0,0), C0,8); \
    KRD(GL,1); GAPB(o[1]=__builtin_amdgcn_mfma_f32_32x32x16_bf16(PAF(1),VFR(5),o[1],0,0,0), C0,12); \
    KRD(GL,2); GAPB(o[0]=__builtin_amdgcn_mfma_f32_32x32x16_bf16(PAF(2),VFR(2),o[0],0,0,0), C1,0); \
    KRD(GL,3); GAPB(o[1]=__builtin_amdgcn_mfma_f32_32x32x16_bf16(PAF(2),VFR(6),o[1],0,0,0), C1,4); \
    GAPB(o[0]=__builtin_amdgcn_mfma_f32_32x32x16_bf16(PAF(3),VFR(3),o[0],0,0,0), C1,8); \
    GAPB(o[1]=__builtin_amdgcn_mfma_f32_32x32x16_bf16(PAF(3),VFR(7),o[1],0,0,0), C1,12); \
    }while(0)
  int t=1;
  #undef CMASK
  #define CMASK(P0,P1,t) do{}while(0)
  for(;t+7<NT;t+=2){
    STEP(pB0,pB1,pA0,pA1,t,true,true,true);     WAIT_BAR(2); RESC(); ROT();
    STEP(pA0,pA1,pB0,pB1,t+1,true,true,true);   WAIT_BAR(2); RESC(); ROT();
  }
  #undef CMASK
  #define CMASK(P0,P1,t) do{int jb_=(t)-(NT-4); if(jb_>=-2)cmask(P0,P1,jb_,qrel,hi,tab);}while(0)
  #define ENDW(tt) do{ if((tt)+3<NT){WAIT_BAR(2);} else if((tt)+2<NT){WAIT_BAR(1);} else {WAIT_BAR(0);} }while(0)
  for(;t+1<NT;t+=2){
    STEP(pB0,pB1,pA0,pA1,t,(t+3<NT),(t+1<NT),(t+1<NT));       ENDW(t);   RESC(); ROT();
    STEP(pA0,pA1,pB0,pB1,t+1,(t+4<NT),(t+2<NT),(t+2<NT));     ENDW(t+1); RESC(); ROT();
  }
  STEP(pB0,pB1,pA0,pA1,NT-1,false,false,false); RESC();
  { float sacc=pB0[0]+pB0[1]; _Pragma("unroll") for(int r=2;r<16;++r)sacc+=pB0[r]; _Pragma("unroll") for(int r=0;r<16;++r)sacc+=pB1[r]; l_reg+=sacc;
    pw0=(u32x4){PKW(pB0,0),PKW(pB0,2),PKW(pB0,4),PKW(pB0,6)};pw1=(u32x4){PKW(pB0,8),PKW(pB0,10),PKW(pB0,12),PKW(pB0,14)};pw2=(u32x4){PKW(pB1,0),PKW(pB1,2),PKW(pB1,4),PKW(pB1,6)};pw3=(u32x4){PKW(pB1,8),PKW(pB1,10),PKW(pB1,12),PKW(pB1,14)};
    SBAR(); pv(o,vb0+sl_cur,PAF(0),PAF(1),PAF(2),PAF(3)); }
  #undef PKW
  #undef PAF
  #undef VFR
  #undef PIN
  #undef MX3
  #undef GAPA
  #undef GAPB
  #undef EX
  #undef VRD
  #undef KRD
  #undef STEP
  #undef ENDW
  {auto rr=__builtin_amdgcn_permlane32_swap(__float_as_uint(l_reg),__float_as_uint(l_reg),false,false);l_reg=__uint_as_float(rr[0])+__uint_as_float(rr[1]);}
  if(hi==0)wsf[32+r32]=l_reg;asm volatile("s_waitcnt lgkmcnt(0)":::"memory");
  float rli[16];
  #pragma unroll
  for(int r=0;r<16;++r)rli[r]=__builtin_amdgcn_rcpf(wsf[32+crow(r,hi)]);
  bf16*Ow=O+(rowbase+q0+wid*QBLK)*OP+ocol;
  { bf16*stg=(bf16*)(shm+LDS_OST)+wid*2048;
    #pragma unroll
    for(int r=0;r<16;++r){const int orow=crow(r,hi);
      #pragma unroll
      for(int d0=0;d0<2;++d0)stg[orow*64+d0*32+r32]=__float2bfloat16(o[d0][r]*rli[r]);}
    asm volatile("s_waitcnt lgkmcnt(0)":::"memory");
    #pragma unroll
    for(int i=0;i<4;++i){const int row=i*8+(lane>>3),ch=lane&7; const u32x4 v=*(const u32x4*)(stg+row*64+ch*8); ATTN_STORE16(Ow+(long)row*OP+ch*8,v);} }
  asm volatile("s_waitcnt lgkmcnt(0)\n\ts_barrier":::"memory");
  #undef DMA_K
  #undef DMA_V
  #undef CMASK
  #undef START
  #undef RESC
  #undef ROT
}
constexpr int ATTN_LDS_BYTES=LDS_BYTES;
struct AttnUnit { int bh; int qb; };
struct StaticOrder {
  int vcu;
  __device__ __forceinline__ explicit StaticOrder(int grid,int block):vcu((block%8)*(grid/8)+block/8){}
  __device__ __forceinline__ bool next(int i,AttnUnit&u)const{ if(i>=4)return false; const int s=vcu&7; u.bh=vcu>>3; u.qb=(i==0)?s:(i==1)?15-s:(i==2)?16+s:31-s; return true; }
  __device__ __forceinline__ void a_ready(const AttnUnit&)const{}
  __device__ __forceinline__ void done(const AttnUnit&)const{}
};
template<class Sched,int THRL=8> __device__ __forceinline__ void attn_phase(char*lds,const bf16*Zb,bf16*OA,lds_cfp tab,const Sched&S){
  AttnUnit u;
  for(int i=0;S.next(i,u);++i){ S.a_ready(u); const int b=u.bh>>4,vh=u.bh&15,map=vh>>3,h=(vh>>1)&3,vhalf=vh&1;
    attn_unit<THRL>(b,h*128+map*64,512+h*128+map*64,1024+h*128+vhalf*64,map*512+h*128+vhalf*64,u.qb,Zb,OA,lds,tab+h*128); S.done(u); }
}
template<int THRL=8> __device__ __forceinline__ void attn_one(char*lds,const bf16*Zb,bf16*OA,lds_cfp tab,const AttnUnit&u){
  const int b=u.bh>>4,vh=u.bh&15,map=vh>>3,h=(vh>>1)&3,vhalf=vh&1;
  attn_unit<THRL>(b,h*128+map*64,512+h*128+map*64,1024+h*128+vhalf*64,map*512+h*128+vhalf*64,u.qb,Zb,OA,lds,tab+h*128);
}
#undef SBAR
#undef WAIT_BAR
}

constexpr int NWAVES = 8;
#ifndef MK_PER_PHASE
#define MK_PER_PHASE 0
#endif
constexpr int NPH = 12;

constexpr int MP = 16384, MS = 128, MV = MP + MS, MPAD = 16640;
constexpr int DM = 1024, DIN = 3072, FF = 4096, TSEQ = 8192, NMEM = 256, PASTLEN = 2048;
constexpr float EPS = 1e-6f, LOG2E = 1.4426950408889634f;
constexpr float C2A = 0.125f * LOG2E;
constexpr float C2M = 0.0625f * LOG2E;
constexpr float ONE_M_LAMINIT = 0.8f, LAMINIT = 0.2f;
constexpr int ZQA = 0, ZKA = 512, ZVA = 1024, ZQR = 1536, ZKR = 1792, ZVR = 2048, ZGR = 2560;
constexpr size_t OY_P = 0, OY_S = 16777216, OK_P = 16908288, OV_P = 25296896, OS_P = 33685504, OMK = 33751040, OMV = 34275328, OK_S = 34799616, OV_S = 34865152, OS_S = 34930688, OUT_TOTAL = 39124992;
enum { I_XP = 0, I_XS, I_MEMP, I_CK, I_CV, I_PT, I_SRET, I_CMK, I_CMV, I_RELB, I_NMIX, I_WIN, I_LQ1, I_LK1, I_LQ2, I_LK2, I_SUBLN, I_WOUT, I_NMEMQ, I_NMEMKV, I_WMQ, I_WMK, I_WMV, I_WMO, I_NMLP, I_WUP, I_WDN, I_NFIN, N_IN };

constexpr size_t MiB = 1u << 20;
constexpr size_t WS_CTL = 0, CTL_ZERO_BYTES = 1 * MiB;
constexpr size_t WS_WIN = 2 * MiB, WS_WOUT = 8 * MiB, WS_WMQ = 10 * MiB, WS_WMKV = 12 * MiB, WS_WMO = 16 * MiB, WS_WUP = 18 * MiB, WS_WDN = 26 * MiB;
constexpr size_t WS_MEMN = 34 * MiB, WS_MKB = 35 * MiB, WS_MVT = 36 * MiB, WS_SSQ1 = 37 * MiB, WS_SSQ2 = 39 * MiB, WS_SSQ3 = 41 * MiB;
constexpr size_t WS_XN = 48 * MiB, WS_Z = 82 * MiB, WS_OA = 180 * MiB, WS_MIX = 214 * MiB, WS_KRT = 248 * MiB, WS_VRT = 256 * MiB, WS_U = 272 * MiB, WS_SPT = 288 * MiB;
constexpr size_t WS_X1 = 296 * MiB, WS_X1B = 362 * MiB, WS_QM = 396 * MiB, WS_PM = 430 * MiB, WS_OM = 464 * MiB, WS_X2 = 498 * MiB, WS_X2B = 564 * MiB, WS_H = 598 * MiB, WS_X3 = 730 * MiB, WS_END = 796 * MiB;
static_assert(WS_XN + (size_t)MPAD * DM * 2 <= WS_Z && WS_Z + (size_t)MPAD * DIN * 2 <= WS_OA && WS_OA + (size_t)MPAD * DM * 2 <= WS_MIX && WS_MIX + (size_t)MPAD * DM * 2 <= WS_KRT, "ws map 1");
static_assert(WS_X1 + (size_t)MPAD * DM * 4 <= WS_X1B && WS_H + (size_t)MPAD * FF * 2 <= WS_X3 && WS_X3 + (size_t)MPAD * DM * 4 <= WS_END && WS_SSQ1 + (size_t)MPAD * 16 * 4 <= WS_SSQ2, "ws map 2");
constexpr size_t WS_SSQS1 = WS_SSQ1 + 3 * MiB / 2, WS_SSQS2 = WS_SSQ2 + 3 * MiB / 2, WS_SSQS3 = WS_SSQ3 + 3 * MiB / 2;
constexpr int CW_TMO = 0, CW_CODE = 1, CW_BAR = 4096;

constexpr int RING_OFF = 0, RING_BYTES = 131072;
constexpr int LDSCTL_OFF = RING_BYTES, MISC_OFF = LDSCTL_OFF + 320;
constexpr int TAB_OFF = RING_BYTES + 1024;
constexpr int LDS_BYTES = 147456;
static_assert(MISC_OFF + 128 <= TAB_OFF && TAB_OFF + 2048 <= LDS_BYTES, "LDS map");

#define GAS __attribute__((address_space(1)))
#define LAS __attribute__((address_space(3)))
typedef unsigned short bf16;
typedef unsigned v4u __attribute__((ext_vector_type(4)));
typedef float f32x4 __attribute__((ext_vector_type(4)));
typedef short bf16x8 __attribute__((ext_vector_type(8)));
typedef GAS unsigned gu32;
typedef GAS unsigned long long gu64;
#define RLX_AGENT __ATOMIC_RELAXED, __HIP_MEMORY_SCOPE_AGENT
#define LDS_WAIT() asm volatile("s_waitcnt lgkmcnt(0)" ::: "memory")
#define VM_WAIT() asm volatile("s_waitcnt vmcnt(0)" ::: "memory")
__device__ __forceinline__ unsigned long long rt() { return __builtin_amdgcn_s_memrealtime(); }
__device__ __forceinline__ unsigned f2bf(float f) { unsigned u = __builtin_bit_cast(unsigned, f); return (u + 0x7fffu + ((u >> 16) & 1u)) >> 16; }
__device__ __forceinline__ unsigned pk2(float lo, float hi) { return f2bf(lo) | (f2bf(hi) << 16); }

#define XB_TMO      128
#define XB_XCNT(j)  (256  + 64 * (j))
#define XB_XSUB(j)  (1280 + 64 * (j))
#define XB_XGEN(j)  (2304 + 64 * (j))
#define XB_TOP      3328
#define XB_TOPGEN   3392
#define XCD_BAR_WORDS 3456
#define XB_SPIN_CAP (1u << 18)

__device__ __forceinline__ unsigned xb_ld(unsigned* p)              { return __hip_atomic_load(p, __ATOMIC_RELAXED, __HIP_MEMORY_SCOPE_AGENT); }
__device__ __forceinline__ unsigned xb_add(unsigned* p, unsigned v) { return __hip_atomic_fetch_add(p, v, __ATOMIC_RELAXED, __HIP_MEMORY_SCOPE_AGENT); }
__device__ __forceinline__ unsigned xb_xcc_id() { return (unsigned)__builtin_amdgcn_s_getreg((3 << 11) | 20) & 0xFu; }
#define XB_SPIN(cond, bar) do { unsigned _sp = 0; while (cond) { __builtin_amdgcn_s_sleep(1); \
    if ((++_sp & 255u) == 0u) { if (xb_ld(&(bar)[XB_TMO])) break; if (_sp > XB_SPIN_CAP) { atomicAdd(&(bar)[XB_TMO], 1u); break; } } } } while (0)

struct XcdBarrier {
    unsigned* bar; unsigned x;
    volatile LAS unsigned* st;
};

__device__ __forceinline__ XcdBarrier xcd_barrier_post(unsigned* bar, volatile LAS unsigned* st) {
    XcdBarrier b; b.bar = bar; b.x = xb_xcc_id(); b.st = st;
    if (threadIdx.x == 0) (void)xb_add(&bar[XB_XCNT(b.x)], 1u);
    return b;
}
__device__ __forceinline__ void xcd_barrier_complete(unsigned* bar, unsigned x, unsigned& nloc, unsigned& nx) {
    const unsigned G = gridDim.x * gridDim.y * gridDim.z;
    unsigned sum, cnt, mine, sp = 0u;
    for (;;) {
        sum = 0u; cnt = 0u; mine = 0u;
#pragma unroll
        for (unsigned j = 0; j < 16; ++j) { const unsigned c = xb_ld(&bar[XB_XCNT(j)]); sum += c; cnt += (c > 0u) ? 1u : 0u; mine = (j == x) ? c : mine; }
        if (sum == G) break;
        __builtin_amdgcn_s_sleep(1);
        if ((++sp & 255u) == 0u) { if (xb_ld(&bar[XB_TMO])) break; if (sp > XB_SPIN_CAP) { atomicAdd(&bar[XB_TMO], 1u); break; } }
    }
    nloc = mine > 0u ? mine : 1u; nx = cnt > 0u ? cnt : 1u;
}

__device__ __forceinline__ void xcd_barrier(const XcdBarrier& b) {
    asm volatile("s_waitcnt vmcnt(0)" ::: "memory");
    __syncthreads();
    if (threadIdx.x == 0) {
        unsigned* bar = b.bar;
        __builtin_amdgcn_s_waitcnt(0);
        unsigned nloc = b.st[0], nx = b.st[1];
        if (nloc == 0u) { xcd_barrier_complete(bar, b.x, nloc, nx); b.st[0] = nloc; b.st[1] = nx; }
        const unsigned old = xb_add(&bar[XB_XSUB(b.x)], 1u);
        const unsigned gen = old / nloc;
        if (old + 1u == (gen + 1u) * nloc) {
            __builtin_amdgcn_fence(__ATOMIC_RELEASE, "agent");
            asm volatile("s_waitcnt vmcnt(0)" ::: "memory");
            const unsigned og = xb_add(&bar[XB_TOP], 1u);
            const unsigned tg = og / nx;
            if (og + 1u == (tg + 1u) * nx) xb_add(&bar[XB_TOPGEN], 1u);
            else XB_SPIN(xb_ld(&bar[XB_TOPGEN]) == tg, bar);
            __builtin_amdgcn_fence(__ATOMIC_ACQUIRE, "agent");
            xb_add(&bar[XB_XGEN(b.x)], 1u);
            asm volatile("s_waitcnt vmcnt(0)" ::: "memory");
        } else {
            XB_SPIN(xb_ld(&bar[XB_XGEN(b.x)]) == gen, bar);
            __builtin_amdgcn_fence(__ATOMIC_ACQUIRE, "agent");
            asm volatile("s_waitcnt vmcnt(0)" ::: "memory");
        }
    }
    __syncthreads();
}

typedef unsigned u32x2 __attribute__((ext_vector_type(2)));
typedef float f32x2 __attribute__((ext_vector_type(2)));
typedef float f32x16 __attribute__((ext_vector_type(16)));
typedef short s16x4 __attribute__((ext_vector_type(4)));
struct Frame {
    LAS unsigned char* lds;
    volatile LAS unsigned* MISC;
    gu32* ctl;
    int wave, vcu, G;
    const float* const* in;
    float* out; unsigned char* ws;
};
#define WSP(T, off) ((T*)(F.ws + (off)))
__device__ __forceinline__ int fresh_tid() { int t = threadIdx.x; asm volatile("" : "+v"(t)); return t; }

__device__ __forceinline__ float bf2f(unsigned short b) { return __uint_as_float((unsigned)b << 16); }
__device__ __forceinline__ float bflo(unsigned w) { return __uint_as_float(w << 16); }
__device__ __forceinline__ float bfhi(unsigned w) { return __uint_as_float(w & 0xffff0000u); }
__device__ __forceinline__ v4u pack8(const f32x4 a, const f32x4 b) { v4u w; w.x = pg8::cvt_pk_bf16(a.x, a.y); w.y = pg8::cvt_pk_bf16(a.z, a.w); w.z = pg8::cvt_pk_bf16(b.x, b.y); w.w = pg8::cvt_pk_bf16(b.z, b.w); return w; }
template <int CTRL> __device__ __forceinline__ float dpp_mov(float v) { return __builtin_bit_cast(float, __builtin_amdgcn_update_dpp(0, __builtin_bit_cast(int, v), CTRL, 0xF, 0xF, true)); }
__device__ __forceinline__ float row16_sum(float v) {
    v += dpp_mov<0xB1>(v);
    v += dpp_mov<0x4E>(v);
    v += dpp_mov<0x141>(v);
    v += dpp_mov<0x140>(v);
    return v;
}
__device__ __forceinline__ float wave_sum(float v) { v = row16_sum(v); v += __shfl_xor(v, 16); v += __shfl_xor(v, 32); return v; }
__device__ __forceinline__ float wave_max(float v) {
#pragma unroll
    for (int o = 1; o < 64; o <<= 1) v = fmaxf(v, __shfl_xor(v, o));
    return v;
}
__device__ __forceinline__ float log2gamma(int h) { return log2f(1.0f - exp2f(-(float)(5 + h))); }
__device__ __forceinline__ int t5_bucket(int n) {
    if (n < 16) return n;
    return 16 + (n >= 19) + (n >= 21) + (n >= 24) + (n >= 27) + (n >= 31) + (n >= 35) + (n >= 40) + (n >= 46) + (n >= 52) + (n >= 59) + (n >= 67) + (n >= 77) + (n >= 87) + (n >= 99) + (n >= 113);
}
__device__ __forceinline__ float lam_value(Frame& F, int lane) {
    const float a = F.in[I_LQ1][lane] * F.in[I_LK1][lane], b = F.in[I_LQ2][lane] * F.in[I_LK2][lane];
    return expf(wave_sum(a)) - expf(wave_sum(b)) + LAMINIT;
}

__device__ __forceinline__ int win_src_col(int n) {
    if (n < ZQR || n >= ZVR) return n;
    const int p = (n - ZQR) & 63;
    return (n - p) + (p >> 1) + 32 * (p & 1);
}
__device__ __forceinline__ void p0_transpose_item(const float* W, int K, int N, bf16* WT, int row_off, LAS float* scr, int item, int lane, const float* gk, bool perm) {
    const int nblk = N / 32, kb = item / nblk, nb = item % nblk, k0 = 64 * kb, n0 = 32 * nb;
    const int sc = perm ? win_src_col(n0 + (lane & 31)) : n0 + (lane & 31);
#pragma unroll 8
    for (int i = 0; i < 32; ++i) { const int kk = 2 * i + (lane >> 5); float v = W[(size_t)(k0 + kk) * N + sc]; if (gk) v *= gk[k0 + kk]; scr[kk * 33 + (lane & 31)] = v; }
    LDS_WAIT(); asm volatile("" ::: "memory");
    const int c = lane & 7;
#pragma unroll
    for (int j = 0; j < 4; ++j) { const int n = (lane >> 3) + 8 * j; const LAS float* s = scr + (8 * c) * 33 + n;
        v4u o; o.x = pk2(s[0 * 33], s[1 * 33]); o.y = pk2(s[2 * 33], s[3 * 33]); o.z = pk2(s[4 * 33], s[5 * 33]); o.w = pk2(s[6 * 33], s[7 * 33]);
        *(GAS v4u*)(WT + (size_t)(row_off + n0 + n) * K + k0 + 8 * c) = o; }
    LDS_WAIT(); asm volatile("" ::: "memory");
}
__device__ __forceinline__ void rms_row_to_bf16(int lane, const float* xrow, const float* g, bf16* orow) {
    const GAS f32x4* xr = (const GAS f32x4*)xrow + lane; const GAS f32x4* gr = (const GAS f32x4*)g + lane;
    f32x4 v[4]; float s = 0.f;
#pragma unroll
    for (int j = 0; j < 4; ++j) { v[j] = xr[64 * j]; s += (v[j].x * v[j].x + v[j].y * v[j].y) + (v[j].z * v[j].z + v[j].w * v[j].w); }
    const float rstd = 1.f / sqrtf(wave_sum(s) * (1.f / DM) + EPS);
    GAS unsigned long long* o8 = (GAS unsigned long long*)orow + lane;
#pragma unroll
    for (int j = 0; j < 4; ++j) { const f32x4 gv = gr[64 * j];
        o8[64 * j] = (unsigned long long)pk2(v[j].x * rstd * gv.x, v[j].y * rstd * gv.y) | ((unsigned long long)pk2(v[j].z * rstd * gv.z, v[j].w * rstd * gv.w) << 32); }
}
__device__ __forceinline__ void p0_prologue(Frame& F) {
    const int lane = fresh_tid() & 63;
    LAS float* scr = (LAS float*)(F.lds + RING_OFF + F.wave * 16384);
    const int gw = F.vcu * NWAVES + F.wave, NGW = F.G * NWAVES;
    constexpr int I_IN = 16 * 96, I_SQ = 16 * 32, I_UP = 16 * 128, I_DN = 64 * 32;
    constexpr int NITEMS = I_IN + 5 * I_SQ + I_UP + I_DN;
    for (int it = gw; it < NITEMS; it += NGW) {
        int r = it;
        if (r < I_IN) { p0_transpose_item(F.in[I_WIN], DM, DIN, WSP(bf16, WS_WIN), 0, scr, r, lane, nullptr, true); continue; } r -= I_IN;
        if (r < I_SQ) { p0_transpose_item(F.in[I_WOUT], DM, DM, WSP(bf16, WS_WOUT), 0, scr, r, lane, nullptr, false); continue; } r -= I_SQ;
        if (r < I_SQ) { p0_transpose_item(F.in[I_WMQ], DM, DM, WSP(bf16, WS_WMQ), 0, scr, r, lane, F.in[I_NMEMQ], false); continue; } r -= I_SQ;
        if (r < I_SQ) { p0_transpose_item(F.in[I_WMK], DM, DM, WSP(bf16, WS_WMKV), 0, scr, r, lane, nullptr, false); continue; } r -= I_SQ;
        if (r < I_SQ) { p0_transpose_item(F.in[I_WMV], DM, DM, WSP(bf16, WS_WMKV), DM, scr, r, lane, nullptr, false); continue; } r -= I_SQ;
        if (r < I_SQ) { p0_transpose_item(F.in[I_WMO], DM, DM, WSP(bf16, WS_WMO), 0, scr, r, lane, nullptr, false); continue; } r -= I_SQ;
        if (r < I_UP) { p0_transpose_item(F.in[I_WUP], DM, FF, WSP(bf16, WS_WUP), 0, scr, r, lane, F.in[I_NMLP], false); continue; } r -= I_UP;
        p0_transpose_item(F.in[I_WDN], FF, DM, WSP(bf16, WS_WDN), 0, scr, r, lane, nullptr, false);
    }
    bf16* XN = WSP(bf16, WS_XN); bf16* MEMN = WSP(bf16, WS_MEMN);
    for (int m = gw; m < MPAD + 2 * NMEM; m += NGW) {
        if (m < MP) rms_row_to_bf16(lane, F.in[I_XP] + (size_t)m * DM, F.in[I_NMIX], XN + (size_t)m * DM);
        else if (m < MV) rms_row_to_bf16(lane, F.in[I_XS] + (size_t)(m - MP) * DM, F.in[I_NMIX], XN + (size_t)m * DM);
        else if (m < MPAD) { GAS v4u* o = (GAS v4u*)(XN + (size_t)m * DM) + lane; o[0] = (v4u){0u, 0u, 0u, 0u}; o[64] = (v4u){0u, 0u, 0u, 0u}; }
        else rms_row_to_bf16(lane, F.in[I_MEMP] + (size_t)(m - MPAD) * DM, F.in[I_NMEMKV], MEMN + (size_t)(m - MPAD) * DM);
    }
}

__device__ __forceinline__ f32x4 silu4(f32x4 x) {
    f32x4 r;
    r.x = x.x * __builtin_amdgcn_rcpf(1.f + __builtin_amdgcn_exp2f(-x.x * LOG2E)); r.y = x.y * __builtin_amdgcn_rcpf(1.f + __builtin_amdgcn_exp2f(-x.y * LOG2E));
    r.z = x.z * __builtin_amdgcn_rcpf(1.f + __builtin_amdgcn_exp2f(-x.z * LOG2E)); r.w = x.w * __builtin_amdgcn_rcpf(1.f + __builtin_amdgcn_exp2f(-x.w * LOG2E));
    return r;
}
__device__ __forceinline__ void st_bf16(bf16* p, float v) { *(GAS unsigned short*)p = (unsigned short)f2bf(v); }

struct EpiZ {
    static constexpr bool PERM = true, AFTER_DRAIN = false;
    bf16* Z; float* out; bf16* KRT; bf16* VRT;
    __device__ __forceinline__ void operator()(const pg8::f32x4 (&acc)[2][2][4][2], const pg8::Unit& u, int wr, int wc, int fr, int fq) const {
        const int pn = u.pn, row0 = u.pm * 256 + wr * 64 + fr, colw = wc * 32 + 8 * fq;
        if (pn < 2 || pn >= 10) {
#pragma unroll
            for (int ai = 0; ai < 2; ++ai)
#pragma unroll
                for (int m = 0; m < 4; ++m) { const int row = row0 + ai * 128 + m * 16; bf16* zp = Z + (size_t)row * DIN + pn * 256 + colw;
#pragma unroll
                    for (int bj = 0; bj < 2; ++bj) { f32x4 v0 = acc[ai][bj][m][0], v1 = acc[ai][bj][m][1];
                        if (pn < 2) { v0 = v0 * C2A; v1 = v1 * C2A; } else { v0 = silu4(v0); v1 = silu4(v1); }
                        *(GAS v4u*)(zp + bj * 128) = pack8(v0, v1); } }
        } else if (pn < 6) {
            const bool isK = pn < 4; const int cb = (pn & 1) * 256;
#pragma unroll
            for (int ai = 0; ai < 2; ++ai)
#pragma unroll
                for (int m = 0; m < 4; ++m) { const int row = row0 + ai * 128 + m * 16; bf16* zp = Z + (size_t)row * DIN + pn * 256 + colw;
                    float* dst = nullptr;
                    if (row < MP) dst = out + (isK ? OK_P : OV_P) + (size_t)row * 512; else if (row < MV) dst = out + (isK ? OK_S : OV_S) + (size_t)(row - MP) * 512;
#pragma unroll
                    for (int bj = 0; bj < 2; ++bj) { const f32x4 v0 = acc[ai][bj][m][0], v1 = acc[ai][bj][m][1]; const int c = cb + bj * 128 + colw;
                        if (dst) { *(GAS f32x4*)(dst + c) = v0; *(GAS f32x4*)(dst + c + 4) = v1; }
                        *(GAS v4u*)(zp + bj * 128) = pack8(v0, v1); } }
        } else if (pn < 8) {
            const bool isKr = pn == 7; const int j0 = 16 * (wc & 1) + 4 * fq, p0 = colw & 63;
            float invf[4];
#pragma unroll
            for (int i = 0; i < 4; ++i) invf[i] = exp2f(-(float)(j0 + i) * (13.287712379549449f / 31.0f));
            const float l2g0 = log2gamma(wc >> 1), l2g1 = log2gamma(2 + (wc >> 1));
#pragma unroll
            for (int ai = 0; ai < 2; ++ai)
#pragma unroll
                for (int m = 0; m < 4; ++m) { const int row = row0 + ai * 128 + m * 16; const int pos = row < MP ? (row & (TSEQ - 1)) : PASTLEN;
                    float cs[4], sn[4];
#pragma unroll
                    for (int i = 0; i < 4; ++i) { const float ang = (float)pos * invf[i]; double rv = (double)ang * 0.15915494309189535; rv -= floor(rv); const float rf = (float)rv;
                        sn[i] = __builtin_amdgcn_sinf(rf); cs[i] = __builtin_amdgcn_cosf(rf); }
                    const int t = row & (TSEQ - 1), b = row >> 13;
#pragma unroll
                    for (int bj = 0; bj < 2; ++bj) { const f32x4 v0 = acc[ai][bj][m][0], v1 = acc[ai][bj][m][1]; const int head = 2 * bj + (wc >> 1);
                        float y[8];
                        y[0] = v0.x * cs[0] - v0.y * sn[0]; y[1] = v0.y * cs[0] + v0.x * sn[0]; y[2] = v0.z * cs[1] - v0.w * sn[1]; y[3] = v0.w * cs[1] + v0.z * sn[1];
                        y[4] = v1.x * cs[2] - v1.y * sn[2]; y[5] = v1.y * cs[2] + v1.x * sn[2]; y[6] = v1.z * cs[3] - v1.w * sn[3]; y[7] = v1.w * cs[3] + v1.z * sn[3];
                        if (isKr) {
#pragma unroll
                            for (int e = 0; e < 8; ++e) y[e] *= 0.125f; }
                        *(GAS v4u*)(Z + (size_t)row * DIN + pn * 256 + bj * 128 + colw) = pack8((f32x4){y[0], y[1], y[2], y[3]}, (f32x4){y[4], y[5], y[6], y[7]});
                        if (isKr && row < MP) { const float dec = exp2f((float)(127 - (t & 127)) * (bj ? l2g1 : l2g0));
                            bf16* kp = KRT + ((size_t)((b * 4 + head) * 64 + p0)) * TSEQ + t;
#pragma unroll
                            for (int e = 0; e < 8; ++e) st_bf16(kp + (size_t)e * TSEQ, y[e] * dec); } } }
        } else {
#pragma unroll
            for (int ai = 0; ai < 2; ++ai)
#pragma unroll
                for (int m = 0; m < 4; ++m) { const int row = row0 + ai * 128 + m * 16; const int t = row & (TSEQ - 1), b = row >> 13;
#pragma unroll
                    for (int bj = 0; bj < 2; ++bj) { const f32x4 v0 = acc[ai][bj][m][0], v1 = acc[ai][bj][m][1]; const int head = (pn - 8) * 2 + bj;
                        *(GAS v4u*)(Z + (size_t)row * DIN + pn * 256 + bj * 128 + colw) = pack8(v0, v1);
                        if (row < MP) { bf16* vp = VRT + ((size_t)((b * 4 + head) * 128 + colw)) * TSEQ + t;
                            st_bf16(vp, v0.x); st_bf16(vp + (size_t)TSEQ, v0.y); st_bf16(vp + (size_t)2 * TSEQ, v0.z); st_bf16(vp + (size_t)3 * TSEQ, v0.w);
                            st_bf16(vp + (size_t)4 * TSEQ, v1.x); st_bf16(vp + (size_t)5 * TSEQ, v1.y); st_bf16(vp + (size_t)6 * TSEQ, v1.z); st_bf16(vp + (size_t)7 * TSEQ, v1.w); } } }
        }
    }
};
struct EpiMemKV {
    static constexpr bool PERM = true, AFTER_DRAIN = false;
    float* out; bf16* MKB; bf16* MVT;
    __device__ __forceinline__ void operator()(const pg8::f32x4 (&acc)[2][2][4][2], const pg8::Unit& u, int wr, int wc, int fr, int fq) const {
        const int pn = u.pn, row0 = u.pm * 256 + wr * 64 + fr, colw = wc * 32 + 8 * fq; const bool isK = pn < 4;
#pragma unroll
        for (int ai = 0; ai < 2; ++ai)
#pragma unroll
            for (int m = 0; m < 4; ++m) { const int row = row0 + ai * 128 + m * 16;
#pragma unroll
                for (int bj = 0; bj < 2; ++bj) { const f32x4 v0 = acc[ai][bj][m][0], v1 = acc[ai][bj][m][1]; const int c = (pn & 3) * 256 + bj * 128 + colw;
                    float* dst = out + (isK ? OMK : OMV) + (size_t)row * DM + c;
                    *(GAS f32x4*)dst = v0; *(GAS f32x4*)(dst + 4) = v1;
                    if (isK) *(GAS v4u*)(MKB + (size_t)row * DM + c) = pack8(v0, v1);
                    else { bf16* vp = MVT + (size_t)c * 512 + row;
                        st_bf16(vp, v0.x); st_bf16(vp + 512, v0.y); st_bf16(vp + 1024, v0.z); st_bf16(vp + 1536, v0.w); st_bf16(vp + 2048, v1.x); st_bf16(vp + 2560, v1.y); st_bf16(vp + 3072, v1.z); st_bf16(vp + 3584, v1.w); } } }
    }
};
struct EpiRes {
    static constexpr bool PERM = false, AFTER_DRAIN = false;
    const float* baseP; const float* baseS; float* out; bf16* outb; float* ssq;
    __device__ __forceinline__ void operator()(const pg8::f32x4 (&acc)[2][2][4][2], const pg8::Unit& u, int wr, int wc, int fr, int fq) const {
#pragma unroll
        for (int ai = 0; ai < 2; ++ai) {
            if (u.pm * 256 + ai * 128 >= MV) continue;
#pragma unroll
            for (int m = 0; m < 4; ++m) { const int row = u.pm * 256 + ai * 128 + wr * 64 + m * 16 + fr;
                const float* bp = row < MP ? baseP + (size_t)row * DM : baseS + (size_t)(row - MP) * DM; float ss = 0.f;
#pragma unroll
                for (int bj = 0; bj < 2; ++bj)
#pragma unroll
                    for (int n = 0; n < 2; ++n) { const int c = u.pn * 256 + bj * 128 + wc * 32 + n * 16 + 4 * fq;
                        const f32x4 o = *(const GAS f32x4*)(bp + c) + acc[ai][bj][m][n];
                        *(GAS f32x4*)(out + (size_t)row * DM + c) = o;
                        if (outb) { u32x2 w; w.x = pg8::cvt_pk_bf16(o.x, o.y); w.y = pg8::cvt_pk_bf16(o.z, o.w); *(GAS u32x2*)(outb + (size_t)row * DM + c) = w; }
                        ss += (o.x * o.x + o.y * o.y) + (o.z * o.z + o.w * o.w); }
                ss += __shfl_xor(ss, 16); ss += __shfl_xor(ss, 32);
                if (fq == 0) ssq[(size_t)row * 16 + u.pn * 4 + wc] = ss; }
        }
    }
};
__device__ __forceinline__ float rstd_from_ssq(const float* ssq, int row) {
    const GAS f32x4* p = (const GAS f32x4*)(ssq + (size_t)row * 16); const f32x4 a = p[0], b = p[1], c = p[2], d = p[3];
    const float s = ((a.x + a.y) + (a.z + a.w)) + ((b.x + b.y) + (b.z + b.w)) + ((c.x + c.y) + (c.z + c.w)) + ((d.x + d.y) + (d.z + d.w));
    return 1.f / sqrtf(s * (1.f / DM) + EPS);
}
template <int ACT  > struct EpiScale {
    static constexpr bool PERM = true, AFTER_DRAIN = false;
    bf16* O; int ldc; const float* ssq; float scale;
    __device__ __forceinline__ void operator()(const pg8::f32x4 (&acc)[2][2][4][2], const pg8::Unit& u, int wr, int wc, int fr, int fq) const {
        const int row0 = u.pm * 256 + wr * 64 + fr, colw = u.pn * 256 + wc * 32 + 8 * fq;
#pragma unroll
        for (int ai = 0; ai < 2; ++ai)
#pragma unroll
            for (int m = 0; m < 4; ++m) { const int row = row0 + ai * 128 + m * 16; const float rs = rstd_from_ssq(ssq, row) * scale;
#pragma unroll
                for (int bj = 0; bj < 2; ++bj) { f32x4 v0 = acc[ai][bj][m][0] * rs, v1 = acc[ai][bj][m][1] * rs;
                    if (ACT == 1) { v0.x = fmaxf(v0.x, 0.f); v0.y = fmaxf(v0.y, 0.f); v0.z = fmaxf(v0.z, 0.f); v0.w = fmaxf(v0.w, 0.f); v1.x = fmaxf(v1.x, 0.f); v1.y = fmaxf(v1.y, 0.f); v1.z = fmaxf(v1.z, 0.f); v1.w = fmaxf(v1.w, 0.f);
                        v0 = v0 * v0; v1 = v1 * v1; }
                    *(GAS v4u*)(O + (size_t)row * ldc + bj * 128 + colw) = pack8(v0, v1); } }
    }
};
struct EpiPlain {
    static constexpr bool PERM = true, AFTER_DRAIN = false;
    bf16* O; int ldc;
    __device__ __forceinline__ void operator()(const pg8::f32x4 (&acc)[2][2][4][2], const pg8::Unit& u, int wr, int wc, int fr, int fq) const {
        const int row0 = u.pm * 256 + wr * 64 + fr, colw = u.pn * 256 + wc * 32 + 8 * fq;
#pragma unroll
        for (int ai = 0; ai < 2; ++ai)
#pragma unroll
            for (int m = 0; m < 4; ++m) { const int row = row0 + ai * 128 + m * 16;
#pragma unroll
                for (int bj = 0; bj < 2; ++bj) *(GAS v4u*)(O + (size_t)row * ldc + bj * 128 + colw) = pack8(acc[ai][bj][m][0], acc[ai][bj][m][1]); }
    }
};
struct EpiSoftmax {
    static constexpr bool PERM = true, AFTER_DRAIN = true;
    bf16* O; int ldc;
    __device__ __forceinline__ void fused(pg8::f32x4 (&acc)[2][2][4][2], const pg8::Unit& u, int wr, int wc, int fr, int fq, PG8_LAS unsigned char* lds, int wid, int lane) const {
        PG8_LAS float* PMX = (PG8_LAS float*)lds;
        PG8_LAS float* PSM = (PG8_LAS float*)(lds + 4096);
#pragma unroll
        for (int ai = 0; ai < 2; ++ai)
#pragma unroll
            for (int m = 0; m < 4; ++m) { float mx = -INFINITY;
#pragma unroll
                for (int bj = 0; bj < 2; ++bj)
#pragma unroll
                    for (int n = 0; n < 2; ++n) { const pg8::f32x4 x = acc[ai][bj][m][n]; mx = fmaxf(mx, fmaxf(fmaxf(x.x, x.y), fmaxf(x.z, x.w))); }
                mx = fmaxf(mx, __shfl_xor(mx, 16)); mx = fmaxf(mx, __shfl_xor(mx, 32));
                if (fq == 0) PMX[(ai * 128 + wr * 64 + m * 16 + fr) * 4 + wc] = mx; }
        asm volatile("s_waitcnt lgkmcnt(0)" ::: "memory"); __builtin_amdgcn_s_barrier(); asm volatile("" ::: "memory");
#pragma unroll
        for (int ai = 0; ai < 2; ++ai)
#pragma unroll
            for (int m = 0; m < 4; ++m) { const int r = ai * 128 + wr * 64 + m * 16 + fr; const pg8::f32x4 q = *(const PG8_LAS pg8::f32x4*)(PMX + r * 4);
                const float mx = fmaxf(fmaxf(q.x, q.y), fmaxf(q.z, q.w)); float s = 0.f;
#pragma unroll
                for (int bj = 0; bj < 2; ++bj)
#pragma unroll
                    for (int n = 0; n < 2; ++n) { pg8::f32x4 x = acc[ai][bj][m][n];
                        x.x = __builtin_amdgcn_exp2f(x.x - mx); x.y = __builtin_amdgcn_exp2f(x.y - mx); x.z = __builtin_amdgcn_exp2f(x.z - mx); x.w = __builtin_amdgcn_exp2f(x.w - mx);
                        acc[ai][bj][m][n] = x; s += (x.x + x.y) + (x.z + x.w); }
                s += __shfl_xor(s, 16); s += __shfl_xor(s, 32);
                if (fq == 0) PSM[r * 4 + wc] = s; }
        asm volatile("s_waitcnt lgkmcnt(0)" ::: "memory"); __builtin_amdgcn_s_barrier(); asm volatile("" ::: "memory");
        const int colw = wc * 32 + 8 * fq;
#pragma unroll
        for (int ai = 0; ai < 2; ++ai)
#pragma unroll
            for (int m = 0; m < 4; ++m) { const int r = ai * 128 + wr * 64 + m * 16 + fr; const pg8::f32x4 q = *(const PG8_LAS pg8::f32x4*)(PSM + r * 4);
                const float inv = 1.f / ((q.x + q.y) + (q.z + q.w));
#pragma unroll
                for (int bj = 0; bj < 2; ++bj) *(GAS v4u*)(O + (size_t)(u.pm * 256 + r) * ldc + bj * 128 + colw) = pack8(acc[ai][bj][m][0] * inv, acc[ai][bj][m][1] * inv); }
    }
};

__device__ __forceinline__ f32x16 mfma32(bf16x8 a, bf16x8 b, f32x16 c) { return __builtin_amdgcn_mfma_f32_32x32x16_bf16(a, b, c, 0, 0, 0); }
__device__ __forceinline__ int crow16(int r, int hh) { return (r & 3) + 8 * (r >> 2) + 4 * hh; }

__device__ __forceinline__ void ret_stepA(Frame& F, int bh, int c) {
    const int tid = fresh_tid(), lane = tid & 63; (void)tid; (void)lane;
    const int w = F.wave, r = lane & 31, hh = lane >> 5, db = w >> 2, eb = w & 3;
    const bf16* ka = WSP(bf16, WS_KRT) + ((size_t)(bh * 64 + 32 * db + r)) * TSEQ + c * 128 + 8 * hh;
    const bf16* va = WSP(bf16, WS_VRT) + ((size_t)(bh * 128 + 32 * eb + r)) * TSEQ + c * 128 + 8 * hh;
    bf16x8 af[8], bfr[8];
#pragma unroll
    for (int ks = 0; ks < 8; ++ks) { af[ks] = *(const GAS bf16x8*)(ka + 16 * ks); bfr[ks] = *(const GAS bf16x8*)(va + 16 * ks); }
    f32x16 acc = {};
#pragma unroll
    for (int ks = 0; ks < 8; ++ks) acc = mfma32(af[ks], bfr[ks], acc);
    float* up = WSP(float, WS_U) + ((size_t)(bh * 64 + c) * 64 + 32 * db) * 128 + 32 * eb + r;
#pragma unroll
    for (int q = 0; q < 16; ++q) up[(size_t)crow16(q, hh) * 128] = acc[q];
}

__device__ __forceinline__ void dec_attn_unit(Frame& F, int s, int hp) {
    const int tid = fresh_tid(), lane = tid & 63; (void)tid; (void)lane;
    LAS float* sc = (LAS float*)(F.lds);
    LAS float* wm = (LAS float*)(F.lds + 36864);
    LAS float* wo = (LAS float*)(F.lds + 40960);
    const LAS float* tab = (const LAS float*)(F.lds + TAB_OFF);
    const int w = F.wave, l = lane, hsel = l >> 5, f = l & 31, g = l >> 4, h = 2 * hp + hsel, row = MP + s;
    const bf16* Z = WSP(bf16, WS_Z);
    const u32x2 qq = *(const GAS u32x2*)(Z + (size_t)row * DIN + ZQA + h * 128 + 4 * f);
    const f32x4 q4 = {bflo(qq.x), bfhi(qq.x), bflo(qq.y), bfhi(qq.y)};
    const int* pt = (const int*)F.in[I_PT] + s * 16;
    const int pg0 = __builtin_amdgcn_readfirstlane(pt[2 * w]), pg1 = __builtin_amdgcn_readfirstlane(pt[2 * w + 1]);
    LAS float* scw = sc + w * 1040;
    const LAS float* tabh = tab + h * 128;
    const float* ck = F.in[I_CK]; const float* cv = F.in[I_CV];
    for (int kk0 = 0; kk0 < 256; kk0 += 8) {
        const int page = kk0 < 128 ? pg0 : pg1; f32x4 kv[8];
#pragma unroll
        for (int i = 0; i < 8; ++i) kv[i] = *(const GAS f32x4*)(ck + ((size_t)(page * 128 + ((kk0 + i) & 127)) * 4 + 2 * hp) * 128 + 4 * l);
#pragma unroll
        for (int i = 0; i < 8; ++i) { float p = (kv[i].x * q4.x + kv[i].y * q4.y) + (kv[i].z * q4.z + kv[i].w * q4.w); p = row16_sum(p);
            const int rel = PASTLEN - (w * 256 + kk0 + i); const float bsv = tabh[rel < 127 ? rel : 127];
            if ((l & 15) == 0) scw[(kk0 + i) * 4 + g] = p + bsv; }
    }
    const int nk = (w == 0) ? 257 : 256;
    if (w == 0) { const f32x4 kn = *(const GAS f32x4*)(F.out + OK_S + (size_t)s * 512 + h * 128 + 4 * f);
        float p = (kn.x * q4.x + kn.y * q4.y) + (kn.z * q4.z + kn.w * q4.w); p = row16_sum(p);
        if ((l & 15) == 0) scw[256 * 4 + g] = p + tabh[0]; }
    LDS_WAIT(); asm volatile("" ::: "memory");
    float mg0, mg1, mg2, mg3, lg0, lg1, lg2, lg3;
    { float m0 = -INFINITY, m1 = -INFINITY, m2 = -INFINITY, m3 = -INFINITY;
      for (int kk = l; kk < nk; kk += 64) { const f32x4 v = *(const LAS f32x4*)(scw + kk * 4); m0 = fmaxf(m0, v.x); m1 = fmaxf(m1, v.y); m2 = fmaxf(m2, v.z); m3 = fmaxf(m3, v.w); }
      mg0 = wave_max(m0); mg1 = wave_max(m1); mg2 = wave_max(m2); mg3 = wave_max(m3);
      float s0 = 0.f, s1 = 0.f, s2 = 0.f, s3 = 0.f;
      for (int kk = l; kk < nk; kk += 64) { f32x4 v = *(const LAS f32x4*)(scw + kk * 4);
          v.x = __builtin_amdgcn_exp2f(v.x - mg0); v.y = __builtin_amdgcn_exp2f(v.y - mg1); v.z = __builtin_amdgcn_exp2f(v.z - mg2); v.w = __builtin_amdgcn_exp2f(v.w - mg3);
          *(LAS f32x4*)(scw + kk * 4) = v; s0 += v.x; s1 += v.y; s2 += v.z; s3 += v.w; }
      lg0 = wave_sum(s0); lg1 = wave_sum(s1); lg2 = wave_sum(s2); lg3 = wave_sum(s3); }
    LDS_WAIT(); asm volatile("" ::: "memory");
    f32x4 o1 = {0.f, 0.f, 0.f, 0.f}, o2 = {0.f, 0.f, 0.f, 0.f};
    for (int kk0 = 0; kk0 < 256; kk0 += 8) {
        const int page = kk0 < 128 ? pg0 : pg1; f32x4 vv[8];
#pragma unroll
        for (int i = 0; i < 8; ++i) vv[i] = *(const GAS f32x4*)(cv + ((size_t)(page * 128 + ((kk0 + i) & 127)) * 4 + 2 * hp) * 128 + 4 * l);
#pragma unroll
        for (int i = 0; i < 8; ++i) { const float p1 = scw[(kk0 + i) * 4 + hsel * 2], p2 = scw[(kk0 + i) * 4 + hsel * 2 + 1]; o1 = o1 + vv[i] * p1; o2 = o2 + vv[i] * p2; }
    }
    if (w == 0) { const f32x4 vn = *(const GAS f32x4*)(F.out + OV_S + (size_t)s * 512 + h * 128 + 4 * f);
        const float p1 = scw[256 * 4 + hsel * 2], p2 = scw[256 * 4 + hsel * 2 + 1]; o1 = o1 + vn * p1; o2 = o2 + vn * p2; }
    if (l < 4) { const float mv = l == 0 ? mg0 : l == 1 ? mg1 : l == 2 ? mg2 : mg3, lv = l == 0 ? lg0 : l == 1 ? lg1 : l == 2 ? lg2 : lg3; wm[w * 4 + l] = mv; wm[32 + w * 4 + l] = lv; }
    *(LAS f32x4*)(wo + ((w * 2 + 0) * 64 + l) * 4) = o1; *(LAS f32x4*)(wo + ((w * 2 + 1) * 64 + l) * 4) = o2;
    LDS_WAIT(); __syncthreads();
    if (tid < 128) { const int map = tid >> 6, ll = tid & 63, gg = (ll >> 5) * 2 + map;
        float M = -INFINITY;
#pragma unroll
        for (int ww = 0; ww < 8; ++ww) M = fmaxf(M, wm[ww * 4 + gg]);
        float L = 0.f; f32x4 o = {0.f, 0.f, 0.f, 0.f};
#pragma unroll
        for (int ww = 0; ww < 8; ++ww) { const float e = __builtin_amdgcn_exp2f(wm[ww * 4 + gg] - M); L += wm[32 + ww * 4 + gg] * e; o = o + *(const LAS f32x4*)(wo + ((ww * 2 + map) * 64 + ll) * 4) * e; }
        const float inv = 1.f / L; u32x2 ov; ov.x = pk2(o.x * inv, o.y * inv); ov.y = pk2(o.z * inv, o.w * inv);
        *(GAS u32x2*)(WSP(bf16, WS_OA) + (size_t)row * DM + map * 512 + (2 * hp + (ll >> 5)) * 128 + 4 * (ll & 31)) = ov; }
    LDS_WAIT(); __syncthreads();
}

__device__ __forceinline__ void dec_ret_unit(Frame& F, int s, int h) {
    const int tid = fresh_tid(), lane = tid & 63; (void)tid; (void)lane;
    LAS float* part = (LAS float*)(F.lds);
    LAS float* half = (LAS float*)(F.lds + 2048);
    const int e = tid & 127, dg = tid >> 7, row = MP + s;
    const bf16* Zr = WSP(bf16, WS_Z) + (size_t)row * DIN;
    const float gam = 1.0f - exp2f(-(float)(5 + h));
    const float v = bf2f(Zr[ZVR + h * 128 + e]);
    const float* Sin = F.in[I_SRET] + ((size_t)(s * 4 + h) * 64) * 128 + e; float* Sout = F.out + OS_S + ((size_t)(s * 4 + h) * 64) * 128 + e;
    float op = 0.f;
#pragma unroll 4
    for (int i = 0; i < 16; ++i) { const int d = dg * 16 + i, p = 2 * (d & 31) + (d >> 5);
        const float kq = bf2f(Zr[ZKR + h * 64 + p]), qq = bf2f(Zr[ZQR + h * 64 + p]);
        const float sn = gam * Sin[(size_t)d * 128] + kq * v; Sout[(size_t)d * 128] = sn; op += qq * sn; }
    part[dg * 128 + e] = op;
    LDS_WAIT(); __syncthreads();
    float o = 0.f;
    if (tid < 128) { o = (part[e] + part[128 + e]) + (part[256 + e] + part[384 + e]); const float ss = wave_sum(o * o); if (lane == 0) half[F.wave] = ss; }
    LDS_WAIT(); __syncthreads();
    if (tid < 128) { const float rs = 1.f / sqrtf((half[0] + half[1]) * (1.f / 128.f) + EPS);
        st_bf16(WSP(bf16, WS_MIX) + (size_t)row * DM + 512 + h * 128 + e, o * rs * bf2f(Zr[ZGR + h * 128 + e])); }
    LDS_WAIT(); __syncthreads();
}

__device__ __forceinline__ void ret_scan(Frame& F, int wgi) {
    const int tid = fresh_tid(), lane = tid & 63; (void)tid; (void)lane;
    const int bh = wgi >> 4, p = (wgi & 15) * 4 + (tid >> 7), e = tid & 127, h = bh & 3;
    const float g = exp2f(128.f * log2gamma(h));
    const float* up = WSP(float, WS_U) + ((size_t)(bh * 64) * 64 + p) * 128 + e;
    bf16* sp = WSP(bf16, WS_SPT) + ((size_t)(bh * 64) * 128 + e) * 64 + p;
    float st = 0.f;
    for (int c0 = 0; c0 < 64; c0 += 8) { float uu[8];
#pragma unroll
        for (int i = 0; i < 8; ++i) uu[i] = up[(size_t)(c0 + i) * 8192];
#pragma unroll
        for (int i = 0; i < 8; ++i) { st_bf16(sp + (size_t)(c0 + i) * 8192, st); st = g * st + uu[i]; } }
    const int dn = (p >> 1) + 32 * (p & 1);
    F.out[OS_P + ((size_t)(bh * 64 + dn)) * 128 + e] = st;
}
__device__ __forceinline__ void merge_a_rows(Frame& F) {
    const int tid = fresh_tid(), lane = tid & 63; (void)tid; (void)lane;
    const int gw = F.vcu * NWAVES + F.wave, NGW = F.G * NWAVES, l = lane;
    const float lam = lam_value(F, lane);
    const f32x4 g0 = *(const GAS f32x4*)(F.in[I_SUBLN] + (8 * l & 127)), g1 = *(const GAS f32x4*)(F.in[I_SUBLN] + (8 * l & 127) + 4);
    const bf16* OA = WSP(bf16, WS_OA); bf16* MIX = WSP(bf16, WS_MIX);
    for (int m = gw; m < MV; m += NGW) {
        const v4u a = *(const GAS v4u*)(OA + (size_t)m * DM + 8 * l), b = *(const GAS v4u*)(OA + (size_t)m * DM + 512 + 8 * l);
        float x[8];
        x[0] = bflo(a.x) - lam * bflo(b.x); x[1] = bfhi(a.x) - lam * bfhi(b.x); x[2] = bflo(a.y) - lam * bflo(b.y); x[3] = bfhi(a.y) - lam * bfhi(b.y);
        x[4] = bflo(a.z) - lam * bflo(b.z); x[5] = bfhi(a.z) - lam * bfhi(b.z); x[6] = bflo(a.w) - lam * bflo(b.w); x[7] = bfhi(a.w) - lam * bfhi(b.w);
        float ss = 0.f;
#pragma unroll
        for (int i = 0; i < 8; ++i) ss += x[i] * x[i];
        ss = row16_sum(ss);
        const float rs = ONE_M_LAMINIT / sqrtf(ss * (1.f / 128.f) + EPS);
        v4u o; o.x = pk2(x[0] * rs * g0.x, x[1] * rs * g0.y); o.y = pk2(x[2] * rs * g0.z, x[3] * rs * g0.w); o.z = pk2(x[4] * rs * g1.x, x[5] * rs * g1.y); o.w = pk2(x[6] * rs * g1.z, x[7] * rs * g1.w);
        *(GAS v4u*)(MIX + (size_t)m * DM + 8 * l) = o;
    }
}

__device__ __forceinline__ void ret_stepC(Frame& F, int bh, int c) {
    const int tid = fresh_tid(), lane = tid & 63; (void)tid; (void)lane;
    LAS float* psum = (LAS float*)(F.lds);
    const int w = F.wave, r = lane & 31, hh = lane >> 5, rb = w >> 1, ch = w & 1, b = bh >> 2, h = bh & 3;
    const size_t row0 = (size_t)b * TSEQ + c * 128;
    const bf16* Z = WSP(bf16, WS_Z);
    const float l2g = log2gamma(h);
    bf16x8 qf[4];
#pragma unroll
    for (int ks = 0; ks < 4; ++ks) qf[ks] = *(const GAS bf16x8*)(Z + (row0 + 32 * rb + r) * DIN + ZQR + h * 64 + 16 * ks + 8 * hh);
    f32x16 o[2], oc[2];
    o[0] = (f32x16){}; o[1] = (f32x16){}; oc[0] = (f32x16){}; oc[1] = (f32x16){};
    const bf16* spt = WSP(bf16, WS_SPT) + ((size_t)(bh * 64 + c) * 128 + 64 * ch + r) * 64 + 8 * hh;
#pragma unroll
    for (int eb = 0; eb < 2; ++eb)
#pragma unroll
        for (int ks = 0; ks < 4; ++ks) { const bf16x8 sb = *(const GAS bf16x8*)(spt + (size_t)(32 * eb) * 64 + 16 * ks); oc[eb] = mfma32(qf[ks], sb, oc[eb]); }
    const bf16* vt = WSP(bf16, WS_VRT) + ((size_t)(bh * 128 + 64 * ch + r)) * TSEQ + c * 128 + 4 * hh;
    for (int jb = 0; jb <= rb; ++jb) {
        f32x16 st = {};
#pragma unroll
        for (int ks = 0; ks < 4; ++ks) { const bf16x8 kf = *(const GAS bf16x8*)(Z + (row0 + 32 * jb + r) * DIN + ZKR + h * 64 + 16 * ks + 8 * hh); st = mfma32(kf, qf[ks], st); }
        const int irel = 32 * (rb - jb) + r;
#pragma unroll
        for (int q = 0; q < 16; ++q) { const int d = irel - crow16(q, hh); st[q] = d >= 0 ? st[q] * exp2f((float)d * l2g) : 0.f; }
#pragma unroll
        for (int s2 = 0; s2 < 2; ++s2) {
            v4u pw; pw.x = pg8::cvt_pk_bf16(st[8 * s2 + 0], st[8 * s2 + 1]); pw.y = pg8::cvt_pk_bf16(st[8 * s2 + 2], st[8 * s2 + 3]); pw.z = pg8::cvt_pk_bf16(st[8 * s2 + 4], st[8 * s2 + 5]); pw.w = pg8::cvt_pk_bf16(st[8 * s2 + 6], st[8 * s2 + 7]);
            const bf16x8 pa = __builtin_bit_cast(bf16x8, pw);
#pragma unroll
            for (int eb = 0; eb < 2; ++eb) { const bf16* vp = vt + (size_t)(32 * eb) * TSEQ + 32 * jb + 16 * s2;
                const u32x2 lo = *(const GAS u32x2*)vp, hi2 = *(const GAS u32x2*)(vp + 8);
                v4u vb; vb.x = lo.x; vb.y = lo.y; vb.z = hi2.x; vb.w = hi2.y;
                o[eb] = mfma32(pa, __builtin_bit_cast(bf16x8, vb), o[eb]); }
        }
    }
    float ssr[16];
#pragma unroll
    for (int q = 0; q < 16; ++q) { const float sc = exp2f((float)(32 * rb + crow16(q, hh) + 1) * l2g);
        o[0][q] += sc * oc[0][q]; o[1][q] += sc * oc[1][q];
        float ss = o[0][q] * o[0][q] + o[1][q] * o[1][q]; ss = row16_sum(ss); ss += __shfl_xor(ss, 16); ssr[q] = ss; }
    if (r == 0) {
#pragma unroll
        for (int q = 0; q < 16; ++q) psum[ch * 128 + 32 * rb + crow16(q, hh)] = ssr[q]; }
    LDS_WAIT(); __syncthreads();
    bf16* MIX = WSP(bf16, WS_MIX);
#pragma unroll
    for (int q = 0; q < 16; ++q) { const int i = 32 * rb + crow16(q, hh); const float rs = 1.f / sqrtf((psum[i] + psum[128 + i]) * (1.f / 128.f) + EPS);
#pragma unroll
        for (int eb = 0; eb < 2; ++eb) { const int e = 64 * ch + 32 * eb + r; const float gt = bf2f(Z[(row0 + i) * DIN + ZGR + h * 128 + e]);
            st_bf16(MIX + (row0 + i) * DM + 512 + h * 128 + e, o[eb][q] * rs * gt); } }
    LDS_WAIT(); __syncthreads();
}

__device__ __forceinline__ void dec_mem_unit(Frame& F, int s, int hp) {
    const int tid = fresh_tid(), lane = tid & 63; (void)tid; (void)lane;
    LAS float* sc = (LAS float*)(F.lds);
    LAS float* wo = (LAS float*)(F.lds + 4096);
    const int w = F.wave, l = lane, row = MP + s;
    const bf16* QM = WSP(bf16, WS_QM);
    f32x4 q4[2];
#pragma unroll
    for (int hs = 0; hs < 2; ++hs) { const u32x2 qq = *(const GAS u32x2*)(QM + (size_t)row * DM + (2 * hp + hs) * 256 + 4 * l); q4[hs] = (f32x4){bflo(qq.x), bfhi(qq.x), bflo(qq.y), bfhi(qq.y)}; }
    const float* ck = F.in[I_CMK] + ((size_t)s * NMEM * 4 + 2 * hp) * 256 + 4 * l; const float* cv = F.in[I_CMV] + ((size_t)s * NMEM * 4 + 2 * hp) * 256 + 4 * l;
    for (int m0 = 0; m0 < 32; m0 += 4) { f32x4 kv[8];
#pragma unroll
        for (int i = 0; i < 8; ++i) kv[i] = *(const GAS f32x4*)(ck + (size_t)(32 * w + m0 + (i >> 1)) * 1024 + (i & 1) * 256);
#pragma unroll
        for (int i = 0; i < 8; ++i) { const f32x4 q = q4[i & 1]; float p = (kv[i].x * q.x + kv[i].y * q.y) + (kv[i].z * q.z + kv[i].w * q.w); p = wave_sum(p);
            if (l == 0) sc[(i & 1) * 256 + 32 * w + m0 + (i >> 1)] = p; } }
    LDS_WAIT(); __syncthreads();
    float M[2], IL[2];
#pragma unroll
    for (int hs = 0; hs < 2; ++hs) { const f32x4 v = *(const LAS f32x4*)(sc + hs * 256 + 4 * l); const float mx = wave_max(fmaxf(fmaxf(v.x, v.y), fmaxf(v.z, v.w)));
        const float sm = (__builtin_amdgcn_exp2f(v.x - mx) + __builtin_amdgcn_exp2f(v.y - mx)) + (__builtin_amdgcn_exp2f(v.z - mx) + __builtin_amdgcn_exp2f(v.w - mx));
        M[hs] = mx; IL[hs] = 1.f / wave_sum(sm); }
    f32x4 o[2]; o[0] = (f32x4){0.f, 0.f, 0.f, 0.f}; o[1] = (f32x4){0.f, 0.f, 0.f, 0.f};
    for (int m0 = 0; m0 < 32; m0 += 4) { f32x4 vv[8];
#pragma unroll
        for (int i = 0; i < 8; ++i) vv[i] = *(const GAS f32x4*)(cv + (size_t)(32 * w + m0 + (i >> 1)) * 1024 + (i & 1) * 256);
#pragma unroll
        for (int i = 0; i < 8; ++i) { const int hs = i & 1; const float p = __builtin_amdgcn_exp2f(sc[hs * 256 + 32 * w + m0 + (i >> 1)] - M[hs]) * IL[hs]; o[hs] = o[hs] + vv[i] * p; } }
    *(LAS f32x4*)(wo + ((w * 2 + 0) * 64 + l) * 4) = o[0]; *(LAS f32x4*)(wo + ((w * 2 + 1) * 64 + l) * 4) = o[1];
    LDS_WAIT(); __syncthreads();
    if (tid < 128) { const int hs = tid >> 6, ll = tid & 63; f32x4 a = {0.f, 0.f, 0.f, 0.f};
#pragma unroll
        for (int ww = 0; ww < 8; ++ww) a = a + *(const LAS f32x4*)(wo + ((ww * 2 + hs) * 64 + ll) * 4);
        u32x2 ov; ov.x = pk2(a.x, a.y); ov.y = pk2(a.z, a.w);
        *(GAS u32x2*)(WSP(bf16, WS_OM) + (size_t)row * DM + (2 * hp + hs) * 256 + 4 * ll) = ov; }
    LDS_WAIT(); __syncthreads();
}

__device__ __forceinline__ void final_norm_rows(Frame& F) {
    const int tid = fresh_tid(), lane = tid & 63; (void)tid; (void)lane;
    const int gw = F.vcu * NWAVES + F.wave, NGW = F.G * NWAVES, l = lane;
    const float* X3 = WSP(float, WS_X3); const float* ssq = WSP(float, WS_SSQ3);
    for (int m = gw; m < MV; m += NGW) {
        float s;
        if (m < MP) s = row16_sum(ssq[(size_t)m * 16 + (l & 15)]);
        else { const f32x2 q = *(const GAS f32x2*)(WSP(float, WS_SSQS3) + (m - MP) * 32 + 2 * (l & 15)); s = row16_sum(q.x + q.y); }
        const float rs = 1.f / sqrtf(s * (1.f / DM) + EPS);
        float* dst = m < MP ? F.out + OY_P + (size_t)m * DM : F.out + OY_S + (size_t)(m - MP) * DM;
#pragma unroll
        for (int j = 0; j < 4; ++j) { const f32x4 x = *(const GAS f32x4*)(X3 + (size_t)m * DM + 256 * j + 4 * l), g = *(const GAS f32x4*)(F.in[I_NFIN] + 256 * j + 4 * l);
            *(GAS f32x4*)(dst + 256 * j + 4 * l) = x * rs * g; }
    }
}

template <int K, class Epi> __device__ __forceinline__ void sgemm_unit(Frame& F, const bf16* A, int lda, const bf16* Bt, int rb, int cb, const Epi& E) {
    const int tid = fresh_tid(), lane = tid & 63, r = lane & 31, hh = lane >> 5, w = F.wave;
    constexpr int KW = K / 8, NS = KW / 16;
    LAS float* part = (LAS float*)(F.lds);
    const bf16* ap = A + (size_t)(32 * rb + r) * lda + w * KW + 8 * hh; const bf16* bp = Bt + (size_t)(32 * cb + r) * K + w * KW + 8 * hh;
    f32x16 acc = {};
#pragma unroll
    for (int s0 = 0; s0 < NS; s0 += 8) { bf16x8 af[8], bfr[8];
#pragma unroll
        for (int i = 0; i < 8; ++i) { af[i] = *(const GAS bf16x8*)(ap + 16 * (s0 + i)); bfr[i] = *(const GAS bf16x8*)(bp + 16 * (s0 + i)); }
#pragma unroll
        for (int i = 0; i < 8; ++i) acc = mfma32(af[i], bfr[i], acc); }
#pragma unroll
    for (int q = 0; q < 16; ++q) part[(w * 32 + crow16(q, hh)) * 32 + r] = acc[q];
    LDS_WAIT(); __syncthreads();
    const int row = tid >> 4, c2 = (tid & 15) * 2; float v0 = 0.f, v1 = 0.f;
#pragma unroll
    for (int ww = 0; ww < 8; ++ww) { const LAS float* p = part + (ww * 32 + row) * 32 + c2; v0 += p[0]; v1 += p[1]; }
    E(32 * rb + row, 32 * cb + c2, v0, v1, lane);
    LDS_WAIT(); __syncthreads();
}
__device__ __forceinline__ unsigned pk2c(float a, float b) { return pg8::cvt_pk_bf16(a, b); }
struct SEpiZ {
    bf16* Z; float* out;
    __device__ __forceinline__ void operator()(int srow, int col, float v0, float v1, int lane) const {
        bf16* zp = Z + (size_t)(MP + srow) * DIN + col;
        if (col < ZKA) { v0 *= C2A; v1 *= C2A; }
        else if (col < ZQR) { float* dst = out + (col < ZVA ? OK_S + (size_t)srow * 512 + (col - ZKA) : OV_S + (size_t)srow * 512 + (col - ZVA)); *(GAS f32x2*)dst = (f32x2){v0, v1}; }
        else if (col < ZVR) { const int j = ((col - ZQR) & 63) >> 1; const float ang = (float)PASTLEN * exp2f(-(float)j * (13.287712379549449f / 31.0f));
            double rv = (double)ang * 0.15915494309189535; rv -= floor(rv); const float rf = (float)rv; const float sn = __builtin_amdgcn_sinf(rf), cs = __builtin_amdgcn_cosf(rf);
            const float y0 = v0 * cs - v1 * sn, y1 = v1 * cs + v0 * sn; const float sc = col >= ZKR ? 0.125f : 1.0f; v0 = y0 * sc; v1 = y1 * sc; }
        else if (col >= ZGR) { v0 = v0 * __builtin_amdgcn_rcpf(1.f + __builtin_amdgcn_exp2f(-v0 * LOG2E)); v1 = v1 * __builtin_amdgcn_rcpf(1.f + __builtin_amdgcn_exp2f(-v1 * LOG2E)); }
        *(GAS unsigned*)zp = pk2c(v0, v1);
    }
};
struct SEpiRes {
    const float* base; float* out; bf16* outb; float* ssq;
    __device__ __forceinline__ void operator()(int srow, int col, float v0, float v1, int lane) const {
        const f32x2 b = *(const GAS f32x2*)(base + (size_t)srow * DM + col); const float o0 = b.x + v0, o1 = b.y + v1;
        *(GAS f32x2*)(out + (size_t)srow * DM + col) = (f32x2){o0, o1};
        if (outb) *(GAS unsigned*)(outb + (size_t)srow * DM + col) = pk2c(o0, o1);
        const float ss = row16_sum(o0 * o0 + o1 * o1);
        if ((lane & 15) == 0) ssq[srow * 32 + (col >> 5)] = ss;
    }
};
template <int ACT> struct SEpiScale {
    bf16* O; int ldc; const float* ssq; float scale;
    __device__ __forceinline__ void operator()(int srow, int col, float v0, float v1, int lane) const {
        const f32x2 q = *(const GAS f32x2*)(ssq + srow * 32 + 2 * (lane & 15)); const float s = row16_sum(q.x + q.y);
        const float rs = scale / sqrtf(s * (1.f / DM) + EPS); v0 *= rs; v1 *= rs;
        if (ACT == 1) { v0 = fmaxf(v0, 0.f); v1 = fmaxf(v1, 0.f); v0 *= v0; v1 *= v1; }
        *(GAS unsigned*)(O + (size_t)srow * ldc + col) = pk2c(v0, v1);
    }
};

#ifndef PG8_SP2
#define PG8_SP2 true
#endif
#ifndef PG8_ALIGN
#define PG8_ALIGN true
#endif
struct Args { const float* in[N_IN]; float* out; unsigned char* ws; int ph_lo, ph_hi; };
__global__ void __launch_bounds__(NWAVES * 64, 2) fwd(Args args) {
    extern __shared__ __attribute__((aligned(16))) unsigned char lds[];
    Frame F;
    F.lds = (LAS unsigned char*)lds;
    F.MISC = (volatile LAS unsigned*)(F.lds + MISC_OFF);
    const int tid0 = threadIdx.x; F.wave = __builtin_amdgcn_readfirstlane(tid0 >> 6);
    F.G = gridDim.x; { const int bx = blockIdx.x; F.vcu = (F.G % 8 == 0) ? (bx % 8) * (F.G / 8) + bx / 8 : bx; }
    F.in = args.in; F.out = args.out; F.ws = args.ws;
    F.ctl = (gu32*)(args.ws + WS_CTL);
    for (int u = tid0; u < (TAB_OFF - LDSCTL_OFF) / 4; u += NWAVES * 64) ((LAS unsigned*)(F.lds + LDSCTL_OFF))[u] = 0u;
    { const int h = tid0 >> 7, rel = tid0 & 127; const float* rb = args.in[I_RELB];
      ((LAS float*)(F.lds + TAB_OFF))[tid0] = (rb[t5_bucket(rel) * 4 + h] - rb[31 * 4 + h]) * LOG2E; }
    __syncthreads();
#if MK_PER_PHASE
#define GRID_BAR() do { } while (0)
#else
    XcdBarrier bar = xcd_barrier_post((unsigned*)(F.ctl + CW_BAR), F.MISC + 8);
#define GRID_BAR() xcd_barrier(bar)
#endif
    const int lo = args.ph_lo, hi = args.ph_hi, bx = blockIdx.x;
#define IN(k) (lo <= (k) && (k) < hi)
#define BOTH(k) (IN(k) && IN((k) + 1))
    bf16* const Zb = WSP(bf16, WS_Z);

    if (IN(0)) { p0_prologue(F); if (BOTH(0)) GRID_BAR(); }

    if (IN(1)) {
        { pg8::Gemm g{WSP(bf16, WS_XN), WSP(bf16, WS_WIN), MP, DIN, DM, DM, DM}; pg8::StaticOrder S; S.init(MP, DIN, F.G, bx);
          EpiZ E{Zb, F.out, WSP(bf16, WS_KRT), WSP(bf16, WS_VRT)};
          pg8::gemm_phase<EpiZ, pg8::StaticOrder, PG8_ALIGN, PG8_SP2>(F.lds + RING_OFF, g, S, E); }
        for (int u = bx; u < 4 * (DIN / 32); u += F.G) sgemm_unit<DM>(F, WSP(bf16, WS_XN) + (size_t)MP * DM, DM, WSP(bf16, WS_WIN), u & 3, u >> 2, SEpiZ{Zb, F.out});
        if (BOTH(1)) GRID_BAR();
    }

    if (IN(2)) {
        const attn_body::StaticOrder S((int)F.G, bx); const int slot = F.vcu % 5;
        { attn_body::AttnUnit au;
          for (int i = 0; i < slot && S.next(i, au); ++i) attn_body::attn_one<8>((char*)lds + RING_OFF, (const attn_body::bf16*)Zb, (attn_body::bf16*)WSP(bf16, WS_OA), (attn_body::lds_cfp)(F.lds + TAB_OFF), au); }
        __syncthreads();
        for (int u = bx; u < 512; u += F.G) ret_stepA(F, u >> 6, u & 63);
        for (int u = bx; u < 256; u += F.G) dec_attn_unit(F, u >> 1, u & 1);
        for (int u = bx; u < 512; u += F.G) dec_ret_unit(F, u >> 2, u & 3);
        { attn_body::AttnUnit au;
          for (int i = slot; S.next(i, au); ++i) attn_body::attn_one<8>((char*)lds + RING_OFF, (const attn_body::bf16*)Zb, (attn_body::bf16*)WSP(bf16, WS_OA), (attn_body::lds_cfp)(F.lds + TAB_OFF), au); }
        if (BOTH(2)) GRID_BAR();
    }

    if (IN(3)) {
        if (bx < 128) ret_scan(F, bx);
        { pg8::Gemm g{WSP(bf16, WS_MEMN), WSP(bf16, WS_WMKV), 2 * NMEM, 2 * DM, DM, DM, DM}; pg8::StaticOrder S; S.init(2 * NMEM, 2 * DM, F.G, (bx + F.G - 128) % F.G);
          EpiMemKV E{F.out, WSP(bf16, WS_MKB), WSP(bf16, WS_MVT)};
          pg8::gemm_phase<EpiMemKV, pg8::StaticOrder, PG8_ALIGN, PG8_SP2>(F.lds + RING_OFF, g, S, E); }
        merge_a_rows(F);
        if (BOTH(3)) GRID_BAR();
    }

    if (IN(4)) { for (int u = bx; u < 512; u += F.G) ret_stepC(F, u >> 6, u & 63); if (BOTH(4)) GRID_BAR(); }

    if (IN(5)) {
        pg8::Gemm g{WSP(bf16, WS_MIX), WSP(bf16, WS_WOUT), MP, DM, DM, DM, DM}; pg8::StaticOrder S; S.init(MP, DM, F.G, bx);
        EpiRes E{args.in[I_XP], args.in[I_XS], WSP(float, WS_X1), WSP(bf16, WS_X1B), WSP(float, WS_SSQ1)};
        pg8::gemm_phase<EpiRes, pg8::StaticOrder, PG8_ALIGN, PG8_SP2>(F.lds + RING_OFF, g, S, E);
        for (int u = bx; u < 4 * (DM / 32); u += F.G) sgemm_unit<DM>(F, WSP(bf16, WS_MIX) + (size_t)MP * DM, DM, WSP(bf16, WS_WOUT), u & 3, u >> 2,
            SEpiRes{args.in[I_XS], WSP(float, WS_X1) + (size_t)MP * DM, WSP(bf16, WS_X1B) + (size_t)MP * DM, WSP(float, WS_SSQS1)});
        if (BOTH(5)) GRID_BAR();
    }

    if (IN(6)) {
        pg8::Gemm g{WSP(bf16, WS_X1B), WSP(bf16, WS_WMQ), MP, DM, DM, DM, DM}; pg8::StaticOrder S; S.init(MP, DM, F.G, bx);
        EpiScale<0> E{WSP(bf16, WS_QM), DM, WSP(float, WS_SSQ1), C2M};
        pg8::gemm_phase<EpiScale<0>, pg8::StaticOrder, PG8_ALIGN, PG8_SP2>(F.lds + RING_OFF, g, S, E);
        for (int u = bx; u < 4 * (DM / 32); u += F.G) sgemm_unit<DM>(F, WSP(bf16, WS_X1B) + (size_t)MP * DM, DM, WSP(bf16, WS_WMQ), u & 3, u >> 2,
            SEpiScale<0>{WSP(bf16, WS_QM) + (size_t)MP * DM, DM, WSP(float, WS_SSQS1), C2M});
        if (BOTH(6)) GRID_BAR();
    }

    if (IN(7)) {
        if (bx < 256) {
            const int panel = bx >> 2, h = bx & 3, b = panel >> 5;
            { pg8::Gemm g{WSP(bf16, WS_QM) + h * 256, WSP(bf16, WS_MKB) + (size_t)b * NMEM * DM + h * 256, MP, 256, 256, DM, DM}; pg8::OneUnit S{{panel, 0}, true};
              EpiSoftmax E{WSP(bf16, WS_PM) + h * 256, DM};
              pg8::gemm_phase<EpiSoftmax, pg8::OneUnit, false, PG8_SP2>(F.lds + RING_OFF, g, S, E); }
            VM_WAIT(); __syncthreads();
            { pg8::Gemm g{WSP(bf16, WS_PM) + h * 256, WSP(bf16, WS_MVT) + (size_t)h * 256 * 512 + b * NMEM, MP, 256, 256, DM, 512}; pg8::OneUnit S{{panel, 0}, true};
              EpiPlain E{WSP(bf16, WS_OM) + h * 256, DM};
              pg8::gemm_phase<EpiPlain, pg8::OneUnit, false, PG8_SP2>(F.lds + RING_OFF, g, S, E); }
            __syncthreads();
            dec_mem_unit(F, bx >> 1, bx & 1);
        }
        if (BOTH(7)) GRID_BAR();
    }

    if (IN(8)) {
        pg8::Gemm g{WSP(bf16, WS_OM), WSP(bf16, WS_WMO), MP, DM, DM, DM, DM}; pg8::StaticOrder S; S.init(MP, DM, F.G, bx);
        EpiRes E{WSP(float, WS_X1), WSP(float, WS_X1) + (size_t)MP * DM, WSP(float, WS_X2), WSP(bf16, WS_X2B), WSP(float, WS_SSQ2)};
        pg8::gemm_phase<EpiRes, pg8::StaticOrder, PG8_ALIGN, PG8_SP2>(F.lds + RING_OFF, g, S, E);
        for (int u = bx; u < 4 * (DM / 32); u += F.G) sgemm_unit<DM>(F, WSP(bf16, WS_OM) + (size_t)MP * DM, DM, WSP(bf16, WS_WMO), u & 3, u >> 2,
            SEpiRes{WSP(float, WS_X1) + (size_t)MP * DM, WSP(float, WS_X2) + (size_t)MP * DM, WSP(bf16, WS_X2B) + (size_t)MP * DM, WSP(float, WS_SSQS2)});
        if (BOTH(8)) GRID_BAR();
    }

    if (IN(9)) {
        pg8::Gemm g{WSP(bf16, WS_X2B), WSP(bf16, WS_WUP), MP, FF, DM, DM, DM}; pg8::StaticOrder S; S.init(MP, FF, F.G, bx);
        EpiScale<1> E{WSP(bf16, WS_H), FF, WSP(float, WS_SSQ2), 1.0f};
        pg8::gemm_phase<EpiScale<1>, pg8::StaticOrder, PG8_ALIGN, PG8_SP2>(F.lds + RING_OFF, g, S, E);
        for (int u = bx; u < 4 * (FF / 32); u += F.G) sgemm_unit<DM>(F, WSP(bf16, WS_X2B) + (size_t)MP * DM, DM, WSP(bf16, WS_WUP), u & 3, u >> 2,
            SEpiScale<1>{WSP(bf16, WS_H) + (size_t)MP * FF, FF, WSP(float, WS_SSQS2), 1.0f});
        if (BOTH(9)) GRID_BAR();
    }

    if (IN(10)) {
        pg8::Gemm g{WSP(bf16, WS_H), WSP(bf16, WS_WDN), MP, DM, FF, FF, FF}; pg8::StaticOrder S; S.init(MP, DM, F.G, bx);
        EpiRes E{WSP(float, WS_X2), WSP(float, WS_X2) + (size_t)MP * DM, WSP(float, WS_X3), nullptr, WSP(float, WS_SSQ3)};
        pg8::gemm_phase<EpiRes, pg8::StaticOrder, PG8_ALIGN, PG8_SP2>(F.lds + RING_OFF, g, S, E);
        for (int u = bx; u < 4 * (DM / 32); u += F.G) sgemm_unit<FF>(F, WSP(bf16, WS_H) + (size_t)MP * FF, FF, WSP(bf16, WS_WDN), u & 3, u >> 2,
            SEpiRes{WSP(float, WS_X2) + (size_t)MP * DM, WSP(float, WS_X3) + (size_t)MP * DM, nullptr, WSP(float, WS_SSQS3)});
        if (BOTH(10)) GRID_BAR();
    }

    if (IN(11)) final_norm_rows(F);
#undef IN
#undef BOTH
}

extern "C" void kernel_launch(void* const* d_in, const int* in_sizes, int n_in, void* d_out, int out_size, void* d_ws, size_t ws_size, hipStream_t stream) {
    static int grid = 0;
    if (grid == 0) {
        if (n_in != N_IN || in_sizes[0] != MP * DM || (size_t)out_size != OUT_TOTAL || ws_size < WS_END) { fprintf(stderr, "kernel_launch: unexpected shapes (n_in %d, in0 %d, out %d, ws %zu); nothing launched\n", n_in, n_in > 0 ? in_sizes[0] : -1, out_size, ws_size); grid = -1; return; }
        int dev = 0, cus = 0, per_cu = 0;
        if (hipGetDevice(&dev) != hipSuccess || hipDeviceGetAttribute(&cus, hipDeviceAttributeMultiprocessorCount, dev) != hipSuccess) { fprintf(stderr, "kernel_launch: device query failed\n"); grid = -1; return; }
        if (hipFuncSetAttribute((const void*)fwd, hipFuncAttributeMaxDynamicSharedMemorySize, LDS_BYTES) != hipSuccess) { fprintf(stderr, "kernel_launch: hipFuncSetAttribute failed\n"); grid = -1; return; }
        if (hipOccupancyMaxActiveBlocksPerMultiprocessor(&per_cu, (const void*)fwd, NWAVES * 64, LDS_BYTES) != hipSuccess || per_cu < 1)
            fprintf(stderr, "kernel_launch: note: occupancy query reports %d workgroups per CU\n", per_cu);
        (void)hipGetLastError();
        grid = cus;
        if (grid != 256) fprintf(stderr, "kernel_launch: this kernel's static work split expects 256 CUs, found %d\n", grid);
    }
    if (grid < 0) return;
    if (hipMemsetAsync((char*)d_ws + WS_CTL, 0, CTL_ZERO_BYTES, stream) != hipSuccess) { fprintf(stderr, "kernel_launch: memset failed\n"); return; }
    Args a{};
    for (int i = 0; i < N_IN; ++i) a.in[i] = (const float*)d_in[i];
    a.out = (float*)d_out; a.ws = (unsigned char*)d_ws;
#if MK_PER_PHASE
    for (int p = 0; p < NPH; ++p) { a.ph_lo = p; a.ph_hi = p + 1; hipLaunchKernelGGL(fwd, dim3(grid), dim3(NWAVES * 64), LDS_BYTES, stream, a); }
#else
    a.ph_lo = 0; a.ph_hi = NPH; hipLaunchKernelGGL(fwd, dim3(grid), dim3(NWAVES * 64), LDS_BYTES, stream, a);
#endif
    const hipError_t le = hipPeekAtLastError();
    if (le != hipSuccess) fprintf(stderr, "kernel_launch: launch failed: %s\n", hipGetErrorName(le));
}
```

```cpp
#include <hip/hip_runtime.h>
#include <hip/hip_bf16.h>
#include <cstdio>
#include <cstdint>
#include <cmath>
#ifndef MK_PER_PHASE
#define MK_PER_PHASE 0
#endif
namespace pg8 {
#define PG8_LAS __attribute__((address_space(3)))
typedef unsigned short bf16_t;
typedef short bf16x8 __attribute__((ext_vector_type(8)));
typedef float f32x4 __attribute__((ext_vector_type(4)));
typedef unsigned u32x4 __attribute__((ext_vector_type(4)));
constexpr int BM = 256, BK = 64, HALF = 128, HTB = HALF * BK * 2  , STAGE_BYTES = 8 * HTB, NXCD = 8, WGM = 8;

__host__ __device__ __forceinline__ int lds_byte(int r, int c) { const int st = (r >> 4) * 2 + (c >> 5), rr = r & 15, cc = c & 31, ob = rr * 64 + cc * 2; return st * 1024 + (ob ^ (((ob >> 9) & 1) << 5)); }
__host__ __device__ __forceinline__ void stage_rc(int b, int& R, int& C) { const int st = b / 1024, sb = b % 1024, swz = sb ^ (((sb >> 9) & 1) << 5); R = (st >> 1) * 16 + swz / 64; C = (st & 1) * 32 + (swz % 64) / 2; }
__host__ __device__ __forceinline__ int perm32(int rho) { const int n = rho >> 4, i = rho & 15; return 8 * (i >> 2) + 4 * n + (i & 3); }

struct Unit { int pm, pn; };
struct Gemm { const bf16_t* A; const bf16_t* Bt; int M, N, K, lda, ldb; };

struct StaticOrder {
    int nM, nN, nwg, G, c;
    __host__ __device__ void init(int M, int N, int G_, int c_) { nM = M / BM; nN = N / BM; nwg = nM * nN; G = G_; c = c_; }
    __host__ __device__ bool next(int i, Unit& u) const {
        const long L = (long)i * G + c; if (L >= nwg) return false;
        int wgid = (int)L; { const int q = nwg / NXCD, r = nwg % NXCD, xcd = wgid % NXCD, off = wgid / NXCD; wgid = (xcd < r ? xcd * (q + 1) : r * (q + 1) + (xcd - r) * q) + off; }
        const int nig = WGM * nN, gid = wgid / nig, fm = gid * WGM, gsz = (nM - fm) < WGM ? (nM - fm) : WGM;
        u.pm = fm + ((wgid % nig) % gsz); u.pn = (wgid % nig) / gsz; return true;
    }
    __device__ __forceinline__ void a_ready(const Unit&) const {}
    __device__ __forceinline__ void done(const Unit&) const {}
};
struct OneUnit {
    Unit u0; bool has;
    __device__ __forceinline__ bool next(int i, Unit& u) const { if (i != 0 || !has) return false; u = u0; return true; }
    __device__ __forceinline__ void a_ready(const Unit&) const {}
    __device__ __forceinline__ void done(const Unit&) const {}
};
__device__ __forceinline__ unsigned cvt_pk_bf16(float lo, float hi) { unsigned r; asm volatile("v_cvt_pk_bf16_f32 %0, %1, %2" : "=v"(r) : "v"(lo), "v"(hi)); return r; }
template <class Epi, class Sched, bool ALIGN_EPI = false, bool SP2 = false>
__device__ __forceinline__ void gemm_phase(PG8_LAS unsigned char* lds, const Gemm g, const Sched& S, const Epi& E) {
    int tid_ = threadIdx.x; asm volatile("" : "+v"(tid_));
    const int tid = tid_, wid = __builtin_amdgcn_readfirstlane(tid >> 6), lane = tid & 63, wr = wid >> 2, wc = wid & 3, fr = lane & 15, fq = lane >> 4;
    const int K = g.K, nt = K / BK;
    unsigned voffA[2], voffB[2];
#pragma unroll
    for (int i = 0; i < 2; ++i) { int R, C; stage_rc(tid * 16 + i * 8192, R, C); const int Rb = Epi::PERM ? ((R & ~31) + perm32(R & 31)) : R;
        voffA[i] = (unsigned)(R * g.lda + C) * 2u; voffB[i] = (unsigned)(Rb * g.ldb + C) * 2u; }
    const size_t kstep = (size_t)(BK * 2);
    const size_t hstepA = (size_t)HALF * g.lda * 2, hstepB = (size_t)HALF * g.ldb * 2;
    const size_t tstepA = 2 * hstepA, tstepB = 2 * hstepB;
    const unsigned ldsw = (unsigned)wid * 1024u;
    const int aoff = lds_byte(wr * 64 + fr, fq * 8), boff = lds_byte(wc * 32 + fr, fq * 8);
#define PG8_SA(b, h) (((b) * 2 + (h)) * HTB)
#define PG8_SB(b, h) ((4 + (b) * 2 + (h)) * HTB)
#define PG8_STAGE(bufoff, gbase, voff) do { _Pragma("unroll") for (int _i = 0; _i < 2; ++_i) \
        __builtin_amdgcn_global_load_lds((const unsigned*)((const char*)(gbase) + (voff)[_i]), (PG8_LAS unsigned*)(lds + (bufoff) + ldsw + _i * 8192), 16, 0, 0); } while (0)
#define PG8_LDA(dst, b, h) do { _Pragma("unroll") for (int m = 0; m < 4; ++m) _Pragma("unroll") for (int k = 0; k < 2; ++k) dst[m][k] = *(const PG8_LAS bf16x8*)(lds + PG8_SA(b, h) + aoff + m * 2048 + k * 1024); } while (0)
#define PG8_LDB(dst, b, h) do { _Pragma("unroll") for (int n = 0; n < 2; ++n) _Pragma("unroll") for (int k = 0; k < 2; ++k) dst[n][k] = *(const PG8_LAS bf16x8*)(lds + PG8_SB(b, h) + boff + n * 2048 + k * 1024); } while (0)
#define PG8_MMA(ai, bj, At, Bt) do { __builtin_amdgcn_s_setprio(1); _Pragma("unroll") for (int m = 0; m < 4; ++m) _Pragma("unroll") for (int n = 0; n < 2; ++n) _Pragma("unroll") for (int k = 0; k < 2; ++k) \
        acc[ai][bj][m][n] = __builtin_amdgcn_mfma_f32_16x16x32_bf16(Bt[n][k], At[m][k], acc[ai][bj][m][n], 0, 0, 0); __builtin_amdgcn_s_setprio(0); } while (0)
#define PG8_WAIT_V(n) asm volatile("s_waitcnt vmcnt(" #n ")" ::: "memory")
#define PG8_WAIT_L(n) asm volatile("s_waitcnt lgkmcnt(" #n ")" ::: "memory")
#define PG8_BAR __builtin_amdgcn_s_barrier()
#define PG8_SCHED __builtin_amdgcn_sched_barrier(0)
    Unit cur, nxt; int ui = 0;
    if (!S.next(0, cur)) return;
    f32x4 acc[2][2][4][2];
#pragma unroll
    for (int a = 0; a < 2; ++a)
#pragma unroll
        for (int b = 0; b < 2; ++b)
#pragma unroll
            for (int m = 0; m < 4; ++m)
#pragma unroll
                for (int n = 0; n < 2; ++n) acc[a][b][m][n] = (f32x4){0.f, 0.f, 0.f, 0.f};
    bf16x8 At[4][2], B0[2][2], B1[2][2];
    const char* cA = (const char*)g.A + (size_t)cur.pm * tstepA; const char* cB = (const char*)g.Bt + (size_t)cur.pn * tstepB;
    S.a_ready(cur);
    if constexpr (SP2) {
        PG8_STAGE(PG8_SB(0, 0), cB, voffB); PG8_STAGE(PG8_SB(0, 1), cB + hstepB, voffB); PG8_STAGE(PG8_SA(0, 0), cA, voffA); PG8_STAGE(PG8_SA(0, 1), cA + hstepA, voffA);
        if (wr == 1) PG8_BAR;
        PG8_WAIT_V(2); PG8_BAR;
        PG8_STAGE(PG8_SB(1, 0), cB + kstep, voffB); PG8_STAGE(PG8_SA(1, 0), cA + kstep, voffA); PG8_STAGE(PG8_SB(1, 1), cB + hstepB + kstep, voffB);
        PG8_WAIT_V(6); PG8_BAR;
    } else {
        PG8_STAGE(PG8_SB(0, 0), cB, voffB); PG8_STAGE(PG8_SA(0, 0), cA, voffA); PG8_STAGE(PG8_SB(0, 1), cB + hstepB, voffB); PG8_STAGE(PG8_SA(0, 1), cA + hstepA, voffA);
        if (wr == 1) PG8_BAR;
        PG8_WAIT_V(4); PG8_BAR;
        PG8_STAGE(PG8_SB(1, 0), cB + kstep, voffB); PG8_STAGE(PG8_SA(1, 0), cA + kstep, voffA); PG8_STAGE(PG8_SB(1, 1), cB + hstepB + kstep, voffB);
        PG8_WAIT_V(6); PG8_BAR;
    }
    for (;;) {
        const bool has_next = S.next(ui + 1, nxt);
        const char* nA = has_next ? (const char*)g.A + (size_t)nxt.pm * tstepA : cA; const char* nB = has_next ? (const char*)g.Bt + (size_t)nxt.pn * tstepB : cB;
        for (int t = 0; t < nt; t += 2) {
            const bool last = (t == nt - 2);
            const char* a1 = cA + (size_t)(t + 1) * kstep;
            const char* a2 = last ? nA : cA + (size_t)(t + 2) * kstep; const char* b2 = last ? nB : cB + (size_t)(t + 2) * kstep;
            const char* a3 = a2 + kstep; const char* b3 = b2 + kstep;
            if (last && has_next) S.a_ready(nxt);
            if constexpr (SP2) {
            PG8_LDB(B0, 0, 0); PG8_LDB(B1, 0, 1); PG8_SCHED; PG8_LDA(At, 0, 0); PG8_STAGE(PG8_SA(1, 1), a1 + hstepA, voffA);
            PG8_WAIT_V(8); PG8_WAIT_L(0); PG8_BAR; PG8_MMA(0, 0, At, B0); PG8_MMA(0, 1, At, B1); PG8_BAR; PG8_SCHED;
            PG8_LDA(At, 0, 1); PG8_STAGE(PG8_SB(0, 0), b2, voffB); PG8_STAGE(PG8_SB(0, 1), b2 + hstepB, voffB); PG8_STAGE(PG8_SA(0, 0), a2, voffA);
            PG8_WAIT_V(8); PG8_WAIT_L(0); PG8_BAR; PG8_MMA(1, 0, At, B0); PG8_MMA(1, 1, At, B1); PG8_BAR; PG8_SCHED;
            PG8_LDB(B0, 1, 0); PG8_LDB(B1, 1, 1); PG8_SCHED; PG8_LDA(At, 1, 0); PG8_STAGE(PG8_SA(0, 1), a2 + hstepA, voffA);
            PG8_WAIT_V(8); PG8_WAIT_L(0); PG8_BAR; PG8_MMA(0, 0, At, B0); PG8_MMA(0, 1, At, B1); PG8_BAR; PG8_SCHED;
            PG8_LDA(At, 1, 1); PG8_STAGE(PG8_SB(1, 0), b3, voffB); PG8_STAGE(PG8_SB(1, 1), b3 + hstepB, voffB); PG8_STAGE(PG8_SA(1, 0), a3, voffA);
            PG8_WAIT_V(8); PG8_WAIT_L(0); PG8_BAR; PG8_MMA(1, 0, At, B0); PG8_MMA(1, 1, At, B1); PG8_BAR; PG8_SCHED;
            } else {
            PG8_LDB(B0, 0, 0); PG8_SCHED; PG8_LDA(At, 0, 0); PG8_STAGE(PG8_SA(1, 1), a1 + hstepA, voffA);
            PG8_WAIT_L(8); PG8_BAR; PG8_WAIT_L(0); PG8_MMA(0, 0, At, B0); PG8_BAR; PG8_SCHED;
            PG8_LDB(B1, 0, 1); PG8_STAGE(PG8_SB(0, 0), b2, voffB);
            PG8_BAR; PG8_WAIT_L(0); PG8_MMA(0, 1, At, B1); PG8_BAR;
            PG8_LDA(At, 0, 1); PG8_STAGE(PG8_SA(0, 0), a2, voffA);
            PG8_BAR; PG8_WAIT_L(0); PG8_MMA(1, 0, At, B0); PG8_BAR; PG8_SCHED;
            PG8_STAGE(PG8_SB(0, 1), b2 + hstepB, voffB);
            PG8_WAIT_V(6); PG8_BAR; PG8_MMA(1, 1, At, B1); PG8_BAR;
            PG8_LDB(B0, 1, 0); PG8_SCHED; PG8_LDA(At, 1, 0); PG8_STAGE(PG8_SA(0, 1), a2 + hstepA, voffA);
            PG8_WAIT_L(8); PG8_BAR; PG8_WAIT_L(0); PG8_MMA(0, 0, At, B0); PG8_BAR; PG8_SCHED;
            PG8_LDB(B1, 1, 1); PG8_STAGE(PG8_SB(1, 0), b3, voffB);
            PG8_BAR; PG8_WAIT_L(0); PG8_MMA(0, 1, At, B1); PG8_BAR;
            PG8_LDA(At, 1, 1); PG8_STAGE(PG8_SA(1, 0), a3, voffA);
            PG8_BAR; PG8_WAIT_L(0); PG8_MMA(1, 0, At, B0); PG8_BAR; PG8_SCHED;
            PG8_STAGE(PG8_SB(1, 1), b3 + hstepB, voffB);
            PG8_WAIT_V(6); PG8_BAR; PG8_MMA(1, 1, At, B1); PG8_BAR;
            }
        }
        if constexpr (ALIGN_EPI) { if (wr == 0) PG8_BAR; }
        if constexpr (!Epi::AFTER_DRAIN) { E(acc, cur, wr, wc, fr, fq); S.done(cur); }
        if (!has_next) break;
#pragma unroll
        for (int a = 0; a < 2; ++a)
#pragma unroll
            for (int b = 0; b < 2; ++b)
#pragma unroll
                for (int m = 0; m < 4; ++m)
#pragma unroll
                    for (int n = 0; n < 2; ++n) acc[a][b][m][n] = (f32x4){0.f, 0.f, 0.f, 0.f};
        cur = nxt; cA = nA; cB = nB; ++ui;
        if constexpr (ALIGN_EPI) { if (wr == 1) PG8_BAR; }
    }
    PG8_WAIT_V(0);
    if constexpr (!ALIGN_EPI) { if (wr == 0) PG8_BAR; }
    PG8_BAR;
    if constexpr (Epi::AFTER_DRAIN) { E.fused(acc, cur, wr, wc, fr, fq, lds, wid, lane); S.done(cur); }
#undef PG8_SA
#undef PG8_SB
#undef PG8_STAGE
#undef PG8_LDA
#undef PG8_LDB
#undef PG8_MMA
#undef PG8_WAIT_V
#undef PG8_WAIT_L
#undef PG8_BAR
#undef PG8_SCHED
}
}
namespace attn_body {
using bf16=__hip_bfloat16;
using bf16x8=__attribute__((ext_vector_type(8)))short;
using s16x4=__attribute__((ext_vector_type(4)))short;
using f32x16=__attribute__((ext_vector_type(16)))float;
using u32x4=__attribute__((ext_vector_type(4)))unsigned;
constexpr int BATCH=2,NHEAD=16,SEQ=8192,D=64,ZP=3072,OP=1024;
constexpr int NW=8,QBLK=32,QB=QBLK*NW,KVBLK=64,NQB=SEQ/QB;
constexpr int ATTN_UNIT_ROWS=QB;
__device__ __forceinline__ int crow(int r,int hi){return (r&3)+8*(r>>2)+4*hi;}
#define SBAR() __builtin_amdgcn_sched_barrier(0)
typedef const __attribute__((address_space(3))) float* lds_cfp;
__device__ __forceinline__ void cmask(f32x16&p0,f32x16&p1,int jb,int qrel,int hi,lds_cfp tab){
  const float NEG=-INFINITY; const int kb=64*jb+4*hi;
  #pragma unroll
  for(int r=0;r<16;++r){ const int rel=qrel-(kb+(r&3)+8*(r>>2)); const int rel1=rel-32;
    int i0=rel<127?rel:127; i0=i0<0?0:i0; int i1=rel1<127?rel1:127; i1=i1<0?0:i1;
    const float b0=tab[i0], b1=tab[i1];
    p0[r]=rel<0?NEG:p0[r]+b0; p1[r]=rel1<0?NEG:p1[r]+b1; }
}

constexpr int NSLOT=3, SLOTB=8192;
constexpr int LDS_K=0, LDS_V=NSLOT*SLOTB, LDS_WS=2*NSLOT*SLOTB, LDS_OST=LDS_WS+NW*64*4, LDS_BYTES=LDS_OST+NW*4096;
constexpr float C2=0.125f*1.4426950408889634f;
__device__ __forceinline__ void glds16(const void*gsrc,unsigned lds_dst){unsigned keep;
  asm volatile("s_mov_b32 %0, m0\n\ts_mov_b32 m0, %2\n\ts_nop 0\n\tglobal_load_lds_dwordx4 %1, off\n\ts_mov_b32 m0, %0":"=&s"(keep):"v"(gsrc),"s"(lds_dst):"memory");}
__device__ __forceinline__ float max3f(float a,float b,float c){float r;asm("v_max3_f32 %0, %1, %2, %3":"=v"(r):"v"(a),"v"(b),"v"(c));return r;}
__device__ __forceinline__ float max2f(float a,float b){float r;asm("v_max_f32_e32 %0, %1, %2":"=v"(r):"v"(a),"v"(b));return r;}
__device__ __forceinline__ float fadd_s(float a,float b){float r;asm("v_add_f32_e32 %0, %1, %2":"=v"(r):"v"(a),"v"(b));return r;}
__device__ __forceinline__ float fsub_s(float a,float b){float r;asm("v_sub_f32_e32 %0, %1, %2":"=v"(r):"v"(a),"v"(b));return r;}
typedef float f32x2_t __attribute__((ext_vector_type(2))); typedef __bf16 bf16x2_t __attribute__((ext_vector_type(2)));
__device__ __forceinline__ unsigned cvtpk_s(float lo,float hi){f32x2_t v={lo,hi};bf16x2_t b=__builtin_convertvector(v,bf16x2_t);return __builtin_bit_cast(unsigned,b);}
#define WAIT_BAR(N) asm volatile("s_waitcnt vmcnt(" #N ") lgkmcnt(0)\n\ts_barrier":::"memory")

__device__ __forceinline__ void qkt(f32x16&p0,f32x16&p1,const char*Kslot,const bf16x8*qr,const f32x16&negm,int r32,int hi){
  const char*kb=Kslot+hi*1024+r32*16;
  #pragma unroll
  for(int d0=0;d0<4;++d0){
    const bf16x8 b0=*reinterpret_cast<const bf16x8*>(kb+d0*2048);
    const bf16x8 b1=*reinterpret_cast<const bf16x8*>(kb+d0*2048+512);
    if(d0==0){p0=__builtin_amdgcn_mfma_f32_32x32x16_bf16(b0,qr[0],negm,0,0,0);p1=__builtin_amdgcn_mfma_f32_32x32x16_bf16(b1,qr[0],negm,0,0,0);}
    else{p0=__builtin_amdgcn_mfma_f32_32x32x16_bf16(b0,qr[d0],p0,0,0,0);p1=__builtin_amdgcn_mfma_f32_32x32x16_bf16(b1,qr[d0],p1,0,0,0);}}
}
typedef __attribute__((address_space(3))) const char* lds_cptr;
typedef short v4i16_t __attribute__((ext_vector_type(4)));
__device__ __forceinline__ void kload8(bf16x8*kf,lds_cptr kp){
  kf[0]=*(const __attribute__((address_space(3))) bf16x8*)(kp);      kf[1]=*(const __attribute__((address_space(3))) bf16x8*)(kp+512);
  kf[2]=*(const __attribute__((address_space(3))) bf16x8*)(kp+2048); kf[3]=*(const __attribute__((address_space(3))) bf16x8*)(kp+2560);
  kf[4]=*(const __attribute__((address_space(3))) bf16x8*)(kp+4096); kf[5]=*(const __attribute__((address_space(3))) bf16x8*)(kp+4608);
  kf[6]=*(const __attribute__((address_space(3))) bf16x8*)(kp+6144); kf[7]=*(const __attribute__((address_space(3))) bf16x8*)(kp+6656);
}
__device__ __forceinline__ void kload2(bf16x8*kf,lds_cptr kp,int j){ kf[2*j]=*(const __attribute__((address_space(3))) bf16x8*)(kp+j*2048); kf[2*j+1]=*(const __attribute__((address_space(3))) bf16x8*)(kp+j*2048+512); }
__device__ __forceinline__ s16x4 vtr(lds_cptr p){ return __builtin_bit_cast(s16x4,__builtin_amdgcn_ds_read_tr16_b64_v4i16((__attribute__((address_space(3))) v4i16_t*)p)); }
__device__ __forceinline__ float rowmax(const f32x16&p0,const f32x16&p1){
  float a=max3f(p0[0],p0[1],p1[0]),b=max3f(p0[2],p0[3],p1[1]);a=max3f(a,p1[2],p1[3]);
  #pragma unroll
  for(int r=4;r<16;r+=4){a=max3f(a,p0[r],p0[r+1]);b=max3f(b,p0[r+2],p0[r+3]);a=max3f(a,p1[r],p1[r+1]);b=max3f(b,p1[r+2],p1[r+3]);}
  const float m=max2f(a,b);
  auto rr=__builtin_amdgcn_permlane32_swap(__float_as_uint(m),__float_as_uint(m),false,false);
  return max2f(__uint_as_float(rr[0]),__uint_as_float(rr[1]));
}
__device__ __forceinline__ void pv(f32x16*o,int vb,bf16x8 pa0,bf16x8 pa1,bf16x8 pa2,bf16x8 pa3){
  #pragma unroll
  for(int d0=0;d0<2;++d0){s16x4 lo[4],hi[4];
    #pragma unroll
    for(int ks=0;ks<4;++ks){
      asm volatile("ds_read_b64_tr_b16 %0,%1 offset:%c2":"=&v"(lo[ks]):"v"(vb),"i"(d0*4096+ks*1024):"memory");
      asm volatile("ds_read_b64_tr_b16 %0,%1 offset:%c2":"=&v"(hi[ks]):"v"(vb),"i"(d0*4096+ks*1024+512):"memory");}
    asm volatile("s_waitcnt lgkmcnt(0)":::"memory");SBAR();
    #define PK(k) (bf16x8){lo[k][0],lo[k][1],lo[k][2],lo[k][3],hi[k][0],hi[k][1],hi[k][2],hi[k][3]}
    o[d0]=__builtin_amdgcn_mfma_f32_32x32x16_bf16(pa0,PK(0),o[d0],0,0,0);
    o[d0]=__builtin_amdgcn_mfma_f32_32x32x16_bf16(pa1,PK(1),o[d0],0,0,0);
    o[d0]=__builtin_amdgcn_mfma_f32_32x32x16_bf16(pa2,PK(2),o[d0],0,0,0);
    o[d0]=__builtin_amdgcn_mfma_f32_32x32x16_bf16(pa3,PK(3),o[d0],0,0,0);
    #undef PK
  }
}

#ifndef ATTN_STORE16
#define ATTN_STORE16(p,v) (*(u32x4*)(p)=(v))
#endif
template<int THRL> __device__ __forceinline__ void attn_unit(int b,int qcol,int kcol,int vcol,int ocol,int qb,const bf16*__restrict__ Zb,bf16*O,char*shm,lds_cfp tab){
  int tid_=threadIdx.x; asm volatile("":"+v"(tid_));
  const int tid=tid_,lane=tid&63,r32=lane&31,hi=lane>>5; const int wid=__builtin_amdgcn_readfirstlane(tid>>6);
  const long rowbase=(long)b*SEQ; const int q0=qb*QB;
  const bf16*Qw=Zb+(rowbase+q0+wid*QBLK)*ZP+qcol;
  const bf16*Kh=Zb+rowbase*ZP+kcol,*Vh=Zb+rowbase*ZP+vcol;
  const unsigned lds0=(unsigned)(uintptr_t)shm;
  float*wsf=(float*)(shm+LDS_WS)+wid*64;
  const bf16*ksrc=Kh+(long)lane*ZP+wid*8;
  const bf16*vsrc=Vh+(long)(16*(wid&3)+(lane>>2))*ZP+(wid>>2)*32+(lane&3)*8;
  const unsigned kdst=lds0+LDS_K+wid*1024, vdst=lds0+LDS_V+wid*1024;
  #define DMA_K(t,slot) glds16(ksrc+(long)(t)*KVBLK*ZP,(unsigned)__builtin_amdgcn_readfirstlane(kdst+(slot)))
  #define DMA_V(t,slot) glds16(vsrc+(long)(t)*KVBLK*ZP,(unsigned)__builtin_amdgcn_readfirstlane(vdst+(slot)))
  const int vb0=(int)(lds0+LDS_V)+((lane>>4)&1)*32+(lane&3)*8+(4*hi+((lane&15)>>2))*64;
  const char*Kbase=shm+LDS_K; bf16x8 kf[8];
  const lds_cptr shm3=(lds_cptr)shm; const lds_cptr kp0=shm3+LDS_K+hi*1024+r32*16; const lds_cptr vp0=shm3+LDS_V+((lane>>4)&1)*32+(lane&3)*8+(4*hi+((lane&15)>>2))*64;
  const int NT=(q0+QB)/KVBLK;
  DMA_K(0,0);DMA_V(0,0);DMA_K(1,SLOTB);
  bf16x8 qr[4];
  #pragma unroll
  for(int d0=0;d0<4;++d0)qr[d0]=*reinterpret_cast<const bf16x8*>(&Qw[(long)r32*ZP+d0*16+hi*8]);
  float mhat=0.f,l_reg=0.f;f32x16 o[2];o[0]=f32x16{};o[1]=f32x16{};f32x16 negm=f32x16{};asm volatile("":"+v"(negm));
  const int qrel=wid*QBLK+r32;
  #define CMASK(P0,P1,t) do{int jb_=(t)-(NT-4); if(jb_>=-2)cmask(P0,P1,jb_,qrel,hi,tab);}while(0)
  bool resc=false;
  #define START(P0,P1) do{ const float rm=rowmax(P0,P1); resc=false; \
    { const float dl=rm; mhat=fadd_s(mhat,dl); \
      _Pragma("unroll") for(int r=0;r<16;++r){P0[r]=fsub_s(P0[r],dl);P1[r]=fsub_s(P1[r],dl);} \
      _Pragma("unroll") for(int r=0;r<16;++r)negm[r]=-mhat; asm volatile("":"+v"(negm)); } \
    _Pragma("unroll") for(int r=0;r<16;++r)P0[r]=__builtin_amdgcn_exp2f(P0[r]); }while(0)
  #define RESC() do{ if(resc){ asm volatile("s_waitcnt lgkmcnt(0)":::"memory"); \
      _Pragma("unroll") for(int d_=0;d_<2;++d_) _Pragma("unroll") for(int r=0;r<16;++r)o[d_][r]*=wsf[crow(r,hi)]; } }while(0)
  f32x16 pA0,pA1,pB0,pB1;
  int sl_prev=0,sl_cur=0,sl_next=SLOTB;
  #define ROT() do{sl_prev=sl_cur;sl_cur=sl_next;sl_next=(sl_next==(NSLOT-1)*SLOTB)?0:sl_next+SLOTB;}while(0)
  DMA_K(2,2*SLOTB);
  WAIT_BAR(3);
  qkt(pA0,pA1,Kbase,qr,negm,r32,hi);asm volatile("s_nop 15\n\ts_nop 7":"+v"(pA0),"+v"(pA1));CMASK(pA0,pA1,0);
  START(pA0,pA1);
  _Pragma("unroll") for(int r=0;r<16;++r)pA1[r]=__builtin_amdgcn_exp2f(pA1[r]);
  WAIT_BAR(0);
  DMA_K(3,0);DMA_V(1,SLOTB);
  ROT();
  kload8(kf,kp0+sl_cur);
  WAIT_BAR(2);
  s16x4 vlo[8],vhi[8]; u32x4 pw0,pw1,pw2,pw3;
  #define PKW(P,B) cvtpk_s(P[B],P[B+1])
  #define PAF(k) __builtin_bit_cast(bf16x8,pw##k)
  #define VFR(i) (bf16x8){vlo[i][0],vlo[i][1],vlo[i][2],vlo[i][3],vhi[i][0],vhi[i][1],vhi[i][2],vhi[i][3]}
  #define PIN(x) asm volatile("":"+v"(x))
  #define MX3(a,b,c) __builtin_fmaxf(__builtin_fmaxf((a),(b)),(c))
  #define GAPA(MF,A0,A1,A2,A3,W0,W1,PW) do{ MF; sacc+=A0; sacc+=A1; sacc+=A2; sacc+=A3; PIN(sacc); W0; W1; PIN(PW); SBAR(); }while(0)
  #define EX(v) __builtin_amdgcn_exp2f(v)
  #define GAPB(MF,X,B) do{ MF; X[B]=EX(X[B]); X[B+1]=EX(X[B+1]); X[B+2]=EX(X[B+2]); X[B+3]=EX(X[B+3]); PIN(X); SBAR(); }while(0)
  #define VRD(i) do{ vlo[i]=vtr(vp_+(((i)>>2)*4096+((i)&3)*1024)); vhi[i]=vtr(vp_+(((i)>>2)*4096+((i)&3)*1024+512)); }while(0)
  #define KRD(G,j) do{ if(G){ kload2(kf,kp0+sl_next,j); SBAR(); } }while(0)
  #define STEP(C0,C1,P0,P1,t,GK,GV,GL) do{ SBAR(); \
    const lds_cptr vp_=vp0+sl_prev; \
    VRD(0); SBAR(); float sacc=(P0[0]+P0[1]); \
    GAPA(C0=__builtin_amdgcn_mfma_f32_32x32x16_bf16(kf[0],qr[0],negm,0,0,0), P0[2],P0[3],P0[4],P0[5],     pw0[0]=PKW(P0,0), pw0[1]=PKW(P0,2), pw0); \
    VRD(4); SBAR(); GAPA(C1=__builtin_amdgcn_mfma_f32_32x32x16_bf16(kf[1],qr[0],negm,0,0,0), P0[6],P0[7],P0[8],P0[9],     pw0[2]=PKW(P0,4), pw0[3]=PKW(P0,6), pw0); \
    VRD(1); SBAR(); GAPA(C0=__builtin_amdgcn_mfma_f32_32x32x16_bf16(kf[2],qr[1],C0,0,0,0),   P0[10],P0[11],P0[12],P0[13], pw1[0]=PKW(P0,8), pw1[1]=PKW(P0,10), pw1); \
    VRD(5); SBAR(); GAPA(C1=__builtin_amdgcn_mfma_f32_32x32x16_bf16(kf[3],qr[1],C1,0,0,0),   P0[14],P0[15],P1[0],P1[1],   pw1[2]=PKW(P0,12),pw1[3]=PKW(P0,14), pw1); \
    VRD(2); SBAR(); GAPA(C0=__builtin_amdgcn_mfma_f32_32x32x16_bf16(kf[4],qr[2],C0,0,0,0),   P1[2],P1[3],P1[4],P1[5],     pw2[0]=PKW(P1,0), pw2[1]=PKW(P1,2), pw2); \
    VRD(6); SBAR(); GAPA(C1=__builtin_amdgcn_mfma_f32_32x32x16_bf16(kf[5],qr[2],C1,0,0,0),   P1[6],P1[7],P1[8],P1[9],     pw2[2]=PKW(P1,4), pw2[3]=PKW(P1,6), pw2); \
    VRD(3); SBAR(); GAPA(C0=__builtin_amdgcn_mfma_f32_32x32x16_bf16(kf[6],qr[3],C0,0,0,0),   P1[10],P1[11],P1[12],P1[13], pw3[0]=PKW(P1,8), pw3[1]=PKW(P1,10), pw3); \
    VRD(7); SBAR(); GAPA(C1=__builtin_amdgcn_mfma_f32_32x32x16_bf16(kf[7],qr[3],C1,0,0,0),   P1[14],P1[15],0.f,0.f,       pw3[2]=PKW(P1,12),pw3[3]=PKW(P1,14), pw3); \
    l_reg+=sacc; \
    if(GK){DMA_K((t)+3,sl_cur);} if(GV){DMA_V((t)+1,sl_next);} \
    CMASK(C0,C1,t); \
    { float a=MX3(C0[0],C0[1],C1[0]),b=MX3(C0[2],C0[3],C1[1]); a=MX3(a,C1[2],C1[3]); \
      _Pragma("unroll") for(int r=4;r<16;r+=4){a=MX3(a,C0[r],C0[r+1]);b=MX3(b,C0[r+2],C0[r+3]);a=MX3(a,C1[r],C1[r+1]);b=MX3(b,C1[r+2],C1[r+3]);} \
      float rm=__builtin_fmaxf(a,b); { auto rr=__builtin_amdgcn_permlane32_swap(__float_as_uint(rm),__float_as_uint(rm),false,false); rm=__builtin_fmaxf(__uint_as_float(rr[0]),__uint_as_float(rr[1])); } \
      resc=false; \
      if(__builtin_expect(__any(rm>(float)THRL),0)){ const float dl=__builtin_fmaxf(rm,0.f); mhat+=dl; \
        _Pragma("unroll") for(int r=0;r<16;++r){C0[r]-=dl;C1[r]-=dl;} \
        _Pragma("unroll") for(int r=0;r<16;++r)negm[r]=-mhat; asm volatile("":"+v"(negm)); \
        const float f=__builtin_amdgcn_exp2f(-dl); l_reg*=f; if(hi==0)wsf[r32]=f; resc=true; } } \
    SBAR(); \
    GAPB(o[0]=__builtin_amdgcn_mfma_f32_32x32x16_bf16(PAF(0),VFR(0),o[0],0,0,0), C0,0); \
    GAPB(o[1]=__builtin_amdgcn_mfma_f32_32x32x16_bf16(PAF(0),VFR(4),o[1],0,0,0), C0,4); \
    KRD(GL,0); GAPB(o[0]=__builtin_amdgcn_mfma_f32_32x32x16_bf16(PAF(1),VFR(1),o[0],0,0,0), C0,8); \
    KRD(GL,1); GAPB(o[1]=__builtin_amdgcn_mfma_f32_32x32x16_bf16(PAF(1),VFR(5),o[1],0,0,0), C0,12); \
    KRD(GL,2); GAPB(o[0]=__builtin_amdgcn_mfma_f32_32x32x16_bf16(PAF(2),VFR(2),o[0],0,0,0), C1,0); \
    KRD(GL,3); GAPB(o[1]=__builtin_amdgcn_mfma_f32_32x32x16_bf16(PAF(2),VFR(6),o[1],0,0,0), C1,4); \
    GAPB(o[0]=__builtin_amdgcn_mfma_f32_32x32x16_bf16(PAF(3),VFR(3),o[0],0,0,0), C1,8); \
    GAPB(o[1]=__builtin_amdgcn_mfma_f32_32x32x16_bf16(PAF(3),VFR(7),o[1],0,0,0), C1,12); \
    }while(0)
  int t=1;
  #undef CMASK
  #define CMASK(P0,P1,t) do{}while(0)
  for(;t+7<NT;t+=2){
    STEP(pB0,pB1,pA0,pA1,t,true,true,true);     WAIT_BAR(2); RESC(); ROT();
    STEP(pA0,pA1,pB0,pB1,t+1,true,true,true);   WAIT_BAR(2); RESC(); ROT();
  }
  #undef CMASK
  #define CMASK(P0,P1,t) do{int jb_=(t)-(NT-4); if(jb_>=-2)cmask(P0,P1,jb_,qrel,hi,tab);}while(0)
  #define ENDW(tt) do{ if((tt)+3<NT){WAIT_BAR(2);} else if((tt)+2<NT){WAIT_BAR(1);} else {WAIT_BAR(0);} }while(0)
  for(;t+1<NT;t+=2){
    STEP(pB0,pB1,pA0,pA1,t,(t+3<NT),(t+1<NT),(t+1<NT));       ENDW(t);   RESC(); ROT();
    STEP(pA0,pA1,pB0,pB1,t+1,(t+4<NT),(t+2<NT),(t+2<NT));     ENDW(t+1); RESC(); ROT();
  }
  STEP(pB0,pB1,pA0,pA1,NT-1,false,false,false); RESC();
  { float sacc=pB0[0]+pB0[1]; _Pragma("unroll") for(int r=2;r<16;++r)sacc+=pB0[r]; _Pragma("unroll") for(int r=0;r<16;++r)sacc+=pB1[r]; l_reg+=sacc;
    pw0=(u32x4){PKW(pB0,0),PKW(pB0,2),PKW(pB0,4),PKW(pB0,6)};pw1=(u32x4){PKW(pB0,8),PKW(pB0,10),PKW(pB0,12),PKW(pB0,14)};pw2=(u32x4){PKW(pB1,0),PKW(pB1,2),PKW(pB1,4),PKW(pB1,6)};pw3=(u32x4){PKW(pB1,8),PKW(pB1,10),PKW(pB1,12),PKW(pB1,14)};
    SBAR(); pv(o,vb0+sl_cur,PAF(0),PAF(1),PAF(2),PAF(3)); }
  #undef PKW
  #undef PAF
  #undef VFR
  #undef PIN
  #undef MX3
  #undef GAPA
  #undef GAPB
  #undef EX
  #undef VRD
  #undef KRD
  #undef STEP
  #undef ENDW
  {auto rr=__builtin_amdgcn_permlane32_swap(__float_as_uint(l_reg),__float_as_uint(l_reg),false,false);l_reg=__uint_as_float(rr[0])+__uint_as_float(rr[1]);}
  if(hi==0)wsf[32+r32]=l_reg;asm volatile("s_waitcnt lgkmcnt(0)":::"memory");
  float rli[16];
  #pragma unroll
  for(int r=0;r<16;++r)rli[r]=__builtin_amdgcn_rcpf(wsf[32+crow(r,hi)]);
  bf16*Ow=O+(rowbase+q0+wid*QBLK)*OP+ocol;
  { bf16*stg=(bf16*)(shm+LDS_OST)+wid*2048;
    #pragma unroll
    for(int r=0;r<16;++r){const int orow=crow(r,hi);
      #pragma unroll
      for(int d0=0;d0<2;++d0)stg[orow*64+d0*32+r32]=__float2bfloat16(o[d0][r]*rli[r]);}
    asm volatile("s_waitcnt lgkmcnt(0)":::"memory");
    #pragma unroll
    for(int i=0;i<4;++i){const int row=i*8+(lane>>3),ch=lane&7; const u32x4 v=*(const u32x4*)(stg+row*64+ch*8); ATTN_STORE16(Ow+(long)row*OP+ch*8,v);} }
  asm volatile("s_waitcnt lgkmcnt(0)\n\ts_barrier":::"memory");
  #undef DMA_K
  #undef DMA_V
  #undef CMASK
  #undef START
  #undef RESC
  #undef ROT
}
constexpr int ATTN_LDS_BYTES=LDS_BYTES;
struct AttnUnit { int bh; int qb; };
struct StaticOrder {
  int vcu;
  __device__ __forceinline__ explicit StaticOrder(int grid,int block):vcu((block%8)*(grid/8)+block/8){}
  __device__ __forceinline__ bool next(int i,AttnUnit&u)const{ if(i>=4)return false; const int s=vcu&7; u.bh=vcu>>3; u.qb=(i==0)?s:(i==1)?15-s:(i==2)?16+s:31-s; return true; }
  __device__ __forceinline__ void a_ready(const AttnUnit&)const{}
  __device__ __forceinline__ void done(const AttnUnit&)const{}
};
template<class Sched,int THRL=8> __device__ __forceinline__ void attn_phase(char*lds,const bf16*Zb,bf16*OA,lds_cfp tab,const Sched&S){
  AttnUnit u;
  for(int i=0;S.next(i,u);++i){ S.a_ready(u); const int b=u.bh>>4,vh=u.bh&15,map=vh>>3,h=(vh>>1)&3,vhalf=vh&1;
    attn_unit<THRL>(b,h*128+map*64,512+h*128+map*64,1024+h*128+vhalf*64,map*512+h*128+vhalf*64,u.qb,Zb,OA,lds,tab+h*128); S.done(u); }
}
template<int THRL=8> __device__ __forceinline__ void attn_one(char*lds,const bf16*Zb,bf16*OA,lds_cfp tab,const AttnUnit&u){
  const int b=u.bh>>4,vh=u.bh&15,map=vh>>3,h=(vh>>1)&3,vhalf=vh&1;
  attn_unit<THRL>(b,h*128+map*64,512+h*128+map*64,1024+h*128+vhalf*64,map*512+h*128+vhalf*64,u.qb,Zb,OA,lds,tab+h*128);
}
#undef SBAR
#undef WAIT_BAR
}

constexpr int NWAVES = 8;
#ifndef MK_PER_PHASE
#define MK_PER_PHASE 0
#endif
constexpr int NPH = 12;

constexpr int MP = 16384, MS = 128, MV = MP + MS, MPAD = 16640;
constexpr int DM = 1024, DIN = 3072, FF = 4096, TSEQ = 8192, NMEM = 256, PASTLEN = 2048;
constexpr float EPS = 1e-6f, LOG2E = 1.4426950408889634f;
constexpr float C2A = 0.125f * LOG2E;
constexpr float C2M = 0.0625f * LOG2E;
constexpr float ONE_M_LAMINIT = 0.8f, LAMINIT = 0.2f;
constexpr int ZQA = 0, ZKA = 512, ZVA = 1024, ZQR = 1536, ZKR = 1792, ZVR = 2048, ZGR = 2560;
constexpr size_t OY_P = 0, OY_S = 16777216, OK_P = 16908288, OV_P = 25296896, OS_P = 33685504, OMK = 33751040, OMV = 34275328, OK_S = 34799616, OV_S = 34865152, OS_S = 34930688, OUT_TOTAL = 39124992;
enum { I_XP = 0, I_XS, I_MEMP, I_CK, I_CV, I_PT, I_SRET, I_CMK, I_CMV, I_RELB, I_NMIX, I_WIN, I_LQ1, I_LK1, I_LQ2, I_LK2, I_SUBLN, I_WOUT, I_NMEMQ, I_NMEMKV, I_WMQ, I_WMK, I_WMV, I_WMO, I_NMLP, I_WUP, I_WDN, I_NFIN, N_IN };

constexpr size_t MiB = 1u << 20;
constexpr size_t WS_CTL = 0, CTL_ZERO_BYTES = 1 * MiB;
constexpr size_t WS_WIN = 2 * MiB, WS_WOUT = 8 * MiB, WS_WMQ = 10 * MiB, WS_WMKV = 12 * MiB, WS_WMO = 16 * MiB, WS_WUP = 18 * MiB, WS_WDN = 26 * MiB;
constexpr size_t WS_MEMN = 34 * MiB, WS_MKB = 35 * MiB, WS_MVT = 36 * MiB, WS_SSQ1 = 37 * MiB, WS_SSQ2 = 39 * MiB, WS_SSQ3 = 41 * MiB;
constexpr size_t WS_XN = 48 * MiB, WS_Z = 82 * MiB, WS_OA = 180 * MiB, WS_MIX = 214 * MiB, WS_KRT = 248 * MiB, WS_VRT = 256 * MiB, WS_U = 272 * MiB, WS_SPT = 288 * MiB;
constexpr size_t WS_X1 = 296 * MiB, WS_X1B = 362 * MiB, WS_QM = 396 * MiB, WS_PM = 430 * MiB, WS_OM = 464 * MiB, WS_X2 = 498 * MiB, WS_X2B = 564 * MiB, WS_H = 598 * MiB, WS_X3 = 730 * MiB, WS_END = 796 * MiB;
static_assert(WS_XN + (size_t)MPAD * DM * 2 <= WS_Z && WS_Z + (size_t)MPAD * DIN * 2 <= WS_OA && WS_OA + (size_t)MPAD * DM * 2 <= WS_MIX && WS_MIX + (size_t)MPAD * DM * 2 <= WS_KRT, "ws map 1");
static_assert(WS_X1 + (size_t)MPAD * DM * 4 <= WS_X1B && WS_H + (size_t)MPAD * FF * 2 <= WS_X3 && WS_X3 + (size_t)MPAD * DM * 4 <= WS_END && WS_SSQ1 + (size_t)MPAD * 16 * 4 <= WS_SSQ2, "ws map 2");
constexpr size_t WS_SSQS1 = WS_SSQ1 + 3 * MiB / 2, WS_SSQS2 = WS_SSQ2 + 3 * MiB / 2, WS_SSQS3 = WS_SSQ3 + 3 * MiB / 2;
constexpr int CW_TMO = 0, CW_CODE = 1, CW_BAR = 4096;

constexpr int RING_OFF = 0, RING_BYTES = 131072;
constexpr int LDSCTL_OFF = RING_BYTES, MISC_OFF = LDSCTL_OFF + 320;
constexpr int TAB_OFF = RING_BYTES + 1024;
constexpr int LDS_BYTES = 147456;
static_assert(MISC_OFF + 128 <= TAB_OFF && TAB_OFF + 2048 <= LDS_BYTES, "LDS map");

#define GAS __attribute__((address_space(1)))
#define LAS __attribute__((address_space(3)))
typedef unsigned short bf16;
typedef unsigned v4u __attribute__((ext_vector_type(4)));
typedef float f32x4 __attribute__((ext_vector_type(4)));
typedef short bf16x8 __attribute__((ext_vector_type(8)));
typedef GAS unsigned gu32;
typedef GAS unsigned long long gu64;
#define RLX_AGENT __ATOMIC_RELAXED, __HIP_MEMORY_SCOPE_AGENT
#define LDS_WAIT() asm volatile("s_waitcnt lgkmcnt(0)" ::: "memory")
#define VM_WAIT() asm volatile("s_waitcnt vmcnt(0)" ::: "memory")
__device__ __forceinline__ unsigned long long rt() { return __builtin_amdgcn_s_memrealtime(); }
__device__ __forceinline__ unsigned f2bf(float f) { unsigned u = __builtin_bit_cast(unsigned, f); return (u + 0x7fffu + ((u >> 16) & 1u)) >> 16; }
__device__ __forceinline__ unsigned pk2(float lo, float hi) { return f2bf(lo) | (f2bf(hi) << 16); }

#define XB_TMO      128
#define XB_XCNT(j)  (256  + 64 * (j))
#define XB_XSUB(j)  (1280 + 64 * (j))
#define XB_XGEN(j)  (2304 + 64 * (j))
#define XB_TOP      3328
#define XB_TOPGEN   3392
#define XCD_BAR_WORDS 3456
#define XB_SPIN_CAP (1u << 18)

__device__ __forceinline__ unsigned xb_ld(unsigned* p)              { return __hip_atomic_load(p, __ATOMIC_RELAXED, __HIP_MEMORY_SCOPE_AGENT); }
__device__ __forceinline__ unsigned xb_add(unsigned* p, unsigned v) { return __hip_atomic_fetch_add(p, v, __ATOMIC_RELAXED, __HIP_MEMORY_SCOPE_AGENT); }
__device__ __forceinline__ unsigned xb_xcc_id() { return (unsigned)__builtin_amdgcn_s_getreg((3 << 11) | 20) & 0xFu; }
#define XB_SPIN(cond, bar) do { unsigned _sp = 0; while (cond) { __builtin_amdgcn_s_sleep(1); \
    if ((++_sp & 255u) == 0u) { if (xb_ld(&(bar)[XB_TMO])) break; if (_sp > XB_SPIN_CAP) { atomicAdd(&(bar)[XB_TMO], 1u); break; } } } } while (0)

struct XcdBarrier {
    unsigned* bar; unsigned x;
    volatile LAS unsigned* st;
};

__device__ __forceinline__ XcdBarrier xcd_barrier_post(unsigned* bar, volatile LAS unsigned* st) {
    XcdBarrier b; b.bar = bar; b.x = xb_xcc_id(); b.st = st;
    if (threadIdx.x == 0) (void)xb_add(&bar[XB_XCNT(b.x)], 1u);
    return b;
}
__device__ __forceinline__ void xcd_barrier_complete(unsigned* bar, unsigned x, unsigned& nloc, unsigned& nx) {
    const unsigned G = gridDim.x * gridDim.y * gridDim.z;
    unsigned sum, cnt, mine, sp = 0u;
    for (;;) {
        sum = 0u; cnt = 0u; mine = 0u;
#pragma unroll
        for (unsigned j = 0; j < 16; ++j) { const unsigned c = xb_ld(&bar[XB_XCNT(j)]); sum += c; cnt += (c > 0u) ? 1u : 0u; mine = (j == x) ? c : mine; }
        if (sum == G) break;
        __builtin_amdgcn_s_sleep(1);
        if ((++sp & 255u) == 0u) { if (xb_ld(&bar[XB_TMO])) break; if (sp > XB_SPIN_CAP) { atomicAdd(&bar[XB_TMO], 1u); break; } }
    }
    nloc = mine > 0u ? mine : 1u; nx = cnt > 0u ? cnt : 1u;
}

__device__ __forceinline__ void xcd_barrier(const XcdBarrier& b) {
    asm volatile("s_waitcnt vmcnt(0)" ::: "memory");
    __syncthreads();
    if (threadIdx.x == 0) {
        unsigned* bar = b.bar;
        __builtin_amdgcn_s_waitcnt(0);
        unsigned nloc = b.st[0], nx = b.st[1];
        if (nloc == 0u) { xcd_barrier_complete(bar, b.x, nloc, nx); b.st[0] = nloc; b.st[1] = nx; }
        const unsigned old = xb_add(&bar[XB_XSUB(b.x)], 1u);
        const unsigned gen = old / nloc;
        if (old + 1u == (gen + 1u) * nloc) {
            __builtin_amdgcn_fence(__ATOMIC_RELEASE, "agent");
            asm volatile("s_waitcnt vmcnt(0)" ::: "memory");
            const unsigned og = xb_add(&bar[XB_TOP], 1u);
            const unsigned tg = og / nx;
            if (og + 1u == (tg + 1u) * nx) xb_add(&bar[XB_TOPGEN], 1u);
            else XB_SPIN(xb_ld(&bar[XB_TOPGEN]) == tg, bar);
            __builtin_amdgcn_fence(__ATOMIC_ACQUIRE, "agent");
            xb_add(&bar[XB_XGEN(b.x)], 1u);
            asm volatile("s_waitcnt vmcnt(0)" ::: "memory");
        } else {
            XB_SPIN(xb_ld(&bar[XB_XGEN(b.x)]) == gen, bar);
            __builtin_amdgcn_fence(__ATOMIC_ACQUIRE, "agent");
            asm volatile("s_waitcnt vmcnt(0)" ::: "memory");
        }
    }
    __syncthreads();
}

typedef unsigned u32x2 __attribute__((ext_vector_type(2)));
typedef float f32x2 __attribute__((ext_vector_type(2)));
typedef float f32x16 __attribute__((ext_vector_type(16)));
typedef short s16x4 __attribute__((ext_vector_type(4)));
struct Frame {
    LAS unsigned char* lds;
    volatile LAS unsigned* MISC;
    gu32* ctl;
    int wave, vcu, G;
    const float* const* in;
    float* out; unsigned char* ws;
};
#define WSP(T, off) ((T*)(F.ws + (off)))
__device__ __forceinline__ int fresh_tid() { int t = threadIdx.x; asm volatile("" : "+v"(t)); return t; }

__device__ __forceinline__ float bf2f(unsigned short b) { return __uint_as_float((unsigned)b << 16); }
__device__ __forceinline__ float bflo(unsigned w) { return __uint_as_float(w << 16); }
__device__ __forceinline__ float bfhi(unsigned w) { return __uint_as_float(w & 0xffff0000u); }
__device__ __forceinline__ v4u pack8(const f32x4 a, const f32x4 b) { v4u w; w.x = pg8::cvt_pk_bf16(a.x, a.y); w.y = pg8::cvt_pk_bf16(a.z, a.w); w.z = pg8::cvt_pk_bf16(b.x, b.y); w.w = pg8::cvt_pk_bf16(b.z, b.w); return w; }
template <int CTRL> __device__ __forceinline__ float dpp_mov(float v) { return __builtin_bit_cast(float, __builtin_amdgcn_update_dpp(0, __builtin_bit_cast(int, v), CTRL, 0xF, 0xF, true)); }
__device__ __forceinline__ float row16_sum(float v) {
    v += dpp_mov<0xB1>(v);
    v += dpp_mov<0x4E>(v);
    v += dpp_mov<0x141>(v);
    v += dpp_mov<0x140>(v);
    return v;
}
__device__ __forceinline__ float wave_sum(float v) { v = row16_sum(v); v += __shfl_xor(v, 16); v += __shfl_xor(v, 32); return v; }
__device__ __forceinline__ float wave_max(float v) {
#pragma unroll
    for (int o = 1; o < 64; o <<= 1) v = fmaxf(v, __shfl_xor(v, o));
    return v;
}
__device__ __forceinline__ float log2gamma(int h) { return log2f(1.0f - exp2f(-(float)(5 + h))); }
__device__ __forceinline__ int t5_bucket(int n) {
    if (n < 16) return n;
    return 16 + (n >= 19) + (n >= 21) + (n >= 24) + (n >= 27) + (n >= 31) + (n >= 35) + (n >= 40) + (n >= 46) + (n >= 52) + (n >= 59) + (n >= 67) + (n >= 77) + (n >= 87) + (n >= 99) + (n >= 113);
}
__device__ __forceinline__ float lam_value(Frame& F, int lane) {
    const float a = F.in[I_LQ1][lane] * F.in[I_LK1][lane], b = F.in[I_LQ2][lane] * F.in[I_LK2][lane];
    return expf(wave_sum(a)) - expf(wave_sum(b)) + LAMINIT;
}

__device__ __forceinline__ int win_src_col(int n) {
    if (n < ZQR || n >= ZVR) return n;
    const int p = (n - ZQR) & 63;
    return (n - p) + (p >> 1) + 32 * (p & 1);
}
__device__ __forceinline__ void p0_transpose_item(const float* W, int K, int N, bf16* WT, int row_off, LAS float* scr, int item, int lane, const float* gk, bool perm) {
    const int nblk = N / 32, kb = item / nblk, nb = item % nblk, k0 = 64 * kb, n0 = 32 * nb;
    const int sc = perm ? win_src_col(n0 + (lane & 31)) : n0 + (lane & 31);
#pragma unroll 8
    for (int i = 0; i < 32; ++i) { const int kk = 2 * i + (lane >> 5); float v = W[(size_t)(k0 + kk) * N + sc]; if (gk) v *= gk[k0 + kk]; scr[kk * 33 + (lane & 31)] = v; }
    LDS_WAIT(); asm volatile("" ::: "memory");
    const int c = lane & 7;
#pragma unroll
    for (int j = 0; j < 4; ++j) { const int n = (lane >> 3) + 8 * j; const LAS float* s = scr + (8 * c) * 33 + n;
        v4u o; o.x = pk2(s[0 * 33], s[1 * 33]); o.y = pk2(s[2 * 33], s[3 * 33]); o.z = pk2(s[4 * 33], s[5 * 33]); o.w = pk2(s[6 * 33], s[7 * 33]);
        *(GAS v4u*)(WT + (size_t)(row_off + n0 + n) * K + k0 + 8 * c) = o; }
    LDS_WAIT(); asm volatile("" ::: "memory");
}
__device__ __forceinline__ void rms_row_to_bf16(int lane, const float* xrow, const float* g, bf16* orow) {
    const GAS f32x4* xr = (const GAS f32x4*)xrow + lane; const GAS f32x4* gr = (const GAS f32x4*)g + lane;
    f32x4 v[4]; float s = 0.f;
#pragma unroll
    for (int j = 0; j < 4; ++j) { v[j] = xr[64 * j]; s += (v[j].x * v[j].x + v[j].y * v[j].y) + (v[j].z * v[j].z + v[j].w * v[j].w); }
    const float rstd = 1.f / sqrtf(wave_sum(s) * (1.f / DM) + EPS);
    GAS unsigned long long* o8 = (GAS unsigned long long*)orow + lane;
#pragma unroll
    for (int j = 0; j < 4; ++j) { const f32x4 gv = gr[64 * j];
        o8[64 * j] = (unsigned long long)pk2(v[j].x * rstd * gv.x, v[j].y * rstd * gv.y) | ((unsigned long long)pk2(v[j].z * rstd * gv.z, v[j].w * rstd * gv.w) << 32); }
}
__device__ __forceinline__ void p0_prologue(Frame& F) {
    const int lane = fresh_tid() & 63;
    LAS float* scr = (LAS float*)(F.lds + RING_OFF + F.wave * 16384);
    const int gw = F.vcu * NWAVES + F.wave, NGW = F.G * NWAVES;
    constexpr int I_IN = 16 * 96, I_SQ = 16 * 32, I_UP = 16 * 128, I_DN = 64 * 32;
    constexpr int NITEMS = I_IN + 5 * I_SQ + I_UP + I_DN;
    for (int it = gw; it < NITEMS; it += NGW) {
        int r = it;
        if (r < I_IN) { p0_transpose_item(F.in[I_WIN], DM, DIN, WSP(bf16, WS_WIN), 0, scr, r, lane, nullptr, true); continue; } r -= I_IN;
        if (r < I_SQ) { p0_transpose_item(F.in[I_WOUT], DM, DM, WSP(bf16, WS_WOUT), 0, scr, r, lane, nullptr, false); continue; } r -= I_SQ;
        if (r < I_SQ) { p0_transpose_item(F.in[I_WMQ], DM, DM, WSP(bf16, WS_WMQ), 0, scr, r, lane, F.in[I_NMEMQ], false); continue; } r -= I_SQ;
        if (r < I_SQ) { p0_transpose_item(F.in[I_WMK], DM, DM, WSP(bf16, WS_WMKV), 0, scr, r, lane, nullptr, false); continue; } r -= I_SQ;
        if (r < I_SQ) { p0_transpose_item(F.in[I_WMV], DM, DM, WSP(bf16, WS_WMKV), DM, scr, r, lane, nullptr, false); continue; } r -= I_SQ;
        if (r < I_SQ) { p0_transpose_item(F.in[I_WMO], DM, DM, WSP(bf16, WS_WMO), 0, scr, r, lane, nullptr, false); continue; } r -= I_SQ;
        if (r < I_UP) { p0_transpose_item(F.in[I_WUP], DM, FF, WSP(bf16, WS_WUP), 0, scr, r, lane, F.in[I_NMLP], false); continue; } r -= I_UP;
        p0_transpose_item(F.in[I_WDN], FF, DM, WSP(bf16, WS_WDN), 0, scr, r, lane, nullptr, false);
    }
    bf16* XN = WSP(bf16, WS_XN); bf16* MEMN = WSP(bf16, WS_MEMN);
    for (int m = gw; m < MPAD + 2 * NMEM; m += NGW) {
        if (m < MP) rms_row_to_bf16(lane, F.in[I_XP] + (size_t)m * DM, F.in[I_NMIX], XN + (size_t)m * DM);
        else if (m < MV) rms_row_to_bf16(lane, F.in[I_XS] + (size_t)(m - MP) * DM, F.in[I_NMIX], XN + (size_t)m * DM);
        else if (m < MPAD) { GAS v4u* o = (GAS v4u*)(XN + (size_t)m * DM) + lane; o[0] = (v4u){0u, 0u, 0u, 0u}; o[64] = (v4u){0u, 0u, 0u, 0u}; }
        else rms_row_to_bf16(lane, F.in[I_MEMP] + (size_t)(m - MPAD) * DM, F.in[I_NMEMKV], MEMN + (size_t)(m - MPAD) * DM);
    }
}

__device__ __forceinline__ f32x4 silu4(f32x4 x) {
    f32x4 r;
    r.x = x.x * __builtin_amdgcn_rcpf(1.f + __builtin_amdgcn_exp2f(-x.x * LOG2E)); r.y = x.y * __builtin_amdgcn_rcpf(1.f + __builtin_amdgcn_exp2f(-x.y * LOG2E));
    r.z = x.z * __builtin_amdgcn_rcpf(1.f + __builtin_amdgcn_exp2f(-x.z * LOG2E)); r.w = x.w * __builtin_amdgcn_rcpf(1.f + __builtin_amdgcn_exp2f(-x.w * LOG2E));
    return r;
}
__device__ __forceinline__ void st_bf16(bf16* p, float v) { *(GAS unsigned short*)p = (unsigned short)f2bf(v); }

struct EpiZ {
    static constexpr bool PERM = true, AFTER_DRAIN = false;
    bf16* Z; float* out; bf16* KRT; bf16* VRT;
    __device__ __forceinline__ void operator()(const pg8::f32x4 (&acc)[2][2][4][2], const pg8::Unit& u, int wr, int wc, int fr, int fq) const {
        const int pn = u.pn, row0 = u.pm * 256 + wr * 64 + fr, colw = wc * 32 + 8 * fq;
        if (pn < 2 || pn >= 10) {
#pragma unroll
            for (int ai = 0; ai < 2; ++ai)
#pragma unroll
                for (int m = 0; m < 4; ++m) { const int row = row0 + ai * 128 + m * 16; bf16* zp = Z + (size_t)row * DIN + pn * 256 + colw;
#pragma unroll
                    for (int bj = 0; bj < 2; ++bj) { f32x4 v0 = acc[ai][bj][m][0], v1 = acc[ai][bj][m][1];
                        if (pn < 2) { v0 = v0 * C2A; v1 = v1 * C2A; } else { v0 = silu4(v0); v1 = silu4(v1); }
                        *(GAS v4u*)(zp + bj * 128) = pack8(v0, v1); } }
        } else if (pn < 6) {
            const bool isK = pn < 4; const int cb = (pn & 1) * 256;
#pragma unroll
            for (int ai = 0; ai < 2; ++ai)
#pragma unroll
                for (int m = 0; m < 4; ++m) { const int row = row0 + ai * 128 + m * 16; bf16* zp = Z + (size_t)row * DIN + pn * 256 + colw;
                    float* dst = nullptr;
                    if (row < MP) dst = out + (isK ? OK_P : OV_P) + (size_t)row * 512; else if (row < MV) dst = out + (isK ? OK_S : OV_S) + (size_t)(row - MP) * 512;
#pragma unroll
                    for (int bj = 0; bj < 2; ++bj) { const f32x4 v0 = acc[ai][bj][m][0], v1 = acc[ai][bj][m][1]; const int c = cb + bj * 128 + colw;
                        if (dst) { *(GAS f32x4*)(dst + c) = v0; *(GAS f32x4*)(dst + c + 4) = v1; }
                        *(GAS v4u*)(zp + bj * 128) = pack8(v0, v1); } }
        } else if (pn < 8) {
            const bool isKr = pn == 7; const int j0 = 16 * (wc & 1) + 4 * fq, p0 = colw & 63;
            float invf[4];
#pragma unroll
            for (int i = 0; i < 4; ++i) invf[i] = exp2f(-(float)(j0 + i) * (13.287712379549449f / 31.0f));
            const float l2g0 = log2gamma(wc >> 1), l2g1 = log2gamma(2 + (wc >> 1));
#pragma unroll
            for (int ai = 0; ai < 2; ++ai)
#pragma unroll
                for (int m = 0; m < 4; ++m) { const int row = row0 + ai * 128 + m * 16; const int pos = row < MP ? (row & (TSEQ - 1)) : PASTLEN;
                    float cs[4], sn[4];
#pragma unroll
                    for (int i = 0; i < 4; ++i) { const float ang = (float)pos * invf[i]; double rv = (double)ang * 0.15915494309189535; rv -= floor(rv); const float rf = (float)rv;
                        sn[i] = __builtin_amdgcn_sinf(rf); cs[i] = __builtin_amdgcn_cosf(rf); }
                    const int t = row & (TSEQ - 1), b = row >> 13;
#pragma unroll
                    for (int bj = 0; bj < 2; ++bj) { const f32x4 v0 = acc[ai][bj][m][0], v1 = acc[ai][bj][m][1]; const int head = 2 * bj + (wc >> 1);
                        float y[8];
                        y[0] = v0.x * cs[0] - v0.y * sn[0]; y[1] = v0.y * cs[0] + v0.x * sn[0]; y[2] = v0.z * cs[1] - v0.w * sn[1]; y[3] = v0.w * cs[1] + v0.z * sn[1];
                        y[4] = v1.x * cs[2] - v1.y * sn[2]; y[5] = v1.y * cs[2] + v1.x * sn[2]; y[6] = v1.z * cs[3] - v1.w * sn[3]; y[7] = v1.w * cs[3] + v1.z * sn[3];
                        if (isKr) {
#pragma unroll
                            for (int e = 0; e < 8; ++e) y[e] *= 0.125f; }
                        *(GAS v4u*)(Z + (size_t)row * DIN + pn * 256 + bj * 128 + colw) = pack8((f32x4){y[0], y[1], y[2], y[3]}, (f32x4){y[4], y[5], y[6], y[7]});
                        if (isKr && row < MP) { const float dec = exp2f((float)(127 - (t & 127)) * (bj ? l2g1 : l2g0));
                            bf16* kp = KRT + ((size_t)((b * 4 + head) * 64 + p0)) * TSEQ + t;
#pragma unroll
                            for (int e = 0; e < 8; ++e) st_bf16(kp + (size_t)e * TSEQ, y[e] * dec); } } }
        } else {
#pragma unroll
            for (int ai = 0; ai < 2; ++ai)
#pragma unroll
                for (int m = 0; m < 4; ++m) { const int row = row0 + ai * 128 + m * 16; const int t = row & (TSEQ - 1), b = row >> 13;
#pragma unroll
                    for (int bj = 0; bj < 2; ++bj) { const f32x4 v0 = acc[ai][bj][m][0], v1 = acc[ai][bj][m][1]; const int head = (pn - 8) * 2 + bj;
                        *(GAS v4u*)(Z + (size_t)row * DIN + pn * 256 + bj * 128 + colw) = pack8(v0, v1);
                        if (row < MP) { bf16* vp = VRT + ((size_t)((b * 4 + head) * 128 + colw)) * TSEQ + t;
                            st_bf16(vp, v0.x); st_bf16(vp + (size_t)TSEQ, v0.y); st_bf16(vp + (size_t)2 * TSEQ, v0.z); st_bf16(vp + (size_t)3 * TSEQ, v0.w);
                            st_bf16(vp + (size_t)4 * TSEQ, v1.x); st_bf16(vp + (size_t)5 * TSEQ, v1.y); st_bf16(vp + (size_t)6 * TSEQ, v1.z); st_bf16(vp + (size_t)7 * TSEQ, v1.w); } } }
        }
    }
};
struct EpiMemKV {
    static constexpr bool PERM = true, AFTER_DRAIN = false;
    float* out; bf16* MKB; bf16* MVT;
    __device__ __forceinline__ void operator()(const pg8::f32x4 (&acc)[2][2][4][2], const pg8::Unit& u, int wr, int wc, int fr, int fq) const {
        const int pn = u.pn, row0 = u.pm * 256 + wr * 64 + fr, colw = wc * 32 + 8 * fq; const bool isK = pn < 4;
#pragma unroll
        for (int ai = 0; ai < 2; ++ai)
#pragma unroll
            for (int m = 0; m < 4; ++m) { const int row = row0 + ai * 128 + m * 16;
#pragma unroll
                for (int bj = 0; bj < 2; ++bj) { const f32x4 v0 = acc[ai][bj][m][0], v1 = acc[ai][bj][m][1]; const int c = (pn & 3) * 256 + bj * 128 + colw;
                    float* dst = out + (isK ? OMK : OMV) + (size_t)row * DM + c;
                    *(GAS f32x4*)dst = v0; *(GAS f32x4*)(dst + 4) = v1;
                    if (isK) *(GAS v4u*)(MKB + (size_t)row * DM + c) = pack8(v0, v1);
                    else { bf16* vp = MVT + (size_t)c * 512 + row;
                        st_bf16(vp, v0.x); st_bf16(vp + 512, v0.y); st_bf16(vp + 1024, v0.z); st_bf16(vp + 1536, v0.w); st_bf16(vp + 2048, v1.x); st_bf16(vp + 2560, v1.y); st_bf16(vp + 3072, v1.z); st_bf16(vp + 3584, v1.w); } } }
    }
};
template <bool BASEBF> struct EpiRes {
    static constexpr bool PERM = false, AFTER_DRAIN = false;
    const void* base; float* outf; bf16* outb; float* ssq;
    __device__ __forceinline__ void operator()(const pg8::f32x4 (&acc)[2][2][4][2], const pg8::Unit& u, int wr, int wc, int fr, int fq) const {
#pragma unroll
        for (int ai = 0; ai < 2; ++ai)
#pragma unroll
            for (int m = 0; m < 4; ++m) { const int row = u.pm * 256 + ai * 128 + wr * 64 + m * 16 + fr; float ss = 0.f;
#pragma unroll
                for (int bj = 0; bj < 2; ++bj)
#pragma unroll
                    for (int n = 0; n < 2; ++n) { const int c = u.pn * 256 + bj * 128 + wc * 32 + n * 16 + 4 * fq; f32x4 bv;
                        if (BASEBF) { const u32x2 bb = *(const GAS u32x2*)((const bf16*)base + (size_t)row * DM + c); bv = (f32x4){bflo(bb.x), bfhi(bb.x), bflo(bb.y), bfhi(bb.y)}; }
                        else bv = *(const GAS f32x4*)((const float*)base + (size_t)row * DM + c);
                        const f32x4 o = bv + acc[ai][bj][m][n];
                        if (outf) *(GAS f32x4*)(outf + (size_t)row * DM + c) = o;
                        if (outb) { u32x2 w; w.x = pg8::cvt_pk_bf16(o.x, o.y); w.y = pg8::cvt_pk_bf16(o.z, o.w); *(GAS u32x2*)(outb + (size_t)row * DM + c) = w; }
                        ss += (o.x * o.x + o.y * o.y) + (o.z * o.z + o.w * o.w); }
                ss += __shfl_xor(ss, 16); ss += __shfl_xor(ss, 32);
                if (fq == 0) ssq[(size_t)row * 16 + u.pn * 4 + wc] = ss; }
    }
};
__device__ __forceinline__ float rstd_from_ssq(const float* ssq, int row) {
    const GAS f32x4* p = (const GAS f32x4*)(ssq + (size_t)row * 16); const f32x4 a = p[0], b = p[1], c = p[2], d = p[3];
    const float s = ((a.x + a.y) + (a.z + a.w)) + ((b.x + b.y) + (b.z + b.w)) + ((c.x + c.y) + (c.z + c.w)) + ((d.x + d.y) + (d.z + d.w));
    return 1.f / sqrtf(s * (1.f / DM) + EPS);
}
template <int ACT  > struct EpiScale {
    static constexpr bool PERM = true, AFTER_DRAIN = false;
    bf16* O; int ldc; const float* ssq; float scale;
    __device__ __forceinline__ void operator()(const pg8::f32x4 (&acc)[2][2][4][2], const pg8::Unit& u, int wr, int wc, int fr, int fq) const {
        const int row0 = u.pm * 256 + wr * 64 + fr, colw = u.pn * 256 + wc * 32 + 8 * fq;
#pragma unroll
        for (int ai = 0; ai < 2; ++ai)
#pragma unroll
            for (int m = 0; m < 4; ++m) { const int row = row0 + ai * 128 + m * 16; const float rs = rstd_from_ssq(ssq, row) * scale;
#pragma unroll
                for (int bj = 0; bj < 2; ++bj) { f32x4 v0 = acc[ai][bj][m][0] * rs, v1 = acc[ai][bj][m][1] * rs;
                    if (ACT == 1) { v0.x = fmaxf(v0.x, 0.f); v0.y = fmaxf(v0.y, 0.f); v0.z = fmaxf(v0.z, 0.f); v0.w = fmaxf(v0.w, 0.f); v1.x = fmaxf(v1.x, 0.f); v1.y = fmaxf(v1.y, 0.f); v1.z = fmaxf(v1.z, 0.f); v1.w = fmaxf(v1.w, 0.f);
                        v0 = v0 * v0; v1 = v1 * v1; }
                    *(GAS v4u*)(O + (size_t)row * ldc + bj * 128 + colw) = pack8(v0, v1); } }
    }
};
struct EpiPlain {
    static constexpr bool PERM = true, AFTER_DRAIN = false;
    bf16* O; int ldc;
    __device__ __forceinline__ void operator()(const pg8::f32x4 (&acc)[2][2][4][2], const pg8::Unit& u, int wr, int wc, int fr, int fq) const {
        const int row0 = u.pm * 256 + wr * 64 + fr, colw = u.pn * 256 + wc * 32 + 8 * fq;
#pragma unroll
        for (int ai = 0; ai < 2; ++ai)
#pragma unroll
            for (int m = 0; m < 4; ++m) { const int row = row0 + ai * 128 + m * 16;
#pragma unroll
                for (int bj = 0; bj < 2; ++bj) *(GAS v4u*)(O + (size_t)row * ldc + bj * 128 + colw) = pack8(acc[ai][bj][m][0], acc[ai][bj][m][1]); }
    }
};
struct EpiSoftmax {
    static constexpr bool PERM = true, AFTER_DRAIN = true;
    bf16* O; int ldc;
    __device__ __forceinline__ void fused(pg8::f32x4 (&acc)[2][2][4][2], const pg8::Unit& u, int wr, int wc, int fr, int fq, PG8_LAS unsigned char* lds, int wid, int lane) const {
        PG8_LAS float* PMX = (PG8_LAS float*)lds;
        PG8_LAS float* PSM = (PG8_LAS float*)(lds + 4096);
#pragma unroll
        for (int ai = 0; ai < 2; ++ai)
#pragma unroll
            for (int m = 0; m < 4; ++m) { float mx = -INFINITY;
#pragma unroll
                for (int bj = 0; bj < 2; ++bj)
#pragma unroll
                    for (int n = 0; n < 2; ++n) { const pg8::f32x4 x = acc[ai][bj][m][n]; mx = fmaxf(mx, fmaxf(fmaxf(x.x, x.y), fmaxf(x.z, x.w))); }
                mx = fmaxf(mx, __shfl_xor(mx, 16)); mx = fmaxf(mx, __shfl_xor(mx, 32));
                if (fq == 0) PMX[(ai * 128 + wr * 64 + m * 16 + fr) * 4 + wc] = mx; }
        asm volatile("s_waitcnt lgkmcnt(0)" ::: "memory"); __builtin_amdgcn_s_barrier(); asm volatile("" ::: "memory");
#pragma unroll
        for (int ai = 0; ai < 2; ++ai)
#pragma unroll
            for (int m = 0; m < 4; ++m) { const int r = ai * 128 + wr * 64 + m * 16 + fr; const pg8::f32x4 q = *(const PG8_LAS pg8::f32x4*)(PMX + r * 4);
                const float mx = fmaxf(fmaxf(q.x, q.y), fmaxf(q.z, q.w)); float s = 0.f;
#pragma unroll
                for (int bj = 0; bj < 2; ++bj)
#pragma unroll
                    for (int n = 0; n < 2; ++n) { pg8::f32x4 x = acc[ai][bj][m][n];
                        x.x = __builtin_amdgcn_exp2f(x.x - mx); x.y = __builtin_amdgcn_exp2f(x.y - mx); x.z = __builtin_amdgcn_exp2f(x.z - mx); x.w = __builtin_amdgcn_exp2f(x.w - mx);
                        acc[ai][bj][m][n] = x; s += (x.x + x.y) + (x.z + x.w); }
                s += __shfl_xor(s, 16); s += __shfl_xor(s, 32);
                if (fq == 0) PSM[r * 4 + wc] = s; }
        asm volatile("s_waitcnt lgkmcnt(0)" ::: "memory"); __builtin_amdgcn_s_barrier(); asm volatile("" ::: "memory");
        const int colw = wc * 32 + 8 * fq;
#pragma unroll
        for (int ai = 0; ai < 2; ++ai)
#pragma unroll
            for (int m = 0; m < 4; ++m) { const int r = ai * 128 + wr * 64 + m * 16 + fr; const pg8::f32x4 q = *(const PG8_LAS pg8::f32x4*)(PSM + r * 4);
                const float inv = 1.f / ((q.x + q.y) + (q.z + q.w));
#pragma unroll
                for (int bj = 0; bj < 2; ++bj) *(GAS v4u*)(O + (size_t)(u.pm * 256 + r) * ldc + bj * 128 + colw) = pack8(acc[ai][bj][m][0] * inv, acc[ai][bj][m][1] * inv); }
    }
};

__device__ __forceinline__ f32x16 mfma32(bf16x8 a, bf16x8 b, f32x16 c) { return __builtin_amdgcn_mfma_f32_32x32x16_bf16(a, b, c, 0, 0, 0); }
__device__ __forceinline__ int crow16(int r, int hh) { return (r & 3) + 8 * (r >> 2) + 4 * hh; }

__device__ __forceinline__ void ret_stepA(Frame& F, int bh, int c) {
    const int tid = fresh_tid(), lane = tid & 63; (void)tid; (void)lane;
    const int w = F.wave, r = lane & 31, hh = lane >> 5, db = w >> 2, eb = w & 3;
    const bf16* ka = WSP(bf16, WS_KRT) + ((size_t)(bh * 64 + 32 * db + r)) * TSEQ + c * 128 + 8 * hh;
    const bf16* va = WSP(bf16, WS_VRT) + ((size_t)(bh * 128 + 32 * eb + r)) * TSEQ + c * 128 + 8 * hh;
    bf16x8 af[8], bfr[8];
#pragma unroll
    for (int ks = 0; ks < 8; ++ks) { af[ks] = *(const GAS bf16x8*)(ka + 16 * ks); bfr[ks] = *(const GAS bf16x8*)(va + 16 * ks); }
    f32x16 acc = {};
#pragma unroll
    for (int ks = 0; ks < 8; ++ks) acc = mfma32(af[ks], bfr[ks], acc);
    float* up = WSP(float, WS_U) + ((size_t)(bh * 64 + c) * 64 + 32 * db) * 128 + 32 * eb + r;
#pragma unroll
    for (int q = 0; q < 16; ++q) up[(size_t)crow16(q, hh) * 128] = acc[q];
}

__device__ __forceinline__ void dec_attn_unit(Frame& F, int s, int hp) {
    const int tid = fresh_tid(), lane = tid & 63; (void)tid; (void)lane;
    LAS float* sc = (LAS float*)(F.lds);
    LAS float* wm = (LAS float*)(F.lds + 36864);
    LAS float* wo = (LAS float*)(F.lds + 40960);
    const LAS float* tab = (const LAS float*)(F.lds + TAB_OFF);
    const int w = F.wave, l = lane, hsel = l >> 5, f = l & 31, g = l >> 4, h = 2 * hp + hsel, row = MP + s;
    const bf16* Z = WSP(bf16, WS_Z);
    const u32x2 qq = *(const GAS u32x2*)(Z + (size_t)row * DIN + ZQA + h * 128 + 4 * f);
    const f32x4 q4 = {bflo(qq.x), bfhi(qq.x), bflo(qq.y), bfhi(qq.y)};
    const int* pt = (const int*)F.in[I_PT] + s * 16;
    const int pg0 = __builtin_amdgcn_readfirstlane(pt[2 * w]), pg1 = __builtin_amdgcn_readfirstlane(pt[2 * w + 1]);
    LAS float* scw = sc + w * 1040;
    const LAS float* tabh = tab + h * 128;
    const float* ck = F.in[I_CK]; const float* cv = F.in[I_CV];
    for (int kk0 = 0; kk0 < 256; kk0 += 8) {
        const int page = kk0 < 128 ? pg0 : pg1; f32x4 kv[8];
#pragma unroll
        for (int i = 0; i < 8; ++i) kv[i] = *(const GAS f32x4*)(ck + ((size_t)(page * 128 + ((kk0 + i) & 127)) * 4 + 2 * hp) * 128 + 4 * l);
#pragma unroll
        for (int i = 0; i < 8; ++i) { float p = (kv[i].x * q4.x + kv[i].y * q4.y) + (kv[i].z * q4.z + kv[i].w * q4.w); p = row16_sum(p);
            const int rel = PASTLEN - (w * 256 + kk0 + i); const float bsv = tabh[rel < 127 ? rel : 127];
            if ((l & 15) == 0) scw[(kk0 + i) * 4 + g] = p + bsv; }
    }
    const int nk = (w == 0) ? 257 : 256;
    if (w == 0) { const f32x4 kn = *(const GAS f32x4*)(F.out + OK_S + (size_t)s * 512 + h * 128 + 4 * f);
        float p = (kn.x * q4.x + kn.y * q4.y) + (kn.z * q4.z + kn.w * q4.w); p = row16_sum(p);
        if ((l & 15) == 0) scw[256 * 4 + g] = p + tabh[0]; }
    LDS_WAIT(); asm volatile("" ::: "memory");
    float mg0, mg1, mg2, mg3, lg0, lg1, lg2, lg3;
    { float m0 = -INFINITY, m1 = -INFINITY, m2 = -INFINITY, m3 = -INFINITY;
      for (int kk = l; kk < nk; kk += 64) { const f32x4 v = *(const LAS f32x4*)(scw + kk * 4); m0 = fmaxf(m0, v.x); m1 = fmaxf(m1, v.y); m2 = fmaxf(m2, v.z); m3 = fmaxf(m3, v.w); }
      mg0 = wave_max(m0); mg1 = wave_max(m1); mg2 = wave_max(m2); mg3 = wave_max(m3);
      float s0 = 0.f, s1 = 0.f, s2 = 0.f, s3 = 0.f;
      for (int kk = l; kk < nk; kk += 64) { f32x4 v = *(const LAS f32x4*)(scw + kk * 4);
          v.x = __builtin_amdgcn_exp2f(v.x - mg0); v.y = __builtin_amdgcn_exp2f(v.y - mg1); v.z = __builtin_amdgcn_exp2f(v.z - mg2); v.w = __builtin_amdgcn_exp2f(v.w - mg3);
          *(LAS f32x4*)(scw + kk * 4) = v; s0 += v.x; s1 += v.y; s2 += v.z; s3 += v.w; }
      lg0 = wave_sum(s0); lg1 = wave_sum(s1); lg2 = wave_sum(s2); lg3 = wave_sum(s3); }
    LDS_WAIT(); asm volatile("" ::: "memory");
    f32x4 o1 = {0.f, 0.f, 0.f, 0.f}, o2 = {0.f, 0.f, 0.f, 0.f};
    for (int kk0 = 0; kk0 < 256; kk0 += 8) {
        const int page = kk0 < 128 ? pg0 : pg1; f32x4 vv[8];
#pragma unroll
        for (int i = 0; i < 8; ++i) vv[i] = *(const GAS f32x4*)(cv + ((size_t)(page * 128 + ((kk0 + i) & 127)) * 4 + 2 * hp) * 128 + 4 * l);
#pragma unroll
        for (int i = 0; i < 8; ++i) { const float p1 = scw[(kk0 + i) * 4 + hsel * 2], p2 = scw[(kk0 + i) * 4 + hsel * 2 + 1]; o1 = o1 + vv[i] * p1; o2 = o2 + vv[i] * p2; }
    }
    if (w == 0) { const f32x4 vn = *(const GAS f32x4*)(F.out + OV_S + (size_t)s * 512 + h * 128 + 4 * f);
        const float p1 = scw[256 * 4 + hsel * 2], p2 = scw[256 * 4 + hsel * 2 + 1]; o1 = o1 + vn * p1; o2 = o2 + vn * p2; }
    if (l < 4) { const float mv = l == 0 ? mg0 : l == 1 ? mg1 : l == 2 ? mg2 : mg3, lv = l == 0 ? lg0 : l == 1 ? lg1 : l == 2 ? lg2 : lg3; wm[w * 4 + l] = mv; wm[32 + w * 4 + l] = lv; }
    *(LAS f32x4*)(wo + ((w * 2 + 0) * 64 + l) * 4) = o1; *(LAS f32x4*)(wo + ((w * 2 + 1) * 64 + l) * 4) = o2;
    LDS_WAIT(); __syncthreads();
    if (tid < 128) { const int map = tid >> 6, ll = tid & 63, gg = (ll >> 5) * 2 + map;
        float M = -INFINITY;
#pragma unroll
        for (int ww = 0; ww < 8; ++ww) M = fmaxf(M, wm[ww * 4 + gg]);
        float L = 0.f; f32x4 o = {0.f, 0.f, 0.f, 0.f};
#pragma unroll
        for (int ww = 0; ww < 8; ++ww) { const float e = __builtin_amdgcn_exp2f(wm[ww * 4 + gg] - M); L += wm[32 + ww * 4 + gg] * e; o = o + *(const LAS f32x4*)(wo + ((ww * 2 + map) * 64 + ll) * 4) * e; }
        const float inv = 1.f / L; u32x2 ov; ov.x = pk2(o.x * inv, o.y * inv); ov.y = pk2(o.z * inv, o.w * inv);
        *(GAS u32x2*)(WSP(bf16, WS_OA) + (size_t)row * DM + map * 512 + (2 * hp + (ll >> 5)) * 128 + 4 * (ll & 31)) = ov; }
    LDS_WAIT(); __syncthreads();
}

__device__ __forceinline__ void dec_ret_unit(Frame& F, int s, int h) {
    const int tid = fresh_tid(), lane = tid & 63; (void)tid; (void)lane;
    LAS float* part = (LAS float*)(F.lds);
    LAS float* half = (LAS float*)(F.lds + 2048);
    const int e = tid & 127, dg = tid >> 7, row = MP + s;
    const bf16* Zr = WSP(bf16, WS_Z) + (size_t)row * DIN;
    const float gam = 1.0f - exp2f(-(float)(5 + h));
    const float v = bf2f(Zr[ZVR + h * 128 + e]);
    const float* Sin = F.in[I_SRET] + ((size_t)(s * 4 + h) * 64) * 128 + e; float* Sout = F.out + OS_S + ((size_t)(s * 4 + h) * 64) * 128 + e;
    float op = 0.f;
#pragma unroll 4
    for (int i = 0; i < 16; ++i) { const int d = dg * 16 + i, p = 2 * (d & 31) + (d >> 5);
        const float kq = bf2f(Zr[ZKR + h * 64 + p]), qq = bf2f(Zr[ZQR + h * 64 + p]);
        const float sn = gam * Sin[(size_t)d * 128] + kq * v; Sout[(size_t)d * 128] = sn; op += qq * sn; }
    part[dg * 128 + e] = op;
    LDS_WAIT(); __syncthreads();
    float o = 0.f;
    if (tid < 128) { o = (part[e] + part[128 + e]) + (part[256 + e] + part[384 + e]); const float ss = wave_sum(o * o); if (lane == 0) half[F.wave] = ss; }
    LDS_WAIT(); __syncthreads();
    if (tid < 128) { const float rs = 1.f / sqrtf((half[0] + half[1]) * (1.f / 128.f) + EPS);
        st_bf16(WSP(bf16, WS_MIX) + (size_t)row * DM + 512 + h * 128 + e, o * rs * bf2f(Zr[ZGR + h * 128 + e])); }
    LDS_WAIT(); __syncthreads();
}

__device__ __forceinline__ void ret_scan(Frame& F, int wgi) {
    const int tid = fresh_tid(), lane = tid & 63; (void)tid; (void)lane;
    const int bh = wgi >> 4, p = (wgi & 15) * 4 + (tid >> 7), e = tid & 127, h = bh & 3;
    const float g = exp2f(128.f * log2gamma(h));
    const float* up = WSP(float, WS_U) + ((size_t)(bh * 64) * 64 + p) * 128 + e;
    bf16* sp = WSP(bf16, WS_SPT) + ((size_t)(bh * 64) * 128 + e) * 64 + p;
    float st = 0.f;
    for (int c0 = 0; c0 < 64; c0 += 8) { float uu[8];
#pragma unroll
        for (int i = 0; i < 8; ++i) uu[i] = up[(size_t)(c0 + i) * 8192];
#pragma unroll
        for (int i = 0; i < 8; ++i) { st_bf16(sp + (size_t)(c0 + i) * 8192, st); st = g * st + uu[i]; } }
    const int dn = (p >> 1) + 32 * (p & 1);
    F.out[OS_P + ((size_t)(bh * 64 + dn)) * 128 + e] = st;
}
__device__ __forceinline__ void merge_a_rows(Frame& F) {
    const int tid = fresh_tid(), lane = tid & 63; (void)tid; (void)lane;
    const int gw = F.vcu * NWAVES + F.wave, NGW = F.G * NWAVES, l = lane;
    const float lam = lam_value(F, lane);
    const f32x4 g0 = *(const GAS f32x4*)(F.in[I_SUBLN] + (8 * l & 127)), g1 = *(const GAS f32x4*)(F.in[I_SUBLN] + (8 * l & 127) + 4);
    const bf16* OA = WSP(bf16, WS_OA); bf16* MIX = WSP(bf16, WS_MIX);
    for (int m = gw; m < MV; m += NGW) {
        const v4u a = *(const GAS v4u*)(OA + (size_t)m * DM + 8 * l), b = *(const GAS v4u*)(OA + (size_t)m * DM + 512 + 8 * l);
        float x[8];
        x[0] = bflo(a.x) - lam * bflo(b.x); x[1] = bfhi(a.x) - lam * bfhi(b.x); x[2] = bflo(a.y) - lam * bflo(b.y); x[3] = bfhi(a.y) - lam * bfhi(b.y);
        x[4] = bflo(a.z) - lam * bflo(b.z); x[5] = bfhi(a.z) - lam * bfhi(b.z); x[6] = bflo(a.w) - lam * bflo(b.w); x[7] = bfhi(a.w) - lam * bfhi(b.w);
        float ss = 0.f;
#pragma unroll
        for (int i = 0; i < 8; ++i) ss += x[i] * x[i];
        ss = row16_sum(ss);
        const float rs = ONE_M_LAMINIT / sqrtf(ss * (1.f / 128.f) + EPS);
        v4u o; o.x = pk2(x[0] * rs * g0.x, x[1] * rs * g0.y); o.y = pk2(x[2] * rs * g0.z, x[3] * rs * g0.w); o.z = pk2(x[4] * rs * g1.x, x[5] * rs * g1.y); o.w = pk2(x[6] * rs * g1.z, x[7] * rs * g1.w);
        *(GAS v4u*)(MIX + (size_t)m * DM + 8 * l) = o;
    }
}

__device__ __forceinline__ void ret_stepC(Frame& F, int bh, int c) {
    const int tid = fresh_tid(), lane = tid & 63; (void)tid;
    LAS float* psum = (LAS float*)(F.lds);
    const int w = F.wave, r = lane & 31, hh = lane >> 5, rb = w >> 1, ch = w & 1, b = bh >> 2, h = bh & 3;
    const size_t row0 = (size_t)b * TSEQ + c * 128;
    const bf16* Z = WSP(bf16, WS_Z);
    const float l2g = log2gamma(h);
    bf16x8 qf[4];
#pragma unroll
    for (int ks = 0; ks < 4; ++ks) qf[ks] = *(const GAS bf16x8*)(Z + (row0 + 32 * rb + r) * DIN + ZQR + h * 64 + 16 * ks + 8 * hh);
    f32x16 o[2], oc[2];
    o[0] = (f32x16){}; o[1] = (f32x16){}; oc[0] = (f32x16){}; oc[1] = (f32x16){};
    const bf16* spt = WSP(bf16, WS_SPT) + ((size_t)(bh * 64 + c) * 128 + 64 * ch + r) * 64 + 8 * hh;
    const bf16* vt = WSP(bf16, WS_VRT) + ((size_t)(bh * 128 + 64 * ch + r)) * TSEQ + c * 128 + 4 * hh;
    const bf16* kz = Z + (row0 + r) * DIN + ZKR + h * 64 + 8 * hh;
    bf16x8 sb[2][4]; unsigned short gt[16][2];
#pragma unroll
    for (int eb = 0; eb < 2; ++eb)
#pragma unroll
        for (int ks = 0; ks < 4; ++ks) sb[eb][ks] = *(const GAS bf16x8*)(spt + (size_t)(32 * eb) * 64 + 16 * ks);
#pragma unroll
    for (int q = 0; q < 16; ++q)
#pragma unroll
        for (int eb = 0; eb < 2; ++eb) gt[q][eb] = *(const GAS unsigned short*)(Z + (row0 + 32 * rb + crow16(q, hh)) * DIN + ZGR + h * 128 + 64 * ch + 32 * eb + r);
#pragma unroll
    for (int half = 0; half < 2; ++half) {
        if (2 * half > rb) break;
        bf16x8 kf[2][4]; u32x2 vlo[2][2][2], vhi[2][2][2];
#pragma unroll
        for (int jj = 0; jj < 2; ++jj) { const int jb = 2 * half + jj;
#pragma unroll
            for (int ks = 0; ks < 4; ++ks) kf[jj][ks] = *(const GAS bf16x8*)(kz + (size_t)(32 * jb) * DIN + 16 * ks);
#pragma unroll
            for (int s2 = 0; s2 < 2; ++s2)
#pragma unroll
                for (int eb = 0; eb < 2; ++eb) { const bf16* vp = vt + (size_t)(32 * eb) * TSEQ + 32 * jb + 16 * s2; vlo[jj][s2][eb] = *(const GAS u32x2*)vp; vhi[jj][s2][eb] = *(const GAS u32x2*)(vp + 8); } }
        if (half == 0) {
#pragma unroll
            for (int eb = 0; eb < 2; ++eb)
#pragma unroll
                for (int ks = 0; ks < 4; ++ks) oc[eb] = mfma32(qf[ks], sb[eb][ks], oc[eb]); }
#pragma unroll
        for (int jj = 0; jj < 2; ++jj) { const int jb = 2 * half + jj;
            if (jb <= rb) {
                f32x16 st = {};
#pragma unroll
                for (int ks = 0; ks < 4; ++ks) st = mfma32(kf[jj][ks], qf[ks], st);
                const int irel = 32 * (rb - jb) + r;
#pragma unroll
                for (int q = 0; q < 16; ++q) { const int d = irel - crow16(q, hh); st[q] = d >= 0 ? st[q] * exp2f((float)d * l2g) : 0.f; }
#pragma unroll
                for (int s2 = 0; s2 < 2; ++s2) {
                    v4u pw; pw.x = pg8::cvt_pk_bf16(st[8 * s2 + 0], st[8 * s2 + 1]); pw.y = pg8::cvt_pk_bf16(st[8 * s2 + 2], st[8 * s2 + 3]); pw.z = pg8::cvt_pk_bf16(st[8 * s2 + 4], st[8 * s2 + 5]); pw.w = pg8::cvt_pk_bf16(st[8 * s2 + 6], st[8 * s2 + 7]);
                    const bf16x8 pa = __builtin_bit_cast(bf16x8, pw);
#pragma unroll
                    for (int eb = 0; eb < 2; ++eb) { v4u vb; vb.x = vlo[jj][s2][eb].x; vb.y = vlo[jj][s2][eb].y; vb.z = vhi[jj][s2][eb].x; vb.w = vhi[jj][s2][eb].y;
                        o[eb] = mfma32(pa, __builtin_bit_cast(bf16x8, vb), o[eb]); }
                }
            }
        }
    }
    float ssr[16];
#pragma unroll
    for (int q = 0; q < 16; ++q) { const float sc = exp2f((float)(32 * rb + crow16(q, hh) + 1) * l2g);
        o[0][q] += sc * oc[0][q]; o[1][q] += sc * oc[1][q];
        float ss = o[0][q] * o[0][q] + o[1][q] * o[1][q]; ss = row16_sum(ss); ss += __shfl_xor(ss, 16); ssr[q] = ss; }
    if (r == 0) {
#pragma unroll
        for (int q = 0; q < 16; ++q) psum[ch * 128 + 32 * rb + crow16(q, hh)] = ssr[q]; }
    LDS_WAIT(); __syncthreads();
    bf16* MIX = WSP(bf16, WS_MIX);
#pragma unroll
    for (int q = 0; q < 16; ++q) { const int i = 32 * rb + crow16(q, hh); const float rs = 1.f / sqrtf((psum[i] + psum[128 + i]) * (1.f / 128.f) + EPS);
#pragma unroll
        for (int eb = 0; eb < 2; ++eb) { const int e = 64 * ch + 32 * eb + r;
            st_bf16(MIX + (row0 + i) * DM + 512 + h * 128 + e, o[eb][q] * rs * bf2f(gt[q][eb])); } }
    LDS_WAIT(); __syncthreads();
}

__device__ __forceinline__ void dec_mem_unit(Frame& F, int s, int hp) {
    const int tid = fresh_tid(), lane = tid & 63; (void)tid; (void)lane;
    LAS float* sc = (LAS float*)(F.lds);
    LAS float* wo = (LAS float*)(F.lds + 4096);
    const int w = F.wave, l = lane, row = MP + s;
    const bf16* QM = WSP(bf16, WS_QM);
    f32x4 q4[2];
#pragma unroll
    for (int hs = 0; hs < 2; ++hs) { const u32x2 qq = *(const GAS u32x2*)(QM + (size_t)row * DM + (2 * hp + hs) * 256 + 4 * l); q4[hs] = (f32x4){bflo(qq.x), bfhi(qq.x), bflo(qq.y), bfhi(qq.y)}; }
    const float* ck = F.in[I_CMK] + ((size_t)s * NMEM * 4 + 2 * hp) * 256 + 4 * l; const float* cv = F.in[I_CMV] + ((size_t)s * NMEM * 4 + 2 * hp) * 256 + 4 * l;
    for (int m0 = 0; m0 < 32; m0 += 4) { f32x4 kv[8];
#pragma unroll
        for (int i = 0; i < 8; ++i) kv[i] = *(const GAS f32x4*)(ck + (size_t)(32 * w + m0 + (i >> 1)) * 1024 + (i & 1) * 256);
#pragma unroll
        for (int i = 0; i < 8; ++i) { const f32x4 q = q4[i & 1]; float p = (kv[i].x * q.x + kv[i].y * q.y) + (kv[i].z * q.z + kv[i].w * q.w); p = wave_sum(p);
            if (l == 0) sc[(i & 1) * 256 + 32 * w + m0 + (i >> 1)] = p; } }
    LDS_WAIT(); __syncthreads();
    float M[2], IL[2];
#pragma unroll
    for (int hs = 0; hs < 2; ++hs) { const f32x4 v = *(const LAS f32x4*)(sc + hs * 256 + 4 * l); const float mx = wave_max(fmaxf(fmaxf(v.x, v.y), fmaxf(v.z, v.w)));
        const float sm = (__builtin_amdgcn_exp2f(v.x - mx) + __builtin_amdgcn_exp2f(v.y - mx)) + (__builtin_amdgcn_exp2f(v.z - mx) + __builtin_amdgcn_exp2f(v.w - mx));
        M[hs] = mx; IL[hs] = 1.f / wave_sum(sm); }
    f32x4 o[2]; o[0] = (f32x4){0.f, 0.f, 0.f, 0.f}; o[1] = (f32x4){0.f, 0.f, 0.f, 0.f};
    for (int m0 = 0; m0 < 32; m0 += 4) { f32x4 vv[8];
#pragma unroll
        for (int i = 0; i < 8; ++i) vv[i] = *(const GAS f32x4*)(cv + (size_t)(32 * w + m0 + (i >> 1)) * 1024 + (i & 1) * 256);
#pragma unroll
        for (int i = 0; i < 8; ++i) { const int hs = i & 1; const float p = __builtin_amdgcn_exp2f(sc[hs * 256 + 32 * w + m0 + (i >> 1)] - M[hs]) * IL[hs]; o[hs] = o[hs] + vv[i] * p; } }
    *(LAS f32x4*)(wo + ((w * 2 + 0) * 64 + l) * 4) = o[0]; *(LAS f32x4*)(wo + ((w * 2 + 1) * 64 + l) * 4) = o[1];
    LDS_WAIT(); __syncthreads();
    if (tid < 128) { const int hs = tid >> 6, ll = tid & 63; f32x4 a = {0.f, 0.f, 0.f, 0.f};
#pragma unroll
        for (int ww = 0; ww < 8; ++ww) a = a + *(const LAS f32x4*)(wo + ((ww * 2 + hs) * 64 + ll) * 4);
        u32x2 ov; ov.x = pk2(a.x, a.y); ov.y = pk2(a.z, a.w);
        *(GAS u32x2*)(WSP(bf16, WS_OM) + (size_t)row * DM + (2 * hp + hs) * 256 + 4 * ll) = ov; }
    LDS_WAIT(); __syncthreads();
}

__device__ __forceinline__ void final_norm_rows(Frame& F) {
    const int tid = fresh_tid(), lane = tid & 63; (void)tid; (void)lane;
    const int gw = F.vcu * NWAVES + F.wave, NGW = F.G * NWAVES, l = lane;
    const float* X3 = WSP(float, WS_X3); const float* ssq = WSP(float, WS_SSQ3);
    for (int m = gw; m < MV; m += NGW) {
        float s;
        if (m < MP) s = row16_sum(ssq[(size_t)m * 16 + (l & 15)]);
        else { const f32x2 q = *(const GAS f32x2*)(WSP(float, WS_SSQS3) + (m - MP) * 32 + 2 * (l & 15)); s = row16_sum(q.x + q.y); }
        const float rs = 1.f / sqrtf(s * (1.f / DM) + EPS);
        float* dst = m < MP ? F.out + OY_P + (size_t)m * DM : F.out + OY_S + (size_t)(m - MP) * DM;
#pragma unroll
        for (int j = 0; j < 4; ++j) { const f32x4 x = *(const GAS f32x4*)(X3 + (size_t)m * DM + 256 * j + 4 * l), g = *(const GAS f32x4*)(F.in[I_NFIN] + 256 * j + 4 * l);
            *(GAS f32x4*)(dst + 256 * j + 4 * l) = x * rs * g; }
    }
}

template <int K, class Epi> __device__ __forceinline__ void sgemm_unit(Frame& F, const bf16* A, int lda, const bf16* Bt, int rb, int cb, const Epi& E) {
    const int tid = fresh_tid(), lane = tid & 63, r = lane & 31, hh = lane >> 5, w = F.wave;
    constexpr int KW = K / 8, NS = KW / 16;
    LAS float* part = (LAS float*)(F.lds);
    const bf16* ap = A + (size_t)(32 * rb + r) * lda + w * KW + 8 * hh; const bf16* bp = Bt + (size_t)(32 * cb + r) * K + w * KW + 8 * hh;
    f32x16 acc = {};
#pragma unroll
    for (int s0 = 0; s0 < NS; s0 += 8) { bf16x8 af[8], bfr[8];
#pragma unroll
        for (int i = 0; i < 8; ++i) { af[i] = *(const GAS bf16x8*)(ap + 16 * (s0 + i)); bfr[i] = *(const GAS bf16x8*)(bp + 16 * (s0 + i)); }
#pragma unroll
        for (int i = 0; i < 8; ++i) acc = mfma32(af[i], bfr[i], acc); }
#pragma unroll
    for (int q = 0; q < 16; ++q) part[(w * 32 + crow16(q, hh)) * 32 + r] = acc[q];
    LDS_WAIT(); __syncthreads();
    const int row = tid >> 4, c2 = (tid & 15) * 2; float v0 = 0.f, v1 = 0.f;
#pragma unroll
    for (int ww = 0; ww < 8; ++ww) { const LAS float* p = part + (ww * 32 + row) * 32 + c2; v0 += p[0]; v1 += p[1]; }
    E(32 * rb + row, 32 * cb + c2, v0, v1, lane);
    LDS_WAIT(); __syncthreads();
}
__device__ __forceinline__ unsigned pk2c(float a, float b) { return pg8::cvt_pk_bf16(a, b); }
struct SEpiZ {
    bf16* Z; float* out;
    __device__ __forceinline__ void operator()(int srow, int col, float v0, float v1, int lane) const {
        bf16* zp = Z + (size_t)(MP + srow) * DIN + col;
        if (col < ZKA) { v0 *= C2A; v1 *= C2A; }
        else if (col < ZQR) { float* dst = out + (col < ZVA ? OK_S + (size_t)srow * 512 + (col - ZKA) : OV_S + (size_t)srow * 512 + (col - ZVA)); *(GAS f32x2*)dst = (f32x2){v0, v1}; }
        else if (col < ZVR) { const int j = ((col - ZQR) & 63) >> 1; const float ang = (float)PASTLEN * exp2f(-(float)j * (13.287712379549449f / 31.0f));
            double rv = (double)ang * 0.15915494309189535; rv -= floor(rv); const float rf = (float)rv; const float sn = __builtin_amdgcn_sinf(rf), cs = __builtin_amdgcn_cosf(rf);
            const float y0 = v0 * cs - v1 * sn, y1 = v1 * cs + v0 * sn; const float sc = col >= ZKR ? 0.125f : 1.0f; v0 = y0 * sc; v1 = y1 * sc; }
        else if (col >= ZGR) { v0 = v0 * __builtin_amdgcn_rcpf(1.f + __builtin_amdgcn_exp2f(-v0 * LOG2E)); v1 = v1 * __builtin_amdgcn_rcpf(1.f + __builtin_amdgcn_exp2f(-v1 * LOG2E)); }
        *(GAS unsigned*)zp = pk2c(v0, v1);
    }
};
template <bool BASEBF> struct SEpiRes {
    const void* base; float* outf; bf16* outb; float* ssq;
    __device__ __forceinline__ void operator()(int srow, int col, float v0, float v1, int lane) const {
        float b0, b1;
        if (BASEBF) { const unsigned bb = *(const GAS unsigned*)((const bf16*)base + (size_t)srow * DM + col); b0 = bflo(bb); b1 = bfhi(bb); }
        else { const f32x2 b = *(const GAS f32x2*)((const float*)base + (size_t)srow * DM + col); b0 = b.x; b1 = b.y; }
        const float o0 = b0 + v0, o1 = b1 + v1;
        if (outf) *(GAS f32x2*)(outf + (size_t)srow * DM + col) = (f32x2){o0, o1};
        if (outb) *(GAS unsigned*)(outb + (size_t)srow * DM + col) = pk2c(o0, o1);
        const float ss = row16_sum(o0 * o0 + o1 * o1);
        if ((lane & 15) == 0) ssq[srow * 32 + (col >> 5)] = ss;
    }
};
template <int ACT> struct SEpiScale {
    bf16* O; int ldc; const float* ssq; float scale;
    __device__ __forceinline__ void operator()(int srow, int col, float v0, float v1, int lane) const {
        const f32x2 q = *(const GAS f32x2*)(ssq + srow * 32 + 2 * (lane & 15)); const float s = row16_sum(q.x + q.y);
        const float rs = scale / sqrtf(s * (1.f / DM) + EPS); v0 *= rs; v1 *= rs;
        if (ACT == 1) { v0 = fmaxf(v0, 0.f); v1 = fmaxf(v1, 0.f); v0 *= v0; v1 *= v1; }
        *(GAS unsigned*)(O + (size_t)srow * ldc + col) = pk2c(v0, v1);
    }
};

#ifndef PG8_SP2
#define PG8_SP2 true
#endif
#ifndef PG8_ALIGN
#define PG8_ALIGN true
#endif
struct Args { const float* in[N_IN]; float* out; unsigned char* ws; int ph_lo, ph_hi, li, pad; };
__global__ void __launch_bounds__(NWAVES * 64, 2) fwd(Args args) {
    extern __shared__ __attribute__((aligned(16))) unsigned char lds[];
    Frame F;
    F.lds = (LAS unsigned char*)lds;
    F.MISC = (volatile LAS unsigned*)(F.lds + MISC_OFF);
    const int tid0 = threadIdx.x; F.wave = __builtin_amdgcn_readfirstlane(tid0 >> 6);
    F.G = gridDim.x; { const int bx = blockIdx.x; F.vcu = (F.G % 8 == 0) ? (bx % 8) * (F.G / 8) + bx / 8 : bx; }
    F.in = args.in; F.out = args.out; F.ws = args.ws;
    F.ctl = (gu32*)(args.ws + WS_CTL);
    for (int u = tid0; u < (TAB_OFF - LDSCTL_OFF) / 4; u += NWAVES * 64) ((LAS unsigned*)(F.lds + LDSCTL_OFF))[u] = 0u;
    { const int h = tid0 >> 7, rel = tid0 & 127; const float* rb = args.in[I_RELB];
      ((LAS float*)(F.lds + TAB_OFF))[tid0] = (rb[t5_bucket(rel) * 4 + h] - rb[31 * 4 + h]) * LOG2E; }
    __syncthreads();
#if MK_PER_PHASE
#define GRID_BAR() do { } while (0)
#else
    XcdBarrier bar = xcd_barrier_post((unsigned*)(F.ctl + CW_BAR) + args.li * XCD_BAR_WORDS, F.MISC + 8);
#define GRID_BAR() xcd_barrier(bar)
#endif
    const int lo = args.ph_lo, hi = args.ph_hi, bx = blockIdx.x;
#define IN(k) (lo <= (k) && (k) < hi)
#define BOTH(k) (IN(k) && IN((k) + 1))
    bf16* const Zb = WSP(bf16, WS_Z);

    if (IN(0)) { p0_prologue(F); if (BOTH(0)) GRID_BAR(); }

    if (IN(1)) {
        { pg8::Gemm g{WSP(bf16, WS_XN), WSP(bf16, WS_WIN), MP, DIN, DM, DM, DM}; pg8::StaticOrder S; S.init(MP, DIN, F.G, bx);
          EpiZ E{Zb, F.out, WSP(bf16, WS_KRT), WSP(bf16, WS_VRT)};
          pg8::gemm_phase<EpiZ, pg8::StaticOrder, PG8_ALIGN, PG8_SP2>(F.lds + RING_OFF, g, S, E); }
        for (int u = bx; u < 4 * (DIN / 32); u += F.G) sgemm_unit<DM>(F, WSP(bf16, WS_XN) + (size_t)MP * DM, DM, WSP(bf16, WS_WIN), u & 3, u >> 2, SEpiZ{Zb, F.out});
        if (BOTH(1)) GRID_BAR();
    }

    if (IN(2)) {
        const attn_body::StaticOrder S((int)F.G, bx); const int slot = F.vcu % 5;
        { attn_body::AttnUnit au;
          for (int i = 0; i < slot && S.next(i, au); ++i) attn_body::attn_one<8>((char*)lds + RING_OFF, (const attn_body::bf16*)Zb, (attn_body::bf16*)WSP(bf16, WS_OA), (attn_body::lds_cfp)(F.lds + TAB_OFF), au); }
        __syncthreads();
        for (int u = bx; u < 512; u += F.G) ret_stepA(F, u >> 6, u & 63);
        for (int u = bx; u < 256; u += F.G) dec_attn_unit(F, u >> 1, u & 1);
        for (int u = bx; u < 512; u += F.G) dec_ret_unit(F, u >> 2, u & 3);
        { attn_body::AttnUnit au;
          for (int i = slot; S.next(i, au); ++i) attn_body::attn_one<8>((char*)lds + RING_OFF, (const attn_body::bf16*)Zb, (attn_body::bf16*)WSP(bf16, WS_OA), (attn_body::lds_cfp)(F.lds + TAB_OFF), au); }
        if (BOTH(2)) GRID_BAR();
    }

    if (IN(3)) {
        if (bx < 128) ret_scan(F, bx);
        { pg8::Gemm g{WSP(bf16, WS_MEMN), WSP(bf16, WS_WMKV), 2 * NMEM, 2 * DM, DM, DM, DM}; pg8::StaticOrder S; S.init(2 * NMEM, 2 * DM, F.G, (bx + F.G - 128) % F.G);
          EpiMemKV E{F.out, WSP(bf16, WS_MKB), WSP(bf16, WS_MVT)};
          pg8::gemm_phase<EpiMemKV, pg8::StaticOrder, PG8_ALIGN, PG8_SP2>(F.lds + RING_OFF, g, S, E); }
        merge_a_rows(F);
        if (BOTH(3)) GRID_BAR();
    }

    if (IN(4)) { for (int u = bx; u < 512; u += F.G) ret_stepC(F, u >> 6, u & 63); if (BOTH(4)) GRID_BAR(); }

    if (IN(5)) {
        pg8::Gemm g{WSP(bf16, WS_MIX), WSP(bf16, WS_WOUT), MP, DM, DM, DM, DM}; pg8::StaticOrder S; S.init(MP, DM, F.G, bx);
        EpiRes<false> E{args.in[I_XP], nullptr, WSP(bf16, WS_X1B), WSP(float, WS_SSQ1)};
        pg8::gemm_phase<EpiRes<false>, pg8::StaticOrder, PG8_ALIGN, PG8_SP2>(F.lds + RING_OFF, g, S, E);
        for (int u = bx; u < 4 * (DM / 32); u += F.G) sgemm_unit<DM>(F, WSP(bf16, WS_MIX) + (size_t)MP * DM, DM, WSP(bf16, WS_WOUT), u & 3, u >> 2,
            SEpiRes<false>{args.in[I_XS], nullptr, WSP(bf16, WS_X1B) + (size_t)MP * DM, WSP(float, WS_SSQS1)});
        if (BOTH(5)) GRID_BAR();
    }

    if (IN(6)) {
        pg8::Gemm g{WSP(bf16, WS_X1B), WSP(bf16, WS_WMQ), MP, DM, DM, DM, DM}; pg8::StaticOrder S; S.init(MP, DM, F.G, bx);
        EpiScale<0> E{WSP(bf16, WS_QM), DM, WSP(float, WS_SSQ1), C2M};
        pg8::gemm_phase<EpiScale<0>, pg8::StaticOrder, PG8_ALIGN, PG8_SP2>(F.lds + RING_OFF, g, S, E);
        for (int u = bx; u < 4 * (DM / 32); u += F.G) sgemm_unit<DM>(F, WSP(bf16, WS_X1B) + (size_t)MP * DM, DM, WSP(bf16, WS_WMQ), u & 3, u >> 2,
            SEpiScale<0>{WSP(bf16, WS_QM) + (size_t)MP * DM, DM, WSP(float, WS_SSQS1), C2M});
        if (BOTH(6)) GRID_BAR();
    }

    if (IN(7)) {
        if (bx < 256) {
            const int panel = bx >> 2, h = bx & 3, b = panel >> 5;
            { pg8::Gemm g{WSP(bf16, WS_QM) + h * 256, WSP(bf16, WS_MKB) + (size_t)b * NMEM * DM + h * 256, MP, 256, 256, DM, DM}; pg8::OneUnit S{{panel, 0}, true};
              EpiSoftmax E{WSP(bf16, WS_PM) + h * 256, DM};
              pg8::gemm_phase<EpiSoftmax, pg8::OneUnit, false, PG8_SP2>(F.lds + RING_OFF, g, S, E); }
            VM_WAIT(); __syncthreads();
            { pg8::Gemm g{WSP(bf16, WS_PM) + h * 256, WSP(bf16, WS_MVT) + (size_t)h * 256 * 512 + b * NMEM, MP, 256, 256, DM, 512}; pg8::OneUnit S{{panel, 0}, true};
              EpiPlain E{WSP(bf16, WS_OM) + h * 256, DM};
              pg8::gemm_phase<EpiPlain, pg8::OneUnit, false, PG8_SP2>(F.lds + RING_OFF, g, S, E); }
            __syncthreads();
            dec_mem_unit(F, bx >> 1, bx & 1);
        }
        if (BOTH(7)) GRID_BAR();
    }

    if (IN(8)) {
        pg8::Gemm g{WSP(bf16, WS_OM), WSP(bf16, WS_WMO), MP, DM, DM, DM, DM}; pg8::StaticOrder S; S.init(MP, DM, F.G, bx);
        EpiRes<true> E{WSP(bf16, WS_X1B), nullptr, WSP(bf16, WS_X2B), WSP(float, WS_SSQ2)};
        pg8::gemm_phase<EpiRes<true>, pg8::StaticOrder, PG8_ALIGN, PG8_SP2>(F.lds + RING_OFF, g, S, E);
        for (int u = bx; u < 4 * (DM / 32); u += F.G) sgemm_unit<DM>(F, WSP(bf16, WS_OM) + (size_t)MP * DM, DM, WSP(bf16, WS_WMO), u & 3, u >> 2,
            SEpiRes<true>{WSP(bf16, WS_X1B) + (size_t)MP * DM, nullptr, WSP(bf16, WS_X2B) + (size_t)MP * DM, WSP(float, WS_SSQS2)});
        if (BOTH(8)) GRID_BAR();
    }

    if (IN(9)) {
        pg8::Gemm g{WSP(bf16, WS_X2B), WSP(bf16, WS_WUP), MP, FF, DM, DM, DM}; pg8::StaticOrder S; S.init(MP, FF, F.G, bx);
        EpiScale<1> E{WSP(bf16, WS_H), FF, WSP(float, WS_SSQ2), 1.0f};
        pg8::gemm_phase<EpiScale<1>, pg8::StaticOrder, PG8_ALIGN, PG8_SP2>(F.lds + RING_OFF, g, S, E);
        for (int u = bx; u < 4 * (FF / 32); u += F.G) sgemm_unit<DM>(F, WSP(bf16, WS_X2B) + (size_t)MP * DM, DM, WSP(bf16, WS_WUP), u & 3, u >> 2,
            SEpiScale<1>{WSP(bf16, WS_H) + (size_t)MP * FF, FF, WSP(float, WS_SSQS2), 1.0f});
        if (BOTH(9)) GRID_BAR();
    }

    if (IN(10)) {
        pg8::Gemm g{WSP(bf16, WS_H), WSP(bf16, WS_WDN), MP, DM, FF, FF, FF}; pg8::StaticOrder S; S.init(MP, DM, F.G, bx);
        EpiRes<true> E{WSP(bf16, WS_X2B), WSP(float, WS_X3), nullptr, WSP(float, WS_SSQ3)};
        pg8::gemm_phase<EpiRes<true>, pg8::StaticOrder, PG8_ALIGN, PG8_SP2>(F.lds + RING_OFF, g, S, E);
        for (int u = bx; u < 4 * (DM / 32); u += F.G) sgemm_unit<FF>(F, WSP(bf16, WS_H) + (size_t)MP * FF, FF, WSP(bf16, WS_WDN), u & 3, u >> 2,
            SEpiRes<true>{WSP(bf16, WS_X2B) + (size_t)MP * DM, WSP(float, WS_X3) + (size_t)MP * DM, nullptr, WSP(float, WS_SSQS3)});
        if (BOTH(10)) GRID_BAR();
    }

    if (IN(11)) final_norm_rows(F);
#undef IN
#undef BOTH
}

extern "C" void kernel_launch(void* const* d_in, const int* in_sizes, int n_in, void* d_out, int out_size, void* d_ws, size_t ws_size, hipStream_t stream) {
    static int grid = 0;
    if (grid == 0) {
        if (n_in != N_IN || in_sizes[0] != MP * DM || (size_t)out_size != OUT_TOTAL || ws_size < WS_END) { fprintf(stderr, "kernel_launch: unexpected shapes (n_in %d, in0 %d, out %d, ws %zu); nothing launched\n", n_in, n_in > 0 ? in_sizes[0] : -1, out_size, ws_size); grid = -1; return; }
        int dev = 0, cus = 0, per_cu = 0;
        if (hipGetDevice(&dev) != hipSuccess || hipDeviceGetAttribute(&cus, hipDeviceAttributeMultiprocessorCount, dev) != hipSuccess) { fprintf(stderr, "kernel_launch: device query failed\n"); grid = -1; return; }
        if (hipFuncSetAttribute((const void*)fwd, hipFuncAttributeMaxDynamicSharedMemorySize, LDS_BYTES) != hipSuccess) { fprintf(stderr, "kernel_launch: hipFuncSetAttribute failed\n"); grid = -1; return; }
        if (hipOccupancyMaxActiveBlocksPerMultiprocessor(&per_cu, (const void*)fwd, NWAVES * 64, LDS_BYTES) != hipSuccess || per_cu < 1)
            fprintf(stderr, "kernel_launch: note: occupancy query reports %d workgroups per CU\n", per_cu);
        (void)hipGetLastError();
        grid = cus;
        if (grid != 256) fprintf(stderr, "kernel_launch: this kernel's static work split expects 256 CUs, found %d\n", grid);
    }
    if (grid < 0) return;
    if (hipMemsetAsync((char*)d_ws + WS_CTL, 0, CTL_ZERO_BYTES, stream) != hipSuccess) { fprintf(stderr, "kernel_launch: memset failed\n"); return; }
    Args a{};
    for (int i = 0; i < N_IN; ++i) a.in[i] = (const float*)d_in[i];
    a.out = (float*)d_out; a.ws = (unsigned char*)d_ws;
#if MK_PER_PHASE
    for (int p = 0; p < NPH; ++p) { a.ph_lo = p; a.ph_hi = p + 1; hipLaunchKernelGGL(fwd, dim3(grid), dim3(NWAVES * 64), LDS_BYTES, stream, a); }
#elif defined(PROBE_DUP)
    a.ph_lo = 0; a.ph_hi = PROBE_DUP + 1; a.li = 0; hipLaunchKernelGGL(fwd, dim3(grid), dim3(NWAVES * 64), LDS_BYTES, stream, a);
    a.ph_lo = PROBE_DUP; a.ph_hi = NPH; a.li = 1; hipLaunchKernelGGL(fwd, dim3(grid), dim3(NWAVES * 64), LDS_BYTES, stream, a);
#else
    a.ph_lo = 0; a.ph_hi = NPH; hipLaunchKernelGGL(fwd, dim3(grid), dim3(NWAVES * 64), LDS_BYTES, stream, a);
#endif
    const hipError_t le = hipPeekAtLastError();
    if (le != hipSuccess) fprintf(stderr, "kernel_launch: launch failed: %s\n", hipGetErrorName(le));
}
```

```cpp
#include <hip/hip_runtime.h>
#include <hip/hip_bf16.h>
#include <cstdio>
#include <cstdint>
#include <cmath>
#ifndef MK_PER_PHASE
#define MK_PER_PHASE 0
#endif
namespace pg8 {
#define PG8_LAS __attribute__((address_space(3)))
typedef unsigned short bf16_t;
typedef short bf16x8 __attribute__((ext_vector_type(8)));
typedef float f32x4 __attribute__((ext_vector_type(4)));
typedef unsigned u32x4 __attribute__((ext_vector_type(4)));
constexpr int BM = 256, BK = 64, HALF = 128, HTB = HALF * BK * 2  , STAGE_BYTES = 8 * HTB, NXCD = 8, WGM = 8;

__host__ __device__ __forceinline__ int lds_byte(int r, int c) { const int st = (r >> 4) * 2 + (c >> 5), rr = r & 15, cc = c & 31, ob = rr * 64 + cc * 2; return st * 1024 + (ob ^ (((ob >> 9) & 1) << 5)); }
__host__ __device__ __forceinline__ void stage_rc(int b, int& R, int& C) { const int st = b / 1024, sb = b % 1024, swz = sb ^ (((sb >> 9) & 1) << 5); R = (st >> 1) * 16 + swz / 64; C = (st & 1) * 32 + (swz % 64) / 2; }
__host__ __device__ __forceinline__ int perm32(int rho) { const int n = rho >> 4, i = rho & 15; return 8 * (i >> 2) + 4 * n + (i & 3); }

struct Unit { int pm, pn; };
struct Gemm { const bf16_t* A; const bf16_t* Bt; int M, N, K, lda, ldb; };

struct StaticOrder {
    int nM, nN, nwg, G, c;
    __host__ __device__ void init(int M, int N, int G_, int c_) { nM = M / BM; nN = N / BM; nwg = nM * nN; G = G_; c = c_; }
    __host__ __device__ bool next(int i, Unit& u) const {
        const long L = (long)i * G + c; if (L >= nwg) return false;
        int wgid = (int)L; { const int q = nwg / NXCD, r = nwg % NXCD, xcd = wgid % NXCD, off = wgid / NXCD; wgid = (xcd < r ? xcd * (q + 1) : r * (q + 1) + (xcd - r) * q) + off; }
        const int nig = WGM * nN, gid = wgid / nig, fm = gid * WGM, gsz = (nM - fm) < WGM ? (nM - fm) : WGM;
        u.pm = fm + ((wgid % nig) % gsz); u.pn = (wgid % nig) / gsz; return true;
    }
    __device__ __forceinline__ void a_ready(const Unit&) const {}
    __device__ __forceinline__ void done(const Unit&) const {}
};
struct OneUnit {
    Unit u0; bool has;
    __device__ __forceinline__ bool next(int i, Unit& u) const { if (i != 0 || !has) return false; u = u0; return true; }
    __device__ __forceinline__ void a_ready(const Unit&) const {}
    __device__ __forceinline__ void done(const Unit&) const {}
};
__device__ __forceinline__ unsigned cvt_pk_bf16(float lo, float hi) { unsigned r; asm volatile("v_cvt_pk_bf16_f32 %0, %1, %2" : "=v"(r) : "v"(lo), "v"(hi)); return r; }
template <class Epi, class Sched, bool ALIGN_EPI = false, bool SP2 = false>
__device__ __forceinline__ void gemm_phase(PG8_LAS unsigned char* lds, const Gemm g, const Sched& S, const Epi& E) {
    int tid_ = threadIdx.x; asm volatile("" : "+v"(tid_));
    const int tid = tid_, wid = __builtin_amdgcn_readfirstlane(tid >> 6), lane = tid & 63, wr = wid >> 2, wc = wid & 3, fr = lane & 15, fq = lane >> 4;
    const int K = g.K, nt = K / BK;
    unsigned voffA[2], voffB[2];
#pragma unroll
    for (int i = 0; i < 2; ++i) { int R, C; stage_rc(tid * 16 + i * 8192, R, C); const int Rb = Epi::PERM ? ((R & ~31) + perm32(R & 31)) : R;
        voffA[i] = (unsigned)(R * g.lda + C) * 2u; voffB[i] = (unsigned)(Rb * g.ldb + C) * 2u; }
    const size_t kstep = (size_t)(BK * 2);
    const size_t hstepA = (size_t)HALF * g.lda * 2, hstepB = (size_t)HALF * g.ldb * 2;
    const size_t tstepA = 2 * hstepA, tstepB = 2 * hstepB;
    const unsigned ldsw = (unsigned)wid * 1024u;
    const int aoff = lds_byte(wr * 64 + fr, fq * 8), boff = lds_byte(wc * 32 + fr, fq * 8);
#define PG8_SA(b, h) (((b) * 2 + (h)) * HTB)
#define PG8_SB(b, h) ((4 + (b) * 2 + (h)) * HTB)
#define PG8_STAGE(bufoff, gbase, voff) do { _Pragma("unroll") for (int _i = 0; _i < 2; ++_i) \
        __builtin_amdgcn_global_load_lds((const unsigned*)((const char*)(gbase) + (voff)[_i]), (PG8_LAS unsigned*)(lds + (bufoff) + ldsw + _i * 8192), 16, 0, 0); } while (0)
#define PG8_LDA(dst, b, h) do { _Pragma("unroll") for (int m = 0; m < 4; ++m) _Pragma("unroll") for (int k = 0; k < 2; ++k) dst[m][k] = *(const PG8_LAS bf16x8*)(lds + PG8_SA(b, h) + aoff + m * 2048 + k * 1024); } while (0)
#define PG8_LDB(dst, b, h) do { _Pragma("unroll") for (int n = 0; n < 2; ++n) _Pragma("unroll") for (int k = 0; k < 2; ++k) dst[n][k] = *(const PG8_LAS bf16x8*)(lds + PG8_SB(b, h) + boff + n * 2048 + k * 1024); } while (0)
#define PG8_MMA(ai, bj, At, Bt) do { __builtin_amdgcn_s_setprio(1); _Pragma("unroll") for (int m = 0; m < 4; ++m) _Pragma("unroll") for (int n = 0; n < 2; ++n) _Pragma("unroll") for (int k = 0; k < 2; ++k) \
        acc[ai][bj][m][n] = __builtin_amdgcn_mfma_f32_16x16x32_bf16(Bt[n][k], At[m][k], acc[ai][bj][m][n], 0, 0, 0); __builtin_amdgcn_s_setprio(0); } while (0)
#define PG8_WAIT_V(n) asm volatile("s_waitcnt vmcnt(" #n ")" ::: "memory")
#define PG8_WAIT_L(n) asm volatile("s_waitcnt lgkmcnt(" #n ")" ::: "memory")
#define PG8_BAR __builtin_amdgcn_s_barrier()
#define PG8_SCHED __builtin_amdgcn_sched_barrier(0)
    Unit cur, nxt; int ui = 0;
    if (!S.next(0, cur)) return;
    f32x4 acc[2][2][4][2];
#pragma unroll
    for (int a = 0; a < 2; ++a)
#pragma unroll
        for (int b = 0; b < 2; ++b)
#pragma unroll
            for (int m = 0; m < 4; ++m)
#pragma unroll
                for (int n = 0; n < 2; ++n) acc[a][b][m][n] = (f32x4){0.f, 0.f, 0.f, 0.f};
    bf16x8 At[4][2], B0[2][2], B1[2][2];
    const char* cA = (const char*)g.A + (size_t)cur.pm * tstepA; const char* cB = (const char*)g.Bt + (size_t)cur.pn * tstepB;
    S.a_ready(cur);
    if constexpr (SP2) {
        PG8_STAGE(PG8_SB(0, 0), cB, voffB); PG8_STAGE(PG8_SB(0, 1), cB + hstepB, voffB); PG8_STAGE(PG8_SA(0, 0), cA, voffA); PG8_STAGE(PG8_SA(0, 1), cA + hstepA, voffA);
        if (wr == 1) PG8_BAR;
        PG8_WAIT_V(2); PG8_BAR;
        PG8_STAGE(PG8_SB(1, 0), cB + kstep, voffB); PG8_STAGE(PG8_SA(1, 0), cA + kstep, voffA); PG8_STAGE(PG8_SB(1, 1), cB + hstepB + kstep, voffB);
        PG8_WAIT_V(6); PG8_BAR;
    } else {
        PG8_STAGE(PG8_SB(0, 0), cB, voffB); PG8_STAGE(PG8_SA(0, 0), cA, voffA); PG8_STAGE(PG8_SB(0, 1), cB + hstepB, voffB); PG8_STAGE(PG8_SA(0, 1), cA + hstepA, voffA);
        if (wr == 1) PG8_BAR;
        PG8_WAIT_V(4); PG8_BAR;
        PG8_STAGE(PG8_SB(1, 0), cB + kstep, voffB); PG8_STAGE(PG8_SA(1, 0), cA + kstep, voffA); PG8_STAGE(PG8_SB(1, 1), cB + hstepB + kstep, voffB);
        PG8_WAIT_V(6); PG8_BAR;
    }
    for (;;) {
        const bool has_next = S.next(ui + 1, nxt);
        const char* nA = has_next ? (const char*)g.A + (size_t)nxt.pm * tstepA : cA; const char* nB = has_next ? (const char*)g.Bt + (size_t)nxt.pn * tstepB : cB;
        for (int t = 0; t < nt; t += 2) {
            const bool last = (t == nt - 2);
            const char* a1 = cA + (size_t)(t + 1) * kstep;
            const char* a2 = last ? nA : cA + (size_t)(t + 2) * kstep; const char* b2 = last ? nB : cB + (size_t)(t + 2) * kstep;
            const char* a3 = a2 + kstep; const char* b3 = b2 + kstep;
            if (last && has_next) S.a_ready(nxt);
            if constexpr (SP2) {
            PG8_LDB(B0, 0, 0); PG8_LDB(B1, 0, 1); PG8_SCHED; PG8_LDA(At, 0, 0); PG8_STAGE(PG8_SA(1, 1), a1 + hstepA, voffA);
            PG8_WAIT_V(8); PG8_WAIT_L(0); PG8_BAR; PG8_MMA(0, 0, At, B0); PG8_MMA(0, 1, At, B1); PG8_BAR; PG8_SCHED;
            PG8_LDA(At, 0, 1); PG8_STAGE(PG8_SB(0, 0), b2, voffB); PG8_STAGE(PG8_SB(0, 1), b2 + hstepB, voffB); PG8_STAGE(PG8_SA(0, 0), a2, voffA);
            PG8_WAIT_V(8); PG8_WAIT_L(0); PG8_BAR; PG8_MMA(1, 0, At, B0); PG8_MMA(1, 1, At, B1); PG8_BAR; PG8_SCHED;
            PG8_LDB(B0, 1, 0); PG8_LDB(B1, 1, 1); PG8_SCHED; PG8_LDA(At, 1, 0); PG8_STAGE(PG8_SA(0, 1), a2 + hstepA, voffA);
            PG8_WAIT_V(8); PG8_WAIT_L(0); PG8_BAR; PG8_MMA(0, 0, At, B0); PG8_MMA(0, 1, At, B1); PG8_BAR; PG8_SCHED;
            PG8_LDA(At, 1, 1); PG8_STAGE(PG8_SB(1, 0), b3, voffB); PG8_STAGE(PG8_SB(1, 1), b3 + hstepB, voffB); PG8_STAGE(PG8_SA(1, 0), a3, voffA);
            PG8_WAIT_V(8); PG8_WAIT_L(0); PG8_BAR; PG8_MMA(1, 0, At, B0); PG8_MMA(1, 1, At, B1); PG8_BAR; PG8_SCHED;
            } else {
            PG8_LDB(B0, 0, 0); PG8_SCHED; PG8_LDA(At, 0, 0); PG8_STAGE(PG8_SA(1, 1), a1 + hstepA, voffA);
            PG8_WAIT_L(8); PG8_BAR; PG8_WAIT_L(0); PG8_MMA(0, 0, At, B0); PG8_BAR; PG8_SCHED;
            PG8_LDB(B1, 0, 1); PG8_STAGE(PG8_SB(0, 0), b2, voffB);
            PG8_BAR; PG8_WAIT_L(0); PG8_MMA(0, 1, At, B1); PG8_BAR;
            PG8_LDA(At, 0, 1); PG8_STAGE(PG8_SA(0, 0), a2, voffA);
            PG8_BAR; PG8_WAIT_L(0); PG8_MMA(1, 0, At, B0); PG8_BAR; PG8_SCHED;
            PG8_STAGE(PG8_SB(0, 1), b2 + hstepB, voffB);
            PG8_WAIT_V(6); PG8_BAR; PG8_MMA(1, 1, At, B1); PG8_BAR;
            PG8_LDB(B0, 1, 0); PG8_SCHED; PG8_LDA(At, 1, 0); PG8_STAGE(PG8_SA(0, 1), a2 + hstepA, voffA);
            PG8_WAIT_L(8); PG8_BAR; PG8_WAIT_L(0); PG8_MMA(0, 0, At, B0); PG8_BAR; PG8_SCHED;
            PG8_LDB(B1, 1, 1); PG8_STAGE(PG8_SB(1, 0), b3, voffB);
            PG8_BAR; PG8_WAIT_L(0); PG8_MMA(0, 1, At, B1); PG8_BAR;
            PG8_LDA(At, 1, 1); PG8_STAGE(PG8_SA(1, 0), a3, voffA);
            PG8_BAR; PG8_WAIT_L(0); PG8_MMA(1, 0, At, B0); PG8_BAR; PG8_SCHED;
            PG8_STAGE(PG8_SB(1, 1), b3 + hstepB, voffB);
            PG8_WAIT_V(6); PG8_BAR; PG8_MMA(1, 1, At, B1); PG8_BAR;
            }
        }
        if constexpr (ALIGN_EPI) { if (wr == 0) PG8_BAR; }
        if constexpr (!Epi::AFTER_DRAIN) { E(acc, cur, wr, wc, fr, fq); S.done(cur); }
        if (!has_next) break;
#pragma unroll
        for (int a = 0; a < 2; ++a)
#pragma unroll
            for (int b = 0; b < 2; ++b)
#pragma unroll
                for (int m = 0; m < 4; ++m)
#pragma unroll
                    for (int n = 0; n < 2; ++n) acc[a][b][m][n] = (f32x4){0.f, 0.f, 0.f, 0.f};
        cur = nxt; cA = nA; cB = nB; ++ui;
        if constexpr (ALIGN_EPI) { if (wr == 1) PG8_BAR; }
    }
    PG8_WAIT_V(0);
    if constexpr (!ALIGN_EPI) { if (wr == 0) PG8_BAR; }
    PG8_BAR;
    if constexpr (Epi::AFTER_DRAIN) { E.fused(acc, cur, wr, wc, fr, fq, lds, wid, lane); S.done(cur); }
#undef PG8_SA
#undef PG8_SB
#undef PG8_STAGE
#undef PG8_LDA
#undef PG8_LDB
#undef PG8_MMA
#undef PG8_WAIT_V
#undef PG8_WAIT_L
#undef PG8_BAR
#undef PG8_SCHED
}
}
namespace attn_body {
using bf16=__hip_bfloat16;
using bf16x8=__attribute__((ext_vector_type(8)))short;
using s16x4=__attribute__((ext_vector_type(4)))short;
using f32x16=__attribute__((ext_vector_type(16)))float;
using u32x4=__attribute__((ext_vector_type(4)))unsigned;
constexpr int BATCH=2,NHEAD=16,SEQ=8192,D=64,ZP=3072,OP=1024;
constexpr int NW=8,QBLK=32,QB=QBLK*NW,KVBLK=64,NQB=SEQ/QB;
constexpr int ATTN_UNIT_ROWS=QB;
__device__ __forceinline__ int crow(int r,int hi){return (r&3)+8*(r>>2)+4*hi;}
#define SBAR() __builtin_amdgcn_sched_barrier(0)
typedef const __attribute__((address_space(3))) float* lds_cfp;
__device__ __forceinline__ void cmask(f32x16&p0,f32x16&p1,int jb,int qrel,int hi,lds_cfp tab){
  const float NEG=-INFINITY; const int kb=64*jb+4*hi;
  #pragma unroll
  for(int r=0;r<16;++r){ const int rel=qrel-(kb+(r&3)+8*(r>>2)); const int rel1=rel-32;
    int i0=rel<127?rel:127; i0=i0<0?0:i0; int i1=rel1<127?rel1:127; i1=i1<0?0:i1;
    const float b0=tab[i0], b1=tab[i1];
    p0[r]=rel<0?NEG:p0[r]+b0; p1[r]=rel1<0?NEG:p1[r]+b1; }
}

constexpr int NSLOT=3, SLOTB=8192;
constexpr int LDS_K=0, LDS_V=NSLOT*SLOTB, LDS_WS=2*NSLOT*SLOTB, LDS_OST=LDS_WS+NW*64*4, LDS_BYTES=LDS_OST+NW*4096;
constexpr float C2=0.125f*1.4426950408889634f;
__device__ __forceinline__ void glds16(const void*gsrc,unsigned lds_dst){unsigned keep;
  asm volatile("s_mov_b32 %0, m0\n\ts_mov_b32 m0, %2\n\ts_nop 0\n\tglobal_load_lds_dwordx4 %1, off\n\ts_mov_b32 m0, %0":"=&s"(keep):"v"(gsrc),"s"(lds_dst):"memory");}
__device__ __forceinline__ float max3f(float a,float b,float c){float r;asm("v_max3_f32 %0, %1, %2, %3":"=v"(r):"v"(a),"v"(b),"v"(c));return r;}
__device__ __forceinline__ float max2f(float a,float b){float r;asm("v_max_f32_e32 %0, %1, %2":"=v"(r):"v"(a),"v"(b));return r;}
__device__ __forceinline__ float fadd_s(float a,float b){float r;asm("v_add_f32_e32 %0, %1, %2":"=v"(r):"v"(a),"v"(b));return r;}
__device__ __forceinline__ float fsub_s(float a,float b){float r;asm("v_sub_f32_e32 %0, %1, %2":"=v"(r):"v"(a),"v"(b));return r;}
typedef float f32x2_t __attribute__((ext_vector_type(2))); typedef __bf16 bf16x2_t __attribute__((ext_vector_type(2)));
__device__ __forceinline__ unsigned cvtpk_s(float lo,float hi){f32x2_t v={lo,hi};bf16x2_t b=__builtin_convertvector(v,bf16x2_t);return __builtin_bit_cast(unsigned,b);}
#define WAIT_BAR(N) asm volatile("s_waitcnt vmcnt(" #N ") lgkmcnt(0)\n\ts_barrier":::"memory")

__device__ __forceinline__ void qkt(f32x16&p0,f32x16&p1,const char*Kslot,const bf16x8*qr,const f32x16&negm,int r32,int hi){
  const char*kb=Kslot+hi*1024+r32*16;
  #pragma unroll
  for(int d0=0;d0<4;++d0){
    const bf16x8 b0=*reinterpret_cast<const bf16x8*>(kb+d0*2048);
    const bf16x8 b1=*reinterpret_cast<const bf16x8*>(kb+d0*2048+512);
    if(d0==0){p0=__builtin_amdgcn_mfma_f32_32x32x16_bf16(b0,qr[0],negm,0,0,0);p1=__builtin_amdgcn_mfma_f32_32x32x16_bf16(b1,qr[0],negm,0,0,0);}
    else{p0=__builtin_amdgcn_mfma_f32_32x32x16_bf16(b0,qr[d0],p0,0,0,0);p1=__builtin_amdgcn_mfma_f32_32x32x16_bf16(b1,qr[d0],p1,0,0,0);}}
}
typedef __attribute__((address_space(3))) const char* lds_cptr;
typedef short v4i16_t __attribute__((ext_vector_type(4)));
__device__ __forceinline__ void kload8(bf16x8*kf,lds_cptr kp){
  kf[0]=*(const __attribute__((address_space(3))) bf16x8*)(kp);      kf[1]=*(const __attribute__((address_space(3))) bf16x8*)(kp+512);
  kf[2]=*(const __attribute__((address_space(3))) bf16x8*)(kp+2048); kf[3]=*(const __attribute__((address_space(3))) bf16x8*)(kp+2560);
  kf[4]=*(const __attribute__((address_space(3))) bf16x8*)(kp+4096); kf[5]=*(const __attribute__((address_space(3))) bf16x8*)(kp+4608);
  kf[6]=*(const __attribute__((address_space(3))) bf16x8*)(kp+6144); kf[7]=*(const __attribute__((address_space(3))) bf16x8*)(kp+6656);
}
__device__ __forceinline__ void kload2(bf16x8*kf,lds_cptr kp,int j){ kf[2*j]=*(const __attribute__((address_space(3))) bf16x8*)(kp+j*2048); kf[2*j+1]=*(const __attribute__((address_space(3))) bf16x8*)(kp+j*2048+512); }
__device__ __forceinline__ s16x4 vtr(lds_cptr p){ return __builtin_bit_cast(s16x4,__builtin_amdgcn_ds_read_tr16_b64_v4i16((__attribute__((address_space(3))) v4i16_t*)p)); }
__device__ __forceinline__ float rowmax(const f32x16&p0,const f32x16&p1){
  float a=max3f(p0[0],p0[1],p1[0]),b=max3f(p0[2],p0[3],p1[1]);a=max3f(a,p1[2],p1[3]);
  #pragma unroll
  for(int r=4;r<16;r+=4){a=max3f(a,p0[r],p0[r+1]);b=max3f(b,p0[r+2],p0[r+3]);a=max3f(a,p1[r],p1[r+1]);b=max3f(b,p1[r+2],p1[r+3]);}
  const float m=max2f(a,b);
  auto rr=__builtin_amdgcn_permlane32_swap(__float_as_uint(m),__float_as_uint(m),false,false);
  return max2f(__uint_as_float(rr[0]),__uint_as_float(rr[1]));
}
__device__ __forceinline__ void pv(f32x16*o,int vb,bf16x8 pa0,bf16x8 pa1,bf16x8 pa2,bf16x8 pa3){
  #pragma unroll
  for(int d0=0;d0<2;++d0){s16x4 lo[4],hi[4];
    #pragma unroll
    for(int ks=0;ks<4;++ks){
      asm volatile("ds_read_b64_tr_b16 %0,%1 offset:%c2":"=&v"(lo[ks]):"v"(vb),"i"(d0*4096+ks*1024):"memory");
      asm volatile("ds_read_b64_tr_b16 %0,%1 offset:%c2":"=&v"(hi[ks]):"v"(vb),"i"(d0*4096+ks*1024+512):"memory");}
    asm volatile("s_waitcnt lgkmcnt(0)":::"memory");SBAR();
    #define PK(k) (bf16x8){lo[k][0],lo[k][1],lo[k][2],lo[k][3],hi[k][0],hi[k][1],hi[k][2],hi[k][3]}
    o[d0]=__builtin_amdgcn_mfma_f32_32x32x16_bf16(pa0,PK(0),o[d0],0,0,0);
    o[d0]=__builtin_amdgcn_mfma_f32_32x32x16_bf16(pa1,PK(1),o[d0],0,0,0);
    o[d0]=__builtin_amdgcn_mfma_f32_32x32x16_bf16(pa2,PK(2),o[d0],0,0,0);
    o[d0]=__builtin_amdgcn_mfma_f32_32x32x16_bf16(pa3,PK(3),o[d0],0,0,0);
    #undef PK
  }
}

#ifndef ATTN_STORE16
#define ATTN_STORE16(p,v) (*(u32x4*)(p)=(v))
#endif
template<int THRL> __device__ __forceinline__ void attn_unit(int b,int qcol,int kcol,int vcol,int ocol,int qb,const bf16*__restrict__ Zb,bf16*O,char*shm,lds_cfp tab){
  int tid_=threadIdx.x; asm volatile("":"+v"(tid_));
  const int tid=tid_,lane=tid&63,r32=lane&31,hi=lane>>5; const int wid=__builtin_amdgcn_readfirstlane(tid>>6);
  const long rowbase=(long)b*SEQ; const int q0=qb*QB;
  const bf16*Qw=Zb+(rowbase+q0+wid*QBLK)*ZP+qcol;
  const bf16*Kh=Zb+rowbase*ZP+kcol,*Vh=Zb+rowbase*ZP+vcol;
  const unsigned lds0=(unsigned)(uintptr_t)shm;
  float*wsf=(float*)(shm+LDS_WS)+wid*64;
  const bf16*ksrc=Kh+(long)lane*ZP+wid*8;
  const bf16*vsrc=Vh+(long)(16*(wid&3)+(lane>>2))*ZP+(wid>>2)*32+(lane&3)*8;
  const unsigned kdst=lds0+LDS_K+wid*1024, vdst=lds0+LDS_V+wid*1024;
  #define DMA_K(t,slot) glds16(ksrc+(long)(t)*KVBLK*ZP,(unsigned)__builtin_amdgcn_readfirstlane(kdst+(slot)))
  #define DMA_V(t,slot) glds16(vsrc+(long)(t)*KVBLK*ZP,(unsigned)__builtin_amdgcn_readfirstlane(vdst+(slot)))
  const int vb0=(int)(lds0+LDS_V)+((lane>>4)&1)*32+(lane&3)*8+(4*hi+((lane&15)>>2))*64;
  const char*Kbase=shm+LDS_K; bf16x8 kf[8];
  const lds_cptr shm3=(lds_cptr)shm; const lds_cptr kp0=shm3+LDS_K+hi*1024+r32*16; const lds_cptr vp0=shm3+LDS_V+((lane>>4)&1)*32+(lane&3)*8+(4*hi+((lane&15)>>2))*64;
  const int NT=(q0+QB)/KVBLK;
  DMA_K(0,0);DMA_V(0,0);DMA_K(1,SLOTB);
  bf16x8 qr[4];
  #pragma unroll
  for(int d0=0;d0<4;++d0)qr[d0]=*reinterpret_cast<const bf16x8*>(&Qw[(long)r32*ZP+d0*16+hi*8]);
  float mhat=0.f,l_reg=0.f;f32x16 o[2];o[0]=f32x16{};o[1]=f32x16{};f32x16 negm=f32x16{};asm volatile("":"+v"(negm));
  const int qrel=wid*QBLK+r32;
  #define CMASK(P0,P1,t) do{int jb_=(t)-(NT-4); if(jb_>=-2)cmask(P0,P1,jb_,qrel,hi,tab);}while(0)
  bool resc=false;
  #define START(P0,P1) do{ const float rm=rowmax(P0,P1); resc=false; \
    { const float dl=rm; mhat=fadd_s(mhat,dl); \
      _Pragma("unroll") for(int r=0;r<16;++r){P0[r]=fsub_s(P0[r],dl);P1[r]=fsub_s(P1[r],dl);} \
      _Pragma("unroll") for(int r=0;r<16;++r)negm[r]=-mhat; asm volatile("":"+v"(negm)); } \
    _Pragma("unroll") for(int r=0;r<16;++r)P0[r]=__builtin_amdgcn_exp2f(P0[r]); }while(0)
  #define RESC() do{ if(resc){ asm volatile("s_waitcnt lgkmcnt(0)":::"memory"); \
      _Pragma("unroll") for(int d_=0;d_<2;++d_) _Pragma("unroll") for(int r=0;r<16;++r)o[d_][r]*=wsf[crow(r,hi)]; } }while(0)
  f32x16 pA0,pA1,pB0,pB1;
  int sl_prev=0,sl_cur=0,sl_next=SLOTB;
  #define ROT() do{sl_prev=sl_cur;sl_cur=sl_next;sl_next=(sl_next==(NSLOT-1)*SLOTB)?0:sl_next+SLOTB;}while(0)
  DMA_K(2,2*SLOTB);
  WAIT_BAR(3);
  qkt(pA0,pA1,Kbase,qr,negm,r32,hi);asm volatile("s_nop 15\n\ts_nop 7":"+v"(pA0),"+v"(pA1));CMASK(pA0,pA1,0);
  START(pA0,pA1);
  _Pragma("unroll") for(int r=0;r<16;++r)pA1[r]=__builtin_amdgcn_exp2f(pA1[r]);
  WAIT_BAR(0);
  DMA_K(3,0);DMA_V(1,SLOTB);
  ROT();
  kload8(kf,kp0+sl_cur);
  WAIT_BAR(2);
  s16x4 vlo[8],vhi[8]; u32x4 pw0,pw1,pw2,pw3;
  #define PKW(P,B) cvtpk_s(P[B],P[B+1])
  #define PAF(k) __builtin_bit_cast(bf16x8,pw##k)
  #define VFR(i) (bf16x8){vlo[i][0],vlo[i][1],vlo[i][2],vlo[i][3],vhi[i][0],vhi[i][1],vhi[i][2],vhi[i][3]}
  #define PIN(x) asm volatile("":"+v"(x))
  #define MX3(a,b,c) __builtin_fmaxf(__builtin_fmaxf((a),(b)),(c))
  #define GAPA(MF,A0,A1,A2,A3,W0,W1,PW) do{ MF; sacc+=A0; sacc+=A1; sacc+=A2; sacc+=A3; PIN(sacc); W0; W1; PIN(PW); SBAR(); }while(0)
  #define EX(v) __builtin_amdgcn_exp2f(v)
  #define GAPB(MF,X,B) do{ MF; X[B]=EX(X[B]); X[B+1]=EX(X[B+1]); X[B+2]=EX(X[B+2]); X[B+3]=EX(X[B+3]); PIN(X); SBAR(); }while(0)
  #define VRD(i) do{ vlo[i]=vtr(vp_+(((i)>>2)*4096+((i)&3)*1024)); vhi[i]=vtr(vp_+(((i)>>2)*4096+((i)&3)*1024+512)); }while(0)
  #define KRD(G,j) do{ if(G){ kload2(kf,kp0+sl_next,j); SBAR(); } }while(0)
  #define STEP(C0,C1,P0,P1,t,GK,GV,GL) do{ SBAR(); \
    const lds_cptr vp_=vp0+sl_prev; \
    VRD(0); SBAR(); float sacc=(P0[0]+P0[1]); \
    GAPA(C0=__builtin_amdgcn_mfma_f32_32x32x16_bf16(kf[0],qr[0],negm,0,0,0), P0[2],P0[3],P0[4],P0[5],     pw0[0]=PKW(P0,0), pw0[1]=PKW(P0,2), pw0); \
    VRD(4); SBAR(); GAPA(C1=__builtin_amdgcn_mfma_f32_32x32x16_bf16(kf[1],qr[0],negm,0,0,0), P0[6],P0[7],P0[8],P0[9],     pw0[2]=PKW(P0,4), pw0[3]=PKW(P0,6), pw0); \
    VRD(1); SBAR(); GAPA(C0=__builtin_amdgcn_mfma_f32_32x32x16_bf16(kf[2],qr[1],C0,0,0,0),   P0[10],P0[11],P0[12],P0[13], pw1[0]=PKW(P0,8), pw1[1]=PKW(P0,10), pw1); \
    VRD(5); SBAR(); GAPA(C1=__builtin_amdgcn_mfma_f32_32x32x16_bf16(kf[3],qr[1],C1,0,0,0),   P0[14],P0[15],P1[0],P1[1],   pw1[2]=PKW(P0,12),pw1[3]=PKW(P0,14), pw1); \
    VRD(2); SBAR(); GAPA(C0=__builtin_amdgcn_mfma_f32_32x32x16_bf16(kf[4],qr[2],C0,0,0,0),   P1[2],P1[3],P1[4],P1[5],     pw2[0]=PKW(P1,0), pw2[1]=PKW(P1,2), pw2); \
    VRD(6); SBAR(); GAPA(C1=__builtin_amdgcn_mfma_f32_32x32x16_bf16(kf[5],qr[2],C1,0,0,0),   P1[6],P1[7],P1[8],P1[9],     pw2[2]=PKW(P1,4), pw2[3]=PKW(P1,6), pw2); \
    VRD(3); SBAR(); GAPA(C0=__builtin_amdgcn_mfma_f32_32x32x16_bf16(kf[6],qr[3],C0,0,0,0),   P1[10],P1[11],P1[12],P1[13], pw3[0]=PKW(P1,8), pw3[1]=PKW(P1,10), pw3); \
    VRD(7); SBAR(); GAPA(C1=__builtin_amdgcn_mfma_f32_32x32x16_bf16(kf[7],qr[3],C1,0,0,0),   P1[14],P1[15],0.f,0.f,       pw3[2]=PKW(P1,12),pw3[3]=PKW(P1,14), pw3); \
    l_reg+=sacc; \
    if(GK){DMA_K((t)+3,sl_cur);} if(GV){DMA_V((t)+1,sl_next);} \
    CMASK(C0,C1,t); \
    { float a=MX3(C0[0],C0[1],C1[0]),b=MX3(C0[2],C0[3],C1[1]); a=MX3(a,C1[2],C1[3]); \
      _Pragma("unroll") for(int r=4;r<16;r+=4){a=MX3(a,C0[r],C0[r+1]);b=MX3(b,C0[r+2],C0[r+3]);a=MX3(a,C1[r],C1[r+1]);b=MX3(b,C1[r+2],C1[r+3]);} \
      float rm=__builtin_fmaxf(a,b); { auto rr=__builtin_amdgcn_permlane32_swap(__float_as_uint(rm),__float_as_uint(rm),false,false); rm=__builtin_fmaxf(__uint_as_float(rr[0]),__uint_as_float(rr[1])); } \
      resc=false; \
      if(__builtin_expect(__any(rm>(float)THRL),0)){ const float dl=__builtin_fmaxf(rm,0.f); mhat+=dl; \
        _Pragma("unroll") for(int r=0;r<16;++r){C0[r]-=dl;C1[r]-=dl;} \
        _Pragma("unroll") for(int r=0;r<16;++r)negm[r]=-mhat; asm volatile("":"+v"(negm)); \
        const float f=__builtin_amdgcn_exp2f(-dl); l_reg*=f; if(hi==0)wsf[r32]=f; resc=true; } } \
    SBAR(); \
    GAPB(o[0]=__builtin_amdgcn_mfma_f32_32x32x16_bf16(PAF(0),VFR(0),o[0],0,0,0), C0,0); \
    GAPB(o[1]=__builtin_amdgcn_mfma_f32_32x32x16_bf16(PAF(0),VFR(4),o[1],0,0,0), C0,4); \
    KRD(GL,0); GAPB(o[0]=__builtin_amdgcn_mfma_f32_32x32x16_bf16(PAF(1),VFR(1),o[0],0,0,0), C0,8); \
    KRD(GL,1); GAPB(o[1]=__builtin_amdgcn_mfma_f32_32x32x16_bf16(PAF(1),VFR(5),o[1],0,0,0), C0,12); \
    KRD(GL,2); GAPB(o[0]=__builtin_amdgcn_mfma_f32_32x32x16_bf16(PAF(2),VFR(2),o[0],0,0,0), C1,0); \
    KRD(GL,3); GAPB(o[1]=__builtin_amdgcn_mfma_f32_32x32x16_bf16(PAF(2),VFR(6),o[1],0,0,0), C1,4); \
    GAPB(o[0]=__builtin_amdgcn_mfma_f32_32x32x16_bf16(PAF(3),VFR(3),o[0],0,0,0), C1,8); \
    GAPB(o[1]=__builtin_amdgcn_mfma_f32_32x32x16_bf16(PAF(3),VFR(7),o[1],0,0,0), C1,12); \
    }while(0)
  int t=1;
  #undef CMASK
  #define CMASK(P0,P1,t) do{}while(0)
  for(;t+7<NT;t+=2){
    STEP(pB0,pB1,pA0,pA1,t,true,true,true);     WAIT_BAR(2); RESC(); ROT();
    STEP(pA0,pA1,pB0,pB1,t+1,true,true,true);   WAIT_BAR(2); RESC(); ROT();
  }
  #undef CMASK
  #define CMASK(P0,P1,t) do{int jb_=(t)-(NT-4); if(jb_>=-2)cmask(P0,P1,jb_,qrel,hi,tab);}while(0)
  #define ENDW(tt) do{ if((tt)+3<NT){WAIT_BAR(2);} else if((tt)+2<NT){WAIT_BAR(1);} else {WAIT_BAR(0);} }while(0)
  for(;t+1<NT;t+=2){
    STEP(pB0,pB1,pA0,pA1,t,(t+3<NT),(t+1<NT),(t+1<NT));       ENDW(t);   RESC(); ROT();
    STEP(pA0,pA1,pB0,pB1,t+1,(t+4<NT),(t+2<NT),(t+2<NT));     ENDW(t+1); RESC(); ROT();
  }
  STEP(pB0,pB1,pA0,pA1,NT-1,false,false,false); RESC();
  { float sacc=pB0[0]+pB0[1]; _Pragma("unroll") for(int r=2;r<16;++r)sacc+=pB0[r]; _Pragma("unroll") for(int r=0;r<16;++r)sacc+=pB1[r]; l_reg+=sacc;
    pw0=(u32x4){PKW(pB0,0),PKW(pB0,2),PKW(pB0,4),PKW(pB0,6)};pw1=(u32x4){PKW(pB0,8),PKW(pB0,10),PKW(pB0,12),PKW(pB0,14)};pw2=(u32x4){PKW(pB1,0),PKW(pB1,2),PKW(pB1,4),PKW(pB1,6)};pw3=(u32x4){PKW(pB1,8),PKW(pB1,10),PKW(pB1,12),PKW(pB1,14)};
    SBAR(); pv(o,vb0+sl_cur,PAF(0),PAF(1),PAF(2),PAF(3)); }
  #undef PKW
  #undef PAF
  #undef VFR
  #undef PIN
  #undef MX3
  #undef GAPA
  #undef GAPB
  #undef EX
  #undef VRD
  #undef KRD
  #undef STEP
  #undef ENDW
  {auto rr=__builtin_amdgcn_permlane32_swap(__float_as_uint(l_reg),__float_as_uint(l_reg),false,false);l_reg=__uint_as_float(rr[0])+__uint_as_float(rr[1]);}
  if(hi==0)wsf[32+r32]=l_reg;asm volatile("s_waitcnt lgkmcnt(0)":::"memory");
  float rli[16];
  #pragma unroll
  for(int r=0;r<16;++r)rli[r]=__builtin_amdgcn_rcpf(wsf[32+crow(r,hi)]);
  bf16*Ow=O+(rowbase+q0+wid*QBLK)*OP+ocol;
  { bf16*stg=(bf16*)(shm+LDS_OST)+wid*2048;
    #pragma unroll
    for(int r=0;r<16;++r){const int orow=crow(r,hi);
      #pragma unroll
      for(int d0=0;d0<2;++d0)stg[orow*64+d0*32+r32]=__float2bfloat16(o[d0][r]*rli[r]);}
    asm volatile("s_waitcnt lgkmcnt(0)":::"memory");
    #pragma unroll
    for(int i=0;i<4;++i){const int row=i*8+(lane>>3),ch=lane&7; const u32x4 v=*(const u32x4*)(stg+row*64+ch*8); ATTN_STORE16(Ow+(long)row*OP+ch*8,v);} }
  asm volatile("s_waitcnt lgkmcnt(0)\n\ts_barrier":::"memory");
  #undef DMA_K
  #undef DMA_V
  #undef CMASK
  #undef START
  #undef RESC
  #undef ROT
}
constexpr int ATTN_LDS_BYTES=LDS_BYTES;
struct AttnUnit { int bh; int qb; };
struct StaticOrder {
  int vcu;
  __device__ __forceinline__ explicit StaticOrder(int grid,int block):vcu((block%8)*(grid/8)+block/8){}
  __device__ __forceinline__ bool next(int i,AttnUnit&u)const{ if(i>=4)return false; const int s=vcu&7; u.bh=vcu>>3; u.qb=(i==0)?s:(i==1)?15-s:(i==2)?16+s:31-s; return true; }
  __device__ __forceinline__ void a_ready(const AttnUnit&)const{}
  __device__ __forceinline__ void done(const AttnUnit&)const{}
};
template<class Sched,int THRL=8> __device__ __forceinline__ void attn_phase(char*lds,const bf16*Zb,bf16*OA,lds_cfp tab,const Sched&S){
  AttnUnit u;
  for(int i=0;S.next(i,u);++i){ S.a_ready(u); const int b=u.bh>>4,vh=u.bh&15,map=vh>>3,h=(vh>>1)&3,vhalf=vh&1;
    attn_unit<THRL>(b,h*128+map*64,512+h*128+map*64,1024+h*128+vhalf*64,map*512+h*128+vhalf*64,u.qb,Zb,OA,lds,tab+h*128); S.done(u); }
}
template<int THRL=8> __device__ __forceinline__ void attn_one(char*lds,const bf16*Zb,bf16*OA,lds_cfp tab,const AttnUnit&u){
  const int b=u.bh>>4,vh=u.bh&15,map=vh>>3,h=(vh>>1)&3,vhalf=vh&1;
  attn_unit<THRL>(b,h*128+map*64,512+h*128+map*64,1024+h*128+vhalf*64,map*512+h*128+vhalf*64,u.qb,Zb,OA,lds,tab+h*128);
}
#undef SBAR
#undef WAIT_BAR
}

constexpr int NWAVES = 8;
#ifndef MK_PER_PHASE
#define MK_PER_PHASE 0
#endif
constexpr int NPH = 12;

constexpr int MP = 16384, MS = 128, MV = MP + MS, MPAD = 16640;
constexpr int DM = 1024, DIN = 3072, FF = 4096, TSEQ = 8192, NMEM = 256, PASTLEN = 2048;
constexpr float EPS = 1e-6f, LOG2E = 1.4426950408889634f;
constexpr float C2A = 0.125f * LOG2E;
constexpr float C2M = 0.0625f * LOG2E;
constexpr float ONE_M_LAMINIT = 0.8f, LAMINIT = 0.2f;
constexpr int ZQA = 0, ZKA = 512, ZVA = 1024, ZQR = 1536, ZKR = 1792, ZVR = 2048, ZGR = 2560;
constexpr size_t OY_P = 0, OY_S = 16777216, OK_P = 16908288, OV_P = 25296896, OS_P = 33685504, OMK = 33751040, OMV = 34275328, OK_S = 34799616, OV_S = 34865152, OS_S = 34930688, OUT_TOTAL = 39124992;
enum { I_XP = 0, I_XS, I_MEMP, I_CK, I_CV, I_PT, I_SRET, I_CMK, I_CMV, I_RELB, I_NMIX, I_WIN, I_LQ1, I_LK1, I_LQ2, I_LK2, I_SUBLN, I_WOUT, I_NMEMQ, I_NMEMKV, I_WMQ, I_WMK, I_WMV, I_WMO, I_NMLP, I_WUP, I_WDN, I_NFIN, N_IN };

constexpr size_t MiB = 1u << 20;
constexpr size_t WS_CTL = 0, CTL_ZERO_BYTES = 1 * MiB;
constexpr size_t WS_WIN = 2 * MiB, WS_WOUT = 8 * MiB, WS_WMQ = 10 * MiB, WS_WMKV = 12 * MiB, WS_WMO = 16 * MiB, WS_WUP = 18 * MiB, WS_WDN = 26 * MiB;
constexpr size_t WS_MEMN = 34 * MiB, WS_MKB = 35 * MiB, WS_MVT = 36 * MiB, WS_SSQ1 = 37 * MiB, WS_SSQ2 = 39 * MiB, WS_SSQ3 = 41 * MiB;
constexpr size_t WS_XN = 48 * MiB, WS_Z = 82 * MiB, WS_OA = 180 * MiB, WS_MIX = 214 * MiB, WS_KRT = 248 * MiB, WS_VRT = 256 * MiB, WS_U = 272 * MiB, WS_SPT = 288 * MiB;
constexpr size_t WS_X1 = 296 * MiB, WS_X1B = 362 * MiB, WS_QM = 396 * MiB, WS_PM = 430 * MiB, WS_OM = 464 * MiB, WS_X2 = 498 * MiB, WS_X2B = 564 * MiB, WS_H = 598 * MiB, WS_X3 = 730 * MiB, WS_END = 796 * MiB;
static_assert(WS_XN + (size_t)MPAD * DM * 2 <= WS_Z && WS_Z + (size_t)MPAD * DIN * 2 <= WS_OA && WS_OA + (size_t)MPAD * DM * 2 <= WS_MIX && WS_MIX + (size_t)MPAD * DM * 2 <= WS_KRT, "ws map 1");
static_assert(WS_X1 + (size_t)MPAD * DM * 4 <= WS_X1B && WS_H + (size_t)MPAD * FF * 2 <= WS_X3 && WS_X3 + (size_t)MPAD * DM * 4 <= WS_END && WS_SSQ1 + (size_t)MPAD * 16 * 4 <= WS_SSQ2, "ws map 2");
constexpr size_t WS_SSQS1 = WS_SSQ1 + 3 * MiB / 2, WS_SSQS2 = WS_SSQ2 + 3 * MiB / 2, WS_SSQS3 = WS_SSQ3 + 3 * MiB / 2;
constexpr int CW_TMO = 0, CW_CODE = 1, CW_BAR = 4096;

constexpr int RING_OFF = 0, RING_BYTES = 131072;
constexpr int LDSCTL_OFF = RING_BYTES, MISC_OFF = LDSCTL_OFF + 320;
constexpr int TAB_OFF = RING_BYTES + 1024;
constexpr int LDS_BYTES = 147456;
static_assert(MISC_OFF + 128 <= TAB_OFF && TAB_OFF + 2048 <= LDS_BYTES, "LDS map");

#define GAS __attribute__((address_space(1)))
#define LAS __attribute__((address_space(3)))
typedef unsigned short bf16;
typedef unsigned v4u __attribute__((ext_vector_type(4)));
typedef float f32x4 __attribute__((ext_vector_type(4)));
typedef short bf16x8 __attribute__((ext_vector_type(8)));
typedef GAS unsigned gu32;
typedef GAS unsigned long long gu64;
#define RLX_AGENT __ATOMIC_RELAXED, __HIP_MEMORY_SCOPE_AGENT
#define LDS_WAIT() asm volatile("s_waitcnt lgkmcnt(0)" ::: "memory")
#define VM_WAIT() asm volatile("s_waitcnt vmcnt(0)" ::: "memory")
__device__ __forceinline__ unsigned long long rt() { return __builtin_amdgcn_s_memrealtime(); }
__device__ __forceinline__ unsigned f2bf(float f) { unsigned u = __builtin_bit_cast(unsigned, f); return (u + 0x7fffu + ((u >> 16) & 1u)) >> 16; }
__device__ __forceinline__ unsigned pk2(float lo, float hi) { return f2bf(lo) | (f2bf(hi) << 16); }

#define XB_TMO      128
#define XB_XCNT(j)  (256  + 64 * (j))
#define XB_XSUB(j)  (1280 + 64 * (j))
#define XB_XGEN(j)  (2304 + 64 * (j))
#define XB_TOP      3328
#define XB_TOPGEN   3392
#define XCD_BAR_WORDS 3456
#define XB_SPIN_CAP (1u << 18)

__device__ __forceinline__ unsigned xb_ld(unsigned* p)              { return __hip_atomic_load(p, __ATOMIC_RELAXED, __HIP_MEMORY_SCOPE_AGENT); }
__device__ __forceinline__ unsigned xb_add(unsigned* p, unsigned v) { return __hip_atomic_fetch_add(p, v, __ATOMIC_RELAXED, __HIP_MEMORY_SCOPE_AGENT); }
__device__ __forceinline__ unsigned xb_xcc_id() { return (unsigned)__builtin_amdgcn_s_getreg((3 << 11) | 20) & 0xFu; }
#define XB_SPIN(cond, bar) do { unsigned _sp = 0; while (cond) { __builtin_amdgcn_s_sleep(1); \
    if ((++_sp & 255u) == 0u) { if (xb_ld(&(bar)[XB_TMO])) break; if (_sp > XB_SPIN_CAP) { atomicAdd(&(bar)[XB_TMO], 1u); break; } } } } while (0)

struct XcdBarrier {
    unsigned* bar; unsigned x;
    volatile LAS unsigned* st;
};

__device__ __forceinline__ XcdBarrier xcd_barrier_post(unsigned* bar, volatile LAS unsigned* st) {
    XcdBarrier b; b.bar = bar; b.x = xb_xcc_id(); b.st = st;
    if (threadIdx.x == 0) (void)xb_add(&bar[XB_XCNT(b.x)], 1u);
    return b;
}
__device__ __forceinline__ void xcd_barrier_complete(unsigned* bar, unsigned x, unsigned& nloc, unsigned& nx) {
    const unsigned G = gridDim.x * gridDim.y * gridDim.z;
    unsigned sum, cnt, mine, sp = 0u;
    for (;;) {
        sum = 0u; cnt = 0u; mine = 0u;
#pragma unroll
        for (unsigned j = 0; j < 16; ++j) { const unsigned c = xb_ld(&bar[XB_XCNT(j)]); sum += c; cnt += (c > 0u) ? 1u : 0u; mine = (j == x) ? c : mine; }
        if (sum == G) break;
        __builtin_amdgcn_s_sleep(1);
        if ((++sp & 255u) == 0u) { if (xb_ld(&bar[XB_TMO])) break; if (sp > XB_SPIN_CAP) { atomicAdd(&bar[XB_TMO], 1u); break; } }
    }
    nloc = mine > 0u ? mine : 1u; nx = cnt > 0u ? cnt : 1u;
}

__device__ __forceinline__ void xcd_barrier(const XcdBarrier& b) {
    asm volatile("s_waitcnt vmcnt(0)" ::: "memory");
    __syncthreads();
    if (threadIdx.x == 0) {
        unsigned* bar = b.bar;
        __builtin_amdgcn_s_waitcnt(0);
        unsigned nloc = b.st[0], nx = b.st[1];
        if (nloc == 0u) { xcd_barrier_complete(bar, b.x, nloc, nx); b.st[0] = nloc; b.st[1] = nx; }
        const unsigned old = xb_add(&bar[XB_XSUB(b.x)], 1u);
        const unsigned gen = old / nloc;
        if (old + 1u == (gen + 1u) * nloc) {
            __builtin_amdgcn_fence(__ATOMIC_RELEASE, "agent");
            asm volatile("s_waitcnt vmcnt(0)" ::: "memory");
            const unsigned og = xb_add(&bar[XB_TOP], 1u);
            const unsigned tg = og / nx;
            if (og + 1u == (tg + 1u) * nx) xb_add(&bar[XB_TOPGEN], 1u);
            else XB_SPIN(xb_ld(&bar[XB_TOPGEN]) == tg, bar);
            __builtin_amdgcn_fence(__ATOMIC_ACQUIRE, "agent");
            xb_add(&bar[XB_XGEN(b.x)], 1u);
            asm volatile("s_waitcnt vmcnt(0)" ::: "memory");
        } else {
            XB_SPIN(xb_ld(&bar[XB_XGEN(b.x)]) == gen, bar);
            __builtin_amdgcn_fence(__ATOMIC_ACQUIRE, "agent");
            asm volatile("s_waitcnt vmcnt(0)" ::: "memory");
        }
    }
    __syncthreads();
}

typedef unsigned u32x2 __attribute__((ext_vector_type(2)));
typedef float f32x2 __attribute__((ext_vector_type(2)));
typedef float f32x16 __attribute__((ext_vector_type(16)));
typedef short s16x4 __attribute__((ext_vector_type(4)));
struct Frame {
    LAS unsigned char* lds;
    volatile LAS unsigned* MISC;
    gu32* ctl;
    int wave, vcu, G;
    const float* const* in;
    float* out; unsigned char* ws;
};
#define WSP(T, off) ((T*)(F.ws + (off)))
__device__ __forceinline__ int fresh_tid() { int t = threadIdx.x; asm volatile("" : "+v"(t)); return t; }

__device__ __forceinline__ float bf2f(unsigned short b) { return __uint_as_float((unsigned)b << 16); }
__device__ __forceinline__ float bflo(unsigned w) { return __uint_as_float(w << 16); }
__device__ __forceinline__ float bfhi(unsigned w) { return __uint_as_float(w & 0xffff0000u); }
__device__ __forceinline__ v4u pack8(const f32x4 a, const f32x4 b) { v4u w; w.x = pg8::cvt_pk_bf16(a.x, a.y); w.y = pg8::cvt_pk_bf16(a.z, a.w); w.z = pg8::cvt_pk_bf16(b.x, b.y); w.w = pg8::cvt_pk_bf16(b.z, b.w); return w; }
template <int CTRL> __device__ __forceinline__ float dpp_mov(float v) { return __builtin_bit_cast(float, __builtin_amdgcn_update_dpp(0, __builtin_bit_cast(int, v), CTRL, 0xF, 0xF, true)); }
__device__ __forceinline__ float row16_sum(float v) {
    v += dpp_mov<0xB1>(v);
    v += dpp_mov<0x4E>(v);
    v += dpp_mov<0x141>(v);
    v += dpp_mov<0x140>(v);
    return v;
}
__device__ __forceinline__ float wave_sum(float v) { v = row16_sum(v); v += __shfl_xor(v, 16); v += __shfl_xor(v, 32); return v; }
__device__ __forceinline__ float wave_max(float v) {
#pragma unroll
    for (int o = 1; o < 64; o <<= 1) v = fmaxf(v, __shfl_xor(v, o));
    return v;
}
__device__ __forceinline__ float log2gamma(int h) { return log2f(1.0f - exp2f(-(float)(5 + h))); }
__device__ __forceinline__ int t5_bucket(int n) {
    if (n < 16) return n;
    return 16 + (n >= 19) + (n >= 21) + (n >= 24) + (n >= 27) + (n >= 31) + (n >= 35) + (n >= 40) + (n >= 46) + (n >= 52) + (n >= 59) + (n >= 67) + (n >= 77) + (n >= 87) + (n >= 99) + (n >= 113);
}
__device__ __forceinline__ float lam_value(Frame& F, int lane) {
    const float a = F.in[I_LQ1][lane] * F.in[I_LK1][lane], b = F.in[I_LQ2][lane] * F.in[I_LK2][lane];
    return expf(wave_sum(a)) - expf(wave_sum(b)) + LAMINIT;
}

__device__ __forceinline__ int win_src_col(int n) {
    if (n < ZQR || n >= ZVR) return n;
    const int p = (n - ZQR) & 63;
    return (n - p) + (p >> 1) + 32 * (p & 1);
}
__device__ __forceinline__ void p0_transpose_item(const float* W, int K, int N, bf16* WT, int row_off, LAS float* scr, int item, int lane, const float* gk, bool perm) {
    const int nblk = N / 32, kb = item / nblk, nb = item % nblk, k0 = 64 * kb, n0 = 32 * nb;
    const int sc = perm ? win_src_col(n0 + (lane & 31)) : n0 + (lane & 31);
#pragma unroll 8
    for (int i = 0; i < 32; ++i) { const int kk = 2 * i + (lane >> 5); float v = W[(size_t)(k0 + kk) * N + sc]; if (gk) v *= gk[k0 + kk]; scr[kk * 33 + (lane & 31)] = v; }
    LDS_WAIT(); asm volatile("" ::: "memory");
    const int c = lane & 7;
#pragma unroll
    for (int j = 0; j < 4; ++j) { const int n = (lane >> 3) + 8 * j; const LAS float* s = scr + (8 * c) * 33 + n;
        v4u o; o.x = pk2(s[0 * 33], s[1 * 33]); o.y = pk2(s[2 * 33], s[3 * 33]); o.z = pk2(s[4 * 33], s[5 * 33]); o.w = pk2(s[6 * 33], s[7 * 33]);
        *(GAS v4u*)(WT + (size_t)(row_off + n0 + n) * K + k0 + 8 * c) = o; }
    LDS_WAIT(); asm volatile("" ::: "memory");
}
__device__ __forceinline__ void rms_row_to_bf16(int lane, const float* xrow, const float* g, bf16* orow) {
    const GAS f32x4* xr = (const GAS f32x4*)xrow + lane; const GAS f32x4* gr = (const GAS f32x4*)g + lane;
    f32x4 v[4]; float s = 0.f;
#pragma unroll
    for (int j = 0; j < 4; ++j) { v[j] = xr[64 * j]; s += (v[j].x * v[j].x + v[j].y * v[j].y) + (v[j].z * v[j].z + v[j].w * v[j].w); }
    const float rstd = 1.f / sqrtf(wave_sum(s) * (1.f / DM) + EPS);
    GAS unsigned long long* o8 = (GAS unsigned long long*)orow + lane;
#pragma unroll
    for (int j = 0; j < 4; ++j) { const f32x4 gv = gr[64 * j];
        o8[64 * j] = (unsigned long long)pk2(v[j].x * rstd * gv.x, v[j].y * rstd * gv.y) | ((unsigned long long)pk2(v[j].z * rstd * gv.z, v[j].w * rstd * gv.w) << 32); }
}
__device__ __forceinline__ void p0_prologue(Frame& F) {
    const int lane = fresh_tid() & 63;
    LAS float* scr = (LAS float*)(F.lds + RING_OFF + F.wave * 16384);
    const int gw = F.vcu * NWAVES + F.wave, NGW = F.G * NWAVES;
    constexpr int I_IN = 16 * 96, I_SQ = 16 * 32, I_UP = 16 * 128, I_DN = 64 * 32;
    constexpr int NITEMS = I_IN + 5 * I_SQ + I_UP + I_DN;
    for (int it = gw; it < NITEMS; it += NGW) {
        int r = it;
        if (r < I_IN) { p0_transpose_item(F.in[I_WIN], DM, DIN, WSP(bf16, WS_WIN), 0, scr, r, lane, nullptr, true); continue; } r -= I_IN;
        if (r < I_SQ) { p0_transpose_item(F.in[I_WOUT], DM, DM, WSP(bf16, WS_WOUT), 0, scr, r, lane, nullptr, false); continue; } r -= I_SQ;
        if (r < I_SQ) { p0_transpose_item(F.in[I_WMQ], DM, DM, WSP(bf16, WS_WMQ), 0, scr, r, lane, F.in[I_NMEMQ], false); continue; } r -= I_SQ;
        if (r < I_SQ) { p0_transpose_item(F.in[I_WMK], DM, DM, WSP(bf16, WS_WMKV), 0, scr, r, lane, nullptr, false); continue; } r -= I_SQ;
        if (r < I_SQ) { p0_transpose_item(F.in[I_WMV], DM, DM, WSP(bf16, WS_WMKV), DM, scr, r, lane, nullptr, false); continue; } r -= I_SQ;
        if (r < I_SQ) { p0_transpose_item(F.in[I_WMO], DM, DM, WSP(bf16, WS_WMO), 0, scr, r, lane, nullptr, false); continue; } r -= I_SQ;
        if (r < I_UP) { p0_transpose_item(F.in[I_WUP], DM, FF, WSP(bf16, WS_WUP), 0, scr, r, lane, F.in[I_NMLP], false); continue; } r -= I_UP;
        p0_transpose_item(F.in[I_WDN], FF, DM, WSP(bf16, WS_WDN), 0, scr, r, lane, nullptr, false);
    }
    bf16* XN = WSP(bf16, WS_XN); bf16* MEMN = WSP(bf16, WS_MEMN);
    for (int m = gw; m < MPAD + 2 * NMEM; m += NGW) {
        if (m < MP) rms_row_to_bf16(lane, F.in[I_XP] + (size_t)m * DM, F.in[I_NMIX], XN + (size_t)m * DM);
        else if (m < MV) rms_row_to_bf16(lane, F.in[I_XS] + (size_t)(m - MP) * DM, F.in[I_NMIX], XN + (size_t)m * DM);
        else if (m < MPAD) { GAS v4u* o = (GAS v4u*)(XN + (size_t)m * DM) + lane; o[0] = (v4u){0u, 0u, 0u, 0u}; o[64] = (v4u){0u, 0u, 0u, 0u}; }
        else rms_row_to_bf16(lane, F.in[I_MEMP] + (size_t)(m - MPAD) * DM, F.in[I_NMEMKV], MEMN + (size_t)(m - MPAD) * DM);
    }
}

__device__ __forceinline__ f32x4 silu4(f32x4 x) {
    f32x4 r;
    r.x = x.x * __builtin_amdgcn_rcpf(1.f + __builtin_amdgcn_exp2f(-x.x * LOG2E)); r.y = x.y * __builtin_amdgcn_rcpf(1.f + __builtin_amdgcn_exp2f(-x.y * LOG2E));
    r.z = x.z * __builtin_amdgcn_rcpf(1.f + __builtin_amdgcn_exp2f(-x.z * LOG2E)); r.w = x.w * __builtin_amdgcn_rcpf(1.f + __builtin_amdgcn_exp2f(-x.w * LOG2E));
    return r;
}
__device__ __forceinline__ void st_bf16(bf16* p, float v) { *(GAS unsigned short*)p = (unsigned short)f2bf(v); }

struct EpiZ {
    static constexpr bool PERM = true, AFTER_DRAIN = false;
    bf16* Z; float* out; bf16* KRT; bf16* VRT;
    __device__ __forceinline__ void operator()(const pg8::f32x4 (&acc)[2][2][4][2], const pg8::Unit& u, int wr, int wc, int fr, int fq) const {
        const int pn = u.pn, row0 = u.pm * 256 + wr * 64 + fr, colw = wc * 32 + 8 * fq;
        if (pn < 2 || pn >= 10) {
#pragma unroll
            for (int ai = 0; ai < 2; ++ai)
#pragma unroll
                for (int m = 0; m < 4; ++m) { const int row = row0 + ai * 128 + m * 16; bf16* zp = Z + (size_t)row * DIN + pn * 256 + colw;
#pragma unroll
                    for (int bj = 0; bj < 2; ++bj) { f32x4 v0 = acc[ai][bj][m][0], v1 = acc[ai][bj][m][1];
                        if (pn < 2) { v0 = v0 * C2A; v1 = v1 * C2A; } else { v0 = silu4(v0); v1 = silu4(v1); }
                        *(GAS v4u*)(zp + bj * 128) = pack8(v0, v1); } }
        } else if (pn < 6) {
            const bool isK = pn < 4; const int cb = (pn & 1) * 256;
#pragma unroll
            for (int ai = 0; ai < 2; ++ai)
#pragma unroll
                for (int m = 0; m < 4; ++m) { const int row = row0 + ai * 128 + m * 16; bf16* zp = Z + (size_t)row * DIN + pn * 256 + colw;
                    float* dst = nullptr;
                    if (row < MP) dst = out + (isK ? OK_P : OV_P) + (size_t)row * 512; else if (row < MV) dst = out + (isK ? OK_S : OV_S) + (size_t)(row - MP) * 512;
#pragma unroll
                    for (int bj = 0; bj < 2; ++bj) { const f32x4 v0 = acc[ai][bj][m][0], v1 = acc[ai][bj][m][1]; const int c = cb + bj * 128 + colw;
                        if (dst) { *(GAS f32x4*)(dst + c) = v0; *(GAS f32x4*)(dst + c + 4) = v1; }
                        *(GAS v4u*)(zp + bj * 128) = pack8(v0, v1); } }
        } else if (pn < 8) {
            const bool isKr = pn == 7; const int j0 = 16 * (wc & 1) + 4 * fq, p0 = colw & 63;
            float invf[4];
#pragma unroll
            for (int i = 0; i < 4; ++i) invf[i] = exp2f(-(float)(j0 + i) * (13.287712379549449f / 31.0f));
            const float l2g0 = log2gamma(wc >> 1), l2g1 = log2gamma(2 + (wc >> 1));
#pragma unroll
            for (int ai = 0; ai < 2; ++ai)
#pragma unroll
                for (int m = 0; m < 4; ++m) { const int row = row0 + ai * 128 + m * 16; const int pos = row < MP ? (row & (TSEQ - 1)) : PASTLEN;
                    float cs[4], sn[4];
#pragma unroll
                    for (int i = 0; i < 4; ++i) { const float ang = (float)pos * invf[i]; double rv = (double)ang * 0.15915494309189535; rv -= floor(rv); const float rf = (float)rv;
                        sn[i] = __builtin_amdgcn_sinf(rf); cs[i] = __builtin_amdgcn_cosf(rf); }
                    const int t = row & (TSEQ - 1), b = row >> 13;
#pragma unroll
                    for (int bj = 0; bj < 2; ++bj) { const f32x4 v0 = acc[ai][bj][m][0], v1 = acc[ai][bj][m][1]; const int head = 2 * bj + (wc >> 1);
                        float y[8];
                        y[0] = v0.x * cs[0] - v0.y * sn[0]; y[1] = v0.y * cs[0] + v0.x * sn[0]; y[2] = v0.z * cs[1] - v0.w * sn[1]; y[3] = v0.w * cs[1] + v0.z * sn[1];
                        y[4] = v1.x * cs[2] - v1.y * sn[2]; y[5] = v1.y * cs[2] + v1.x * sn[2]; y[6] = v1.z * cs[3] - v1.w * sn[3]; y[7] = v1.w * cs[3] + v1.z * sn[3];
                        if (isKr) {
#pragma unroll
                            for (int e = 0; e < 8; ++e) y[e] *= 0.125f; }
                        *(GAS v4u*)(Z + (size_t)row * DIN + pn * 256 + bj * 128 + colw) = pack8((f32x4){y[0], y[1], y[2], y[3]}, (f32x4){y[4], y[5], y[6], y[7]});
                        if (isKr && row < MP) { const float dec = exp2f((float)(127 - (t & 127)) * (bj ? l2g1 : l2g0));
                            bf16* kp = KRT + ((size_t)((b * 4 + head) * 64 + p0)) * TSEQ + t;
#pragma unroll
                            for (int e = 0; e < 8; ++e) st_bf16(kp + (size_t)e * TSEQ, y[e] * dec); } } }
        } else {
#pragma unroll
            for (int ai = 0; ai < 2; ++ai)
#pragma unroll
                for (int m = 0; m < 4; ++m) { const int row = row0 + ai * 128 + m * 16; const int t = row & (TSEQ - 1), b = row >> 13;
#pragma unroll
                    for (int bj = 0; bj < 2; ++bj) { const f32x4 v0 = acc[ai][bj][m][0], v1 = acc[ai][bj][m][1]; const int head = (pn - 8) * 2 + bj;
                        *(GAS v4u*)(Z + (size_t)row * DIN + pn * 256 + bj * 128 + colw) = pack8(v0, v1);
                        if (row < MP) { bf16* vp = VRT + ((size_t)((b * 4 + head) * 128 + colw)) * TSEQ + t;
                            st_bf16(vp, v0.x); st_bf16(vp + (size_t)TSEQ, v0.y); st_bf16(vp + (size_t)2 * TSEQ, v0.z); st_bf16(vp + (size_t)3 * TSEQ, v0.w);
                            st_bf16(vp + (size_t)4 * TSEQ, v1.x); st_bf16(vp + (size_t)5 * TSEQ, v1.y); st_bf16(vp + (size_t)6 * TSEQ, v1.z); st_bf16(vp + (size_t)7 * TSEQ, v1.w); } } }
        }
    }
};
struct EpiMemKV {
    static constexpr bool PERM = true, AFTER_DRAIN = false;
    float* out; bf16* MKB; bf16* MVT;
    __device__ __forceinline__ void operator()(const pg8::f32x4 (&acc)[2][2][4][2], const pg8::Unit& u, int wr, int wc, int fr, int fq) const {
        const int pn = u.pn, row0 = u.pm * 256 + wr * 64 + fr, colw = wc * 32 + 8 * fq; const bool isK = pn < 4;
#pragma unroll
        for (int ai = 0; ai < 2; ++ai)
#pragma unroll
            for (int m = 0; m < 4; ++m) { const int row = row0 + ai * 128 + m * 16;
#pragma unroll
                for (int bj = 0; bj < 2; ++bj) { const f32x4 v0 = acc[ai][bj][m][0], v1 = acc[ai][bj][m][1]; const int c = (pn & 3) * 256 + bj * 128 + colw;
                    float* dst = out + (isK ? OMK : OMV) + (size_t)row * DM + c;
                    *(GAS f32x4*)dst = v0; *(GAS f32x4*)(dst + 4) = v1;
                    if (isK) *(GAS v4u*)(MKB + (size_t)row * DM + c) = pack8(v0, v1);
                    else { bf16* vp = MVT + (size_t)c * 512 + row;
                        st_bf16(vp, v0.x); st_bf16(vp + 512, v0.y); st_bf16(vp + 1024, v0.z); st_bf16(vp + 1536, v0.w); st_bf16(vp + 2048, v1.x); st_bf16(vp + 2560, v1.y); st_bf16(vp + 3072, v1.z); st_bf16(vp + 3584, v1.w); } } }
    }
};
template <bool BASEBF> struct EpiRes {
    static constexpr bool PERM = false, AFTER_DRAIN = false;
    const void* base; float* outf; bf16* outb; float* ssq;
    __device__ __forceinline__ void operator()(const pg8::f32x4 (&acc)[2][2][4][2], const pg8::Unit& u, int wr, int wc, int fr, int fq) const {
#pragma unroll
        for (int ai = 0; ai < 2; ++ai)
#pragma unroll
            for (int m = 0; m < 4; ++m) { const int row = u.pm * 256 + ai * 128 + wr * 64 + m * 16 + fr; float ss = 0.f;
#pragma unroll
                for (int bj = 0; bj < 2; ++bj)
#pragma unroll
                    for (int n = 0; n < 2; ++n) { const int c = u.pn * 256 + bj * 128 + wc * 32 + n * 16 + 4 * fq; f32x4 bv;
                        if (BASEBF) { const u32x2 bb = *(const GAS u32x2*)((const bf16*)base + (size_t)row * DM + c); bv = (f32x4){bflo(bb.x), bfhi(bb.x), bflo(bb.y), bfhi(bb.y)}; }
                        else bv = *(const GAS f32x4*)((const float*)base + (size_t)row * DM + c);
                        const f32x4 o = bv + acc[ai][bj][m][n];
                        if (outf) *(GAS f32x4*)(outf + (size_t)row * DM + c) = o;
                        if (outb) { u32x2 w; w.x = pg8::cvt_pk_bf16(o.x, o.y); w.y = pg8::cvt_pk_bf16(o.z, o.w); *(GAS u32x2*)(outb + (size_t)row * DM + c) = w; }
                        ss += (o.x * o.x + o.y * o.y) + (o.z * o.z + o.w * o.w); }
                ss += __shfl_xor(ss, 16); ss += __shfl_xor(ss, 32);
                if (fq == 0) ssq[(size_t)row * 16 + u.pn * 4 + wc] = ss; }
    }
};
__device__ __forceinline__ float rstd_from_ssq(const float* ssq, int row) {
    const GAS f32x4* p = (const GAS f32x4*)(ssq + (size_t)row * 16); const f32x4 a = p[0], b = p[1], c = p[2], d = p[3];
    const float s = ((a.x + a.y) + (a.z + a.w)) + ((b.x + b.y) + (b.z + b.w)) + ((c.x + c.y) + (c.z + c.w)) + ((d.x + d.y) + (d.z + d.w));
    return 1.f / sqrtf(s * (1.f / DM) + EPS);
}
template <int ACT  > struct EpiScale {
    static constexpr bool PERM = true, AFTER_DRAIN = false;
    bf16* O; int ldc; const float* ssq; float scale;
    __device__ __forceinline__ void operator()(const pg8::f32x4 (&acc)[2][2][4][2], const pg8::Unit& u, int wr, int wc, int fr, int fq) const {
        const int row0 = u.pm * 256 + wr * 64 + fr, colw = u.pn * 256 + wc * 32 + 8 * fq;
#pragma unroll
        for (int ai = 0; ai < 2; ++ai)
#pragma unroll
            for (int m = 0; m < 4; ++m) { const int row = row0 + ai * 128 + m * 16; const float rs = rstd_from_ssq(ssq, row) * scale;
#pragma unroll
                for (int bj = 0; bj < 2; ++bj) { f32x4 v0 = acc[ai][bj][m][0] * rs, v1 = acc[ai][bj][m][1] * rs;
                    if (ACT == 1) { v0.x = fmaxf(v0.x, 0.f); v0.y = fmaxf(v0.y, 0.f); v0.z = fmaxf(v0.z, 0.f); v0.w = fmaxf(v0.w, 0.f); v1.x = fmaxf(v1.x, 0.f); v1.y = fmaxf(v1.y, 0.f); v1.z = fmaxf(v1.z, 0.f); v1.w = fmaxf(v1.w, 0.f);
                        v0 = v0 * v0; v1 = v1 * v1; }
                    *(GAS v4u*)(O + (size_t)row * ldc + bj * 128 + colw) = pack8(v0, v1); } }
    }
};
struct EpiPlain {
    static constexpr bool PERM = true, AFTER_DRAIN = false;
    bf16* O; int ldc;
    __device__ __forceinline__ void operator()(const pg8::f32x4 (&acc)[2][2][4][2], const pg8::Unit& u, int wr, int wc, int fr, int fq) const {
        const int row0 = u.pm * 256 + wr * 64 + fr, colw = u.pn * 256 + wc * 32 + 8 * fq;
#pragma unroll
        for (int ai = 0; ai < 2; ++ai)
#pragma unroll
            for (int m = 0; m < 4; ++m) { const int row = row0 + ai * 128 + m * 16;
#pragma unroll
                for (int bj = 0; bj < 2; ++bj) *(GAS v4u*)(O + (size_t)row * ldc + bj * 128 + colw) = pack8(acc[ai][bj][m][0], acc[ai][bj][m][1]); }
    }
};
struct EpiSoftmax {
    static constexpr bool PERM = true, AFTER_DRAIN = true;
    bf16* O; int ldc;
    __device__ __forceinline__ void fused(pg8::f32x4 (&acc)[2][2][4][2], const pg8::Unit& u, int wr, int wc, int fr, int fq, PG8_LAS unsigned char* lds, int wid, int lane) const {
        PG8_LAS float* PMX = (PG8_LAS float*)lds;
        PG8_LAS float* PSM = (PG8_LAS float*)(lds + 4096);
#pragma unroll
        for (int ai = 0; ai < 2; ++ai)
#pragma unroll
            for (int m = 0; m < 4; ++m) { float mx = -INFINITY;
#pragma unroll
                for (int bj = 0; bj < 2; ++bj)
#pragma unroll
                    for (int n = 0; n < 2; ++n) { const pg8::f32x4 x = acc[ai][bj][m][n]; mx = fmaxf(mx, fmaxf(fmaxf(x.x, x.y), fmaxf(x.z, x.w))); }
                mx = fmaxf(mx, __shfl_xor(mx, 16)); mx = fmaxf(mx, __shfl_xor(mx, 32));
                if (fq == 0) PMX[(ai * 128 + wr * 64 + m * 16 + fr) * 4 + wc] = mx; }
        asm volatile("s_waitcnt lgkmcnt(0)" ::: "memory"); __builtin_amdgcn_s_barrier(); asm volatile("" ::: "memory");
#pragma unroll
        for (int ai = 0; ai < 2; ++ai)
#pragma unroll
            for (int m = 0; m < 4; ++m) { const int r = ai * 128 + wr * 64 + m * 16 + fr; const pg8::f32x4 q = *(const PG8_LAS pg8::f32x4*)(PMX + r * 4);
                const float mx = fmaxf(fmaxf(q.x, q.y), fmaxf(q.z, q.w)); float s = 0.f;
#pragma unroll
                for (int bj = 0; bj < 2; ++bj)
#pragma unroll
                    for (int n = 0; n < 2; ++n) { pg8::f32x4 x = acc[ai][bj][m][n];
                        x.x = __builtin_amdgcn_exp2f(x.x - mx); x.y = __builtin_amdgcn_exp2f(x.y - mx); x.z = __builtin_amdgcn_exp2f(x.z - mx); x.w = __builtin_amdgcn_exp2f(x.w - mx);
                        acc[ai][bj][m][n] = x; s += (x.x + x.y) + (x.z + x.w); }
                s += __shfl_xor(s, 16); s += __shfl_xor(s, 32);
                if (fq == 0) PSM[r * 4 + wc] = s; }
        asm volatile("s_waitcnt lgkmcnt(0)" ::: "memory"); __builtin_amdgcn_s_barrier(); asm volatile("" ::: "memory");
        const int colw = wc * 32 + 8 * fq;
#pragma unroll
        for (int ai = 0; ai < 2; ++ai)
#pragma unroll
            for (int m = 0; m < 4; ++m) { const int r = ai * 128 + wr * 64 + m * 16 + fr; const pg8::f32x4 q = *(const PG8_LAS pg8::f32x4*)(PSM + r * 4);
                const float inv = 1.f / ((q.x + q.y) + (q.z + q.w));
#pragma unroll
                for (int bj = 0; bj < 2; ++bj) *(GAS v4u*)(O + (size_t)(u.pm * 256 + r) * ldc + bj * 128 + colw) = pack8(acc[ai][bj][m][0] * inv, acc[ai][bj][m][1] * inv); }
    }
};

__device__ __forceinline__ f32x16 mfma32(bf16x8 a, bf16x8 b, f32x16 c) { return __builtin_amdgcn_mfma_f32_32x32x16_bf16(a, b, c, 0, 0, 0); }
__device__ __forceinline__ int crow16(int r, int hh) { return (r & 3) + 8 * (r >> 2) + 4 * hh; }

__device__ __forceinline__ void ret_stepA(Frame& F, int bh, int c) {
    const int tid = fresh_tid(), lane = tid & 63; (void)tid; (void)lane;
    const int w = F.wave, r = lane & 31, hh = lane >> 5, db = w >> 2, eb = w & 3;
    const bf16* ka = WSP(bf16, WS_KRT) + ((size_t)(bh * 64 + 32 * db + r)) * TSEQ + c * 128 + 8 * hh;
    const bf16* va = WSP(bf16, WS_VRT) + ((size_t)(bh * 128 + 32 * eb + r)) * TSEQ + c * 128 + 8 * hh;
    bf16x8 af[8], bfr[8];
#pragma unroll
    for (int ks = 0; ks < 8; ++ks) { af[ks] = *(const GAS bf16x8*)(ka + 16 * ks); bfr[ks] = *(const GAS bf16x8*)(va + 16 * ks); }
    f32x16 acc = {};
#pragma unroll
    for (int ks = 0; ks < 8; ++ks) acc = mfma32(af[ks], bfr[ks], acc);
    float* up = WSP(float, WS_U) + ((size_t)(bh * 64 + c) * 64 + 32 * db) * 128 + 32 * eb + r;
#pragma unroll
    for (int q = 0; q < 16; ++q) up[(size_t)crow16(q, hh) * 128] = acc[q];
}

constexpr size_t WS_DPB = WS_SSQ3 + 7 * MiB / 4;
__device__ __forceinline__ void dec_attn_piece(Frame& F, int s, int hp, int pj) {
    const int tid = fresh_tid(), lane = tid & 63; (void)tid; (void)lane;
    LAS float* sc = (LAS float*)(F.lds);
    LAS float* wm = (LAS float*)(F.lds + 12288);
    LAS float* wo = (LAS float*)(F.lds + 16384);
    const LAS float* tab = (const LAS float*)(F.lds + TAB_OFF);
    const int w = F.wave, l = lane, hsel = l >> 5, f = l & 31, g = l >> 4, h = 2 * hp + hsel, row = MP + s;
    const bf16* Z = WSP(bf16, WS_Z);
    const u32x2 qq = *(const GAS u32x2*)(Z + (size_t)row * DIN + ZQA + h * 128 + 4 * f);
    const f32x4 q4 = {bflo(qq.x), bfhi(qq.x), bflo(qq.y), bfhi(qq.y)};
    const int pgi = 4 * pj + (w >> 1), kpos0 = pgi * 128 + (w & 1) * 64;
    const int pg = __builtin_amdgcn_readfirstlane(((const int*)F.in[I_PT])[s * 16 + pgi]);
    LAS float* scw = sc + w * 272;
    const LAS float* tabh = tab + h * 128;
    const __amdgpu_buffer_rsrc_t rk = __builtin_amdgcn_make_buffer_rsrc((void*)F.in[I_CK], 0, 0x7fffffff, 0x00020000), rv = __builtin_amdgcn_make_buffer_rsrc((void*)F.in[I_CV], 0, 0x7fffffff, 0x00020000);
    const int loff = 16 * l + 2 * hp * 512;
    const int so0 = (pg * 128 + (w & 1) * 64) * 2048;
    const bool near = (pj == 3 && w >= 6);
#define DA_LOAD(buf, rs, bt) do { _Pragma("unroll") for (int i_ = 0; i_ < 8; ++i_) buf[i_] = __builtin_bit_cast(f32x4, __builtin_amdgcn_raw_buffer_load_b128(rs, loff, so0 + ((bt) * 8 + i_) * 2048, 0)); } while (0)
#define DA_SCORE(buf, bt) do { _Pragma("unroll") for (int i_ = 0; i_ < 8; ++i_) { const int kk_ = (bt) * 8 + i_; \
        float p_ = (buf[i_].x * q4.x + buf[i_].y * q4.y) + (buf[i_].z * q4.z + buf[i_].w * q4.w); p_ = row16_sum(p_); \
        if (near) { const int rel_ = PASTLEN - (kpos0 + kk_); p_ += tabh[rel_ < 127 ? rel_ : 127]; } \
        if ((l & 15) == 0) scw[kk_ * 4 + g] = p_; } } while (0)
#define DA_PV(buf, bt) do { _Pragma("unroll") for (int i_ = 0; i_ < 8; ++i_) { const f32x2 pp_ = *(const LAS f32x2*)(scw + ((bt) * 8 + i_) * 4 + hsel * 2); o1 = o1 + buf[i_] * pp_.x; o2 = o2 + buf[i_] * pp_.y; } } while (0)
    f32x4 ba[8], bb[8];
    DA_LOAD(ba, rk, 0);
#pragma unroll 1
    for (int bt = 0; bt < 8; bt += 2) { DA_LOAD(bb, rk, bt + 1); DA_SCORE(ba, bt); if (bt + 2 < 8) DA_LOAD(ba, rk, bt + 2); else DA_LOAD(ba, rv, 0); DA_SCORE(bb, bt + 1); }
    const bool hasnew = (pj == 3 && w == 7); const int nk = hasnew ? 65 : 64;
    if (hasnew) { const f32x4 kn = *(const GAS f32x4*)(F.out + OK_S + (size_t)s * 512 + h * 128 + 4 * f);
        float p = (kn.x * q4.x + kn.y * q4.y) + (kn.z * q4.z + kn.w * q4.w); p = row16_sum(p);
        if ((l & 15) == 0) scw[64 * 4 + g] = p + tabh[0]; }
    LDS_WAIT(); asm volatile("" ::: "memory");
    float mg0, mg1, mg2, mg3, lg0, lg1, lg2, lg3;
    { float m0 = -INFINITY, m1 = -INFINITY, m2 = -INFINITY, m3 = -INFINITY;
      for (int kk = l; kk < nk; kk += 64) { const f32x4 v = *(const LAS f32x4*)(scw + kk * 4); m0 = fmaxf(m0, v.x); m1 = fmaxf(m1, v.y); m2 = fmaxf(m2, v.z); m3 = fmaxf(m3, v.w); }
      mg0 = wave_max(m0); mg1 = wave_max(m1); mg2 = wave_max(m2); mg3 = wave_max(m3);
      float s0 = 0.f, s1 = 0.f, s2 = 0.f, s3 = 0.f;
      for (int kk = l; kk < nk; kk += 64) { f32x4 v = *(const LAS f32x4*)(scw + kk * 4);
          v.x = __builtin_amdgcn_exp2f(v.x - mg0); v.y = __builtin_amdgcn_exp2f(v.y - mg1); v.z = __builtin_amdgcn_exp2f(v.z - mg2); v.w = __builtin_amdgcn_exp2f(v.w - mg3);
          *(LAS f32x4*)(scw + kk * 4) = v; s0 += v.x; s1 += v.y; s2 += v.z; s3 += v.w; }
      lg0 = wave_sum(s0); lg1 = wave_sum(s1); lg2 = wave_sum(s2); lg3 = wave_sum(s3); }
    LDS_WAIT(); asm volatile("" ::: "memory");
    f32x4 o1 = {0.f, 0.f, 0.f, 0.f}, o2 = {0.f, 0.f, 0.f, 0.f};
#pragma unroll 1
    for (int bt = 0; bt < 8; bt += 2) { DA_LOAD(bb, rv, bt + 1); DA_PV(ba, bt); if (bt + 2 < 8) DA_LOAD(ba, rv, bt + 2); DA_PV(bb, bt + 1); }
#undef DA_LOAD
#undef DA_SCORE
#undef DA_PV
    if (hasnew) { const f32x4 vn = *(const GAS f32x4*)(F.out + OV_S + (size_t)s * 512 + h * 128 + 4 * f);
        const float p1 = scw[64 * 4 + hsel * 2], p2 = scw[64 * 4 + hsel * 2 + 1]; o1 = o1 + vn * p1; o2 = o2 + vn * p2; }
    if (l < 4) { const float mv = l == 0 ? mg0 : l == 1 ? mg1 : l == 2 ? mg2 : mg3, lv = l == 0 ? lg0 : l == 1 ? lg1 : l == 2 ? lg2 : lg3; wm[w * 4 + l] = mv; wm[32 + w * 4 + l] = lv; }
    *(LAS f32x4*)(wo + ((w * 2 + 0) * 64 + l) * 4) = o1; *(LAS f32x4*)(wo + ((w * 2 + 1) * 64 + l) * 4) = o2;
    LDS_WAIT(); __syncthreads();
    if (tid < 128) { const int map = tid >> 6, ll = tid & 63, gg = (ll >> 5) * 2 + map;
        float M = -INFINITY;
#pragma unroll
        for (int ww = 0; ww < 8; ++ww) M = fmaxf(M, wm[ww * 4 + gg]);
        float L = 0.f; f32x4 o = {0.f, 0.f, 0.f, 0.f};
#pragma unroll
        for (int ww = 0; ww < 8; ++ww) { const float e = __builtin_amdgcn_exp2f(wm[ww * 4 + gg] - M); L += wm[32 + ww * 4 + gg] * e; o = o + *(const LAS f32x4*)(wo + ((ww * 2 + map) * 64 + ll) * 4) * e; }
        float* pb = WSP(float, WS_DPB) + ((size_t)((s * 2 + hp) * 4 + pj) * 128 + tid) * 8;
        *(GAS f32x4*)pb = o; *(GAS f32x2*)(pb + 4) = (f32x2){M, L}; }
    LDS_WAIT(); __syncthreads();
}
__device__ __forceinline__ void dec_attn_final(Frame& F, int s, int hp) {
    const int tid = fresh_tid();
    VM_WAIT(); __syncthreads();
    if (tid < 128) { const int map = tid >> 6, ll = tid & 63, row = MP + s;
        const float* pb = WSP(float, WS_DPB) + ((size_t)((s * 2 + hp) * 4) * 128 + tid) * 8;
        f32x4 oj[4]; f32x2 ml[4];
#pragma unroll
        for (int jj = 0; jj < 4; ++jj) { oj[jj] = *(const GAS f32x4*)(pb + (size_t)jj * 1024); ml[jj] = *(const GAS f32x2*)(pb + (size_t)jj * 1024 + 4); }
        const float M = fmaxf(fmaxf(ml[0].x, ml[1].x), fmaxf(ml[2].x, ml[3].x)); float L = 0.f; f32x4 o = {0.f, 0.f, 0.f, 0.f};
#pragma unroll
        for (int jj = 0; jj < 4; ++jj) { const float e = __builtin_amdgcn_exp2f(ml[jj].x - M); L += ml[jj].y * e; o = o + oj[jj] * e; }
        const float inv = 1.f / L; u32x2 ov; ov.x = pk2(o.x * inv, o.y * inv); ov.y = pk2(o.z * inv, o.w * inv);
        *(GAS u32x2*)(WSP(bf16, WS_OA) + (size_t)row * DM + map * 512 + (2 * hp + (ll >> 5)) * 128 + 4 * (ll & 31)) = ov; }
}

__device__ __forceinline__ void dec_attn_unit(Frame& F, int s, int hp) {
    const int tid = fresh_tid(), lane = tid & 63; (void)tid; (void)lane;
    LAS float* sc = (LAS float*)(F.lds);
    LAS float* wm = (LAS float*)(F.lds + 36864);
    LAS float* wo = (LAS float*)(F.lds + 40960);
    const LAS float* tab = (const LAS float*)(F.lds + TAB_OFF);
    const int w = F.wave, l = lane, hsel = l >> 5, f = l & 31, g = l >> 4, h = 2 * hp + hsel, row = MP + s;
    const bf16* Z = WSP(bf16, WS_Z);
    const u32x2 qq = *(const GAS u32x2*)(Z + (size_t)row * DIN + ZQA + h * 128 + 4 * f);
    const f32x4 q4 = {bflo(qq.x), bfhi(qq.x), bflo(qq.y), bfhi(qq.y)};
    const int* pt = (const int*)F.in[I_PT] + s * 16;
    const int pg0 = __builtin_amdgcn_readfirstlane(pt[2 * w]), pg1 = __builtin_amdgcn_readfirstlane(pt[2 * w + 1]);
    LAS float* scw = sc + w * 1040;
    const LAS float* tabh = tab + h * 128;
    const __amdgpu_buffer_rsrc_t rk = __builtin_amdgcn_make_buffer_rsrc((void*)F.in[I_CK], 0, 0x7fffffff, 0x00020000), rv = __builtin_amdgcn_make_buffer_rsrc((void*)F.in[I_CV], 0, 0x7fffffff, 0x00020000);
    const int loff = 16 * l + 2 * hp * 512;
#define DA_LOAD(buf, rs, bt) do { const int so_ = (((bt) < 16 ? pg0 : pg1) * 128 + (((bt) & 15) * 8)) * 2048; \
        _Pragma("unroll") for (int i_ = 0; i_ < 8; ++i_) buf[i_] = __builtin_bit_cast(f32x4, __builtin_amdgcn_raw_buffer_load_b128(rs, loff, so_ + i_ * 2048, 2)); } while (0)
#define DA_SCORE(buf, bt) do { _Pragma("unroll") for (int i_ = 0; i_ < 8; ++i_) { const int kk_ = (bt) * 8 + i_; \
        float p_ = (buf[i_].x * q4.x + buf[i_].y * q4.y) + (buf[i_].z * q4.z + buf[i_].w * q4.w); p_ = row16_sum(p_); \
        if (w == 7) { const int rel_ = PASTLEN - (w * 256 + kk_); p_ += tabh[rel_ < 127 ? rel_ : 127]; }     \
        if ((l & 15) == 0) scw[kk_ * 4 + g] = p_; } } while (0)
#define DA_PV(buf, bt) do { _Pragma("unroll") for (int i_ = 0; i_ < 8; ++i_) { const f32x2 pp_ = *(const LAS f32x2*)(scw + ((bt) * 8 + i_) * 4 + hsel * 2); o1 = o1 + buf[i_] * pp_.x; o2 = o2 + buf[i_] * pp_.y; } } while (0)
    f32x4 ba[8], bb[8];
    DA_LOAD(ba, rk, 0);
#pragma unroll 1
    for (int bt = 0; bt < 32; bt += 2) { DA_LOAD(bb, rk, bt + 1); DA_SCORE(ba, bt); if (bt + 2 < 32) DA_LOAD(ba, rk, bt + 2); DA_SCORE(bb, bt + 1); }
    const int nk = (w == 0) ? 257 : 256;
    if (w == 0) { const f32x4 kn = *(const GAS f32x4*)(F.out + OK_S + (size_t)s * 512 + h * 128 + 4 * f);
        float p = (kn.x * q4.x + kn.y * q4.y) + (kn.z * q4.z + kn.w * q4.w); p = row16_sum(p);
        if ((l & 15) == 0) scw[256 * 4 + g] = p + tabh[0]; }
    LDS_WAIT(); asm volatile("" ::: "memory");
    float mg0, mg1, mg2, mg3, lg0, lg1, lg2, lg3;
    { float m0 = -INFINITY, m1 = -INFINITY, m2 = -INFINITY, m3 = -INFINITY;
      for (int kk = l; kk < nk; kk += 64) { const f32x4 v = *(const LAS f32x4*)(scw + kk * 4); m0 = fmaxf(m0, v.x); m1 = fmaxf(m1, v.y); m2 = fmaxf(m2, v.z); m3 = fmaxf(m3, v.w); }
      mg0 = wave_max(m0); mg1 = wave_max(m1); mg2 = wave_max(m2); mg3 = wave_max(m3);
      float s0 = 0.f, s1 = 0.f, s2 = 0.f, s3 = 0.f;
      for (int kk = l; kk < nk; kk += 64) { f32x4 v = *(const LAS f32x4*)(scw + kk * 4);
          v.x = __builtin_amdgcn_exp2f(v.x - mg0); v.y = __builtin_amdgcn_exp2f(v.y - mg1); v.z = __builtin_amdgcn_exp2f(v.z - mg2); v.w = __builtin_amdgcn_exp2f(v.w - mg3);
          *(LAS f32x4*)(scw + kk * 4) = v; s0 += v.x; s1 += v.y; s2 += v.z; s3 += v.w; }
      lg0 = wave_sum(s0); lg1 = wave_sum(s1); lg2 = wave_sum(s2); lg3 = wave_sum(s3); }
    LDS_WAIT(); asm volatile("" ::: "memory");
    f32x4 o1 = {0.f, 0.f, 0.f, 0.f}, o2 = {0.f, 0.f, 0.f, 0.f};
    DA_LOAD(ba, rv, 0);
#pragma unroll 1
    for (int bt = 0; bt < 32; bt += 2) { DA_LOAD(bb, rv, bt + 1); DA_PV(ba, bt); if (bt + 2 < 32) DA_LOAD(ba, rv, bt + 2); DA_PV(bb, bt + 1); }
#undef DA_LOAD
#undef DA_SCORE
#undef DA_PV
    if (w == 0) { const f32x4 vn = *(const GAS f32x4*)(F.out + OV_S + (size_t)s * 512 + h * 128 + 4 * f);
        const float p1 = scw[256 * 4 + hsel * 2], p2 = scw[256 * 4 + hsel * 2 + 1]; o1 = o1 + vn * p1; o2 = o2 + vn * p2; }
    if (l < 4) { const float mv = l == 0 ? mg0 : l == 1 ? mg1 : l == 2 ? mg2 : mg3, lv = l == 0 ? lg0 : l == 1 ? lg1 : l == 2 ? lg2 : lg3; wm[w * 4 + l] = mv; wm[32 + w * 4 + l] = lv; }
    *(LAS f32x4*)(wo + ((w * 2 + 0) * 64 + l) * 4) = o1; *(LAS f32x4*)(wo + ((w * 2 + 1) * 64 + l) * 4) = o2;
    LDS_WAIT(); __syncthreads();
    if (tid < 128) { const int map = tid >> 6, ll = tid & 63, gg = (ll >> 5) * 2 + map;
        float M = -INFINITY;
#pragma unroll
        for (int ww = 0; ww < 8; ++ww) M = fmaxf(M, wm[ww * 4 + gg]);
        float L = 0.f; f32x4 o = {0.f, 0.f, 0.f, 0.f};
#pragma unroll
        for (int ww = 0; ww < 8; ++ww) { const float e = __builtin_amdgcn_exp2f(wm[ww * 4 + gg] - M); L += wm[32 + ww * 4 + gg] * e; o = o + *(const LAS f32x4*)(wo + ((ww * 2 + map) * 64 + ll) * 4) * e; }
        const float inv = 1.f / L; u32x2 ov; ov.x = pk2(o.x * inv, o.y * inv); ov.y = pk2(o.z * inv, o.w * inv);
        *(GAS u32x2*)(WSP(bf16, WS_OA) + (size_t)row * DM + map * 512 + (2 * hp + (ll >> 5)) * 128 + 4 * (ll & 31)) = ov; }
    LDS_WAIT(); __syncthreads();
}

__device__ __forceinline__ void dec_ret_unit(Frame& F, int s, int h) {
    const int tid = fresh_tid(), lane = tid & 63; (void)tid; (void)lane;
    LAS float* part = (LAS float*)(F.lds);
    LAS float* half = (LAS float*)(F.lds + 2048);
    const int e = tid & 127, dg = tid >> 7, row = MP + s;
    const bf16* Zr = WSP(bf16, WS_Z) + (size_t)row * DIN;
    const float gam = 1.0f - exp2f(-(float)(5 + h));
    const float v = bf2f(Zr[ZVR + h * 128 + e]);
    const float* Sin = F.in[I_SRET] + ((size_t)(s * 4 + h) * 64) * 128 + e; float* Sout = F.out + OS_S + ((size_t)(s * 4 + h) * 64) * 128 + e;
    float op = 0.f;
#pragma unroll 4
    for (int i = 0; i < 16; ++i) { const int d = dg * 16 + i, p = 2 * (d & 31) + (d >> 5);
        const float kq = bf2f(Zr[ZKR + h * 64 + p]), qq = bf2f(Zr[ZQR + h * 64 + p]);
        const float sn = gam * Sin[(size_t)d * 128] + kq * v; Sout[(size_t)d * 128] = sn; op += qq * sn; }
    part[dg * 128 + e] = op;
    LDS_WAIT(); __syncthreads();
    float o = 0.f;
    if (tid < 128) { o = (part[e] + part[128 + e]) + (part[256 + e] + part[384 + e]); const float ss = wave_sum(o * o); if (lane == 0) half[F.wave] = ss; }
    LDS_WAIT(); __syncthreads();
    if (tid < 128) { const float rs = 1.f / sqrtf((half[0] + half[1]) * (1.f / 128.f) + EPS);
        st_bf16(WSP(bf16, WS_MIX) + (size_t)row * DM + 512 + h * 128 + e, o * rs * bf2f(Zr[ZGR + h * 128 + e])); }
    LDS_WAIT(); __syncthreads();
}

__device__ __forceinline__ void ret_scan(Frame& F, int wgi) {
    const int tid = fresh_tid(), lane = tid & 63; (void)tid; (void)lane;
    const int bh = wgi >> 4, p = (wgi & 15) * 4 + (tid >> 7), e = tid & 127, h = bh & 3;
    const float g = exp2f(128.f * log2gamma(h));
    const float* up = WSP(float, WS_U) + ((size_t)(bh * 64) * 64 + p) * 128 + e;
    bf16* sp = WSP(bf16, WS_SPT) + ((size_t)(bh * 64) * 128 + e) * 64 + p;
    float st = 0.f;
    for (int c0 = 0; c0 < 64; c0 += 8) { float uu[8];
#pragma unroll
        for (int i = 0; i < 8; ++i) uu[i] = up[(size_t)(c0 + i) * 8192];
#pragma unroll
        for (int i = 0; i < 8; ++i) { st_bf16(sp + (size_t)(c0 + i) * 8192, st); st = g * st + uu[i]; } }
    const int dn = (p >> 1) + 32 * (p & 1);
    F.out[OS_P + ((size_t)(bh * 64 + dn)) * 128 + e] = st;
}
__device__ __forceinline__ void merge_a_rows(Frame& F) {
    const int tid = fresh_tid(), lane = tid & 63; (void)tid; (void)lane;
    const int gw = F.vcu * NWAVES + F.wave, NGW = F.G * NWAVES, l = lane;
    const float lam = lam_value(F, lane);
    const f32x4 g0 = *(const GAS f32x4*)(F.in[I_SUBLN] + (8 * l & 127)), g1 = *(const GAS f32x4*)(F.in[I_SUBLN] + (8 * l & 127) + 4);
    const bf16* OA = WSP(bf16, WS_OA); bf16* MIX = WSP(bf16, WS_MIX);
    for (int m = gw; m < MV; m += NGW) {
        const v4u a = *(const GAS v4u*)(OA + (size_t)m * DM + 8 * l), b = *(const GAS v4u*)(OA + (size_t)m * DM + 512 + 8 * l);
        float x[8];
        x[0] = bflo(a.x) - lam * bflo(b.x); x[1] = bfhi(a.x) - lam * bfhi(b.x); x[2] = bflo(a.y) - lam * bflo(b.y); x[3] = bfhi(a.y) - lam * bfhi(b.y);
        x[4] = bflo(a.z) - lam * bflo(b.z); x[5] = bfhi(a.z) - lam * bfhi(b.z); x[6] = bflo(a.w) - lam * bflo(b.w); x[7] = bfhi(a.w) - lam * bfhi(b.w);
        float ss = 0.f;
#pragma unroll
        for (int i = 0; i < 8; ++i) ss += x[i] * x[i];
        ss = row16_sum(ss);
        const float rs = ONE_M_LAMINIT / sqrtf(ss * (1.f / 128.f) + EPS);
        v4u o; o.x = pk2(x[0] * rs * g0.x, x[1] * rs * g0.y); o.y = pk2(x[2] * rs * g0.z, x[3] * rs * g0.w); o.z = pk2(x[4] * rs * g1.x, x[5] * rs * g1.y); o.w = pk2(x[6] * rs * g1.z, x[7] * rs * g1.w);
        *(GAS v4u*)(MIX + (size_t)m * DM + 8 * l) = o;
    }
}

__device__ __forceinline__ void ret_stepC(Frame& F, int bh, int c) {
    const int tid = fresh_tid(), lane = tid & 63; (void)tid;
    LAS float* psum = (LAS float*)(F.lds);
    const int w = F.wave, r = lane & 31, hh = lane >> 5, rb = w >> 1, ch = w & 1, b = bh >> 2, h = bh & 3;
    const size_t row0 = (size_t)b * TSEQ + c * 128;
    const bf16* Z = WSP(bf16, WS_Z);
    const float l2g = log2gamma(h);
    bf16x8 qf[4];
#pragma unroll
    for (int ks = 0; ks < 4; ++ks) qf[ks] = *(const GAS bf16x8*)(Z + (row0 + 32 * rb + r) * DIN + ZQR + h * 64 + 16 * ks + 8 * hh);
    f32x16 o[2], oc[2];
    o[0] = (f32x16){}; o[1] = (f32x16){}; oc[0] = (f32x16){}; oc[1] = (f32x16){};
    const bf16* spt = WSP(bf16, WS_SPT) + ((size_t)(bh * 64 + c) * 128 + 64 * ch + r) * 64 + 8 * hh;
    const bf16* vt = WSP(bf16, WS_VRT) + ((size_t)(bh * 128 + 64 * ch + r)) * TSEQ + c * 128 + 4 * hh;
    const bf16* kz = Z + (row0 + r) * DIN + ZKR + h * 64 + 8 * hh;
    bf16x8 sb[2][4]; unsigned short gt[16][2];
#pragma unroll
    for (int eb = 0; eb < 2; ++eb)
#pragma unroll
        for (int ks = 0; ks < 4; ++ks) sb[eb][ks] = *(const GAS bf16x8*)(spt + (size_t)(32 * eb) * 64 + 16 * ks);
#pragma unroll
    for (int q = 0; q < 16; ++q)
#pragma unroll
        for (int eb = 0; eb < 2; ++eb) gt[q][eb] = *(const GAS unsigned short*)(Z + (row0 + 32 * rb + crow16(q, hh)) * DIN + ZGR + h * 128 + 64 * ch + 32 * eb + r);
#pragma unroll
    for (int half = 0; half < 2; ++half) {
        if (2 * half > rb) break;
        bf16x8 kf[2][4]; u32x2 vlo[2][2][2], vhi[2][2][2];
#pragma unroll
        for (int jj = 0; jj < 2; ++jj) { const int jb = 2 * half + jj;
#pragma unroll
            for (int ks = 0; ks < 4; ++ks) kf[jj][ks] = *(const GAS bf16x8*)(kz + (size_t)(32 * jb) * DIN + 16 * ks);
#pragma unroll
            for (int s2 = 0; s2 < 2; ++s2)
#pragma unroll
                for (int eb = 0; eb < 2; ++eb) { const bf16* vp = vt + (size_t)(32 * eb) * TSEQ + 32 * jb + 16 * s2; vlo[jj][s2][eb] = *(const GAS u32x2*)vp; vhi[jj][s2][eb] = *(const GAS u32x2*)(vp + 8); } }
        if (half == 0) {
#pragma unroll
            for (int eb = 0; eb < 2; ++eb)
#pragma unroll
                for (int ks = 0; ks < 4; ++ks) oc[eb] = mfma32(qf[ks], sb[eb][ks], oc[eb]); }
#pragma unroll
        for (int jj = 0; jj < 2; ++jj) { const int jb = 2 * half + jj;
            if (jb <= rb) {
                f32x16 st = {};
#pragma unroll
                for (int ks = 0; ks < 4; ++ks) st = mfma32(kf[jj][ks], qf[ks], st);
                const int irel = 32 * (rb - jb) + r;
#pragma unroll
                for (int q = 0; q < 16; ++q) { const int d = irel - crow16(q, hh); st[q] = d >= 0 ? st[q] * exp2f((float)d * l2g) : 0.f; }
#pragma unroll
                for (int s2 = 0; s2 < 2; ++s2) {
                    v4u pw; pw.x = pg8::cvt_pk_bf16(st[8 * s2 + 0], st[8 * s2 + 1]); pw.y = pg8::cvt_pk_bf16(st[8 * s2 + 2], st[8 * s2 + 3]); pw.z = pg8::cvt_pk_bf16(st[8 * s2 + 4], st[8 * s2 + 5]); pw.w = pg8::cvt_pk_bf16(st[8 * s2 + 6], st[8 * s2 + 7]);
                    const bf16x8 pa = __builtin_bit_cast(bf16x8, pw);
#pragma unroll
                    for (int eb = 0; eb < 2; ++eb) { v4u vb; vb.x = vlo[jj][s2][eb].x; vb.y = vlo[jj][s2][eb].y; vb.z = vhi[jj][s2][eb].x; vb.w = vhi[jj][s2][eb].y;
                        o[eb] = mfma32(pa, __builtin_bit_cast(bf16x8, vb), o[eb]); }
                }
            }
        }
    }
    float ssr[16];
#pragma unroll
    for (int q = 0; q < 16; ++q) { const float sc = exp2f((float)(32 * rb + crow16(q, hh) + 1) * l2g);
        o[0][q] += sc * oc[0][q]; o[1][q] += sc * oc[1][q];
        float ss = o[0][q] * o[0][q] + o[1][q] * o[1][q]; ss = row16_sum(ss); ss += __shfl_xor(ss, 16); ssr[q] = ss; }
    if (r == 0) {
#pragma unroll
        for (int q = 0; q < 16; ++q) psum[ch * 128 + 32 * rb + crow16(q, hh)] = ssr[q]; }
    LDS_WAIT(); __syncthreads();
    bf16* MIX = WSP(bf16, WS_MIX);
#pragma unroll
    for (int q = 0; q < 16; ++q) { const int i = 32 * rb + crow16(q, hh); const float rs = 1.f / sqrtf((psum[i] + psum[128 + i]) * (1.f / 128.f) + EPS);
#pragma unroll
        for (int eb = 0; eb < 2; ++eb) { const int e = 64 * ch + 32 * eb + r;
            st_bf16(MIX + (row0 + i) * DM + 512 + h * 128 + e, o[eb][q] * rs * bf2f(gt[q][eb])); } }
    LDS_WAIT(); __syncthreads();
}

__device__ __forceinline__ void dec_mem_unit(Frame& F, int s, int hp) {
    const int tid = fresh_tid(), lane = tid & 63; (void)tid; (void)lane;
    LAS float* sc = (LAS float*)(F.lds);
    LAS float* wo = (LAS float*)(F.lds + 4096);
    const int w = F.wave, l = lane, row = MP + s;
    const bf16* QM = WSP(bf16, WS_QM);
    f32x4 q4[2];
#pragma unroll
    for (int hs = 0; hs < 2; ++hs) { const u32x2 qq = *(const GAS u32x2*)(QM + (size_t)row * DM + (2 * hp + hs) * 256 + 4 * l); q4[hs] = (f32x4){bflo(qq.x), bfhi(qq.x), bflo(qq.y), bfhi(qq.y)}; }
    const float* ck = F.in[I_CMK] + ((size_t)s * NMEM * 4 + 2 * hp) * 256 + 4 * l; const float* cv = F.in[I_CMV] + ((size_t)s * NMEM * 4 + 2 * hp) * 256 + 4 * l;
    for (int m0 = 0; m0 < 32; m0 += 4) { f32x4 kv[8];
#pragma unroll
        for (int i = 0; i < 8; ++i) kv[i] = *(const GAS f32x4*)(ck + (size_t)(32 * w + m0 + (i >> 1)) * 1024 + (i & 1) * 256);
#pragma unroll
        for (int i = 0; i < 8; ++i) { const f32x4 q = q4[i & 1]; float p = (kv[i].x * q.x + kv[i].y * q.y) + (kv[i].z * q.z + kv[i].w * q.w); p = wave_sum(p);
            if (l == 0) sc[(i & 1) * 256 + 32 * w + m0 + (i >> 1)] = p; } }
    LDS_WAIT(); __syncthreads();
    float M[2], IL[2];
#pragma unroll
    for (int hs = 0; hs < 2; ++hs) { const f32x4 v = *(const LAS f32x4*)(sc + hs * 256 + 4 * l); const float mx = wave_max(fmaxf(fmaxf(v.x, v.y), fmaxf(v.z, v.w)));
        const float sm = (__builtin_amdgcn_exp2f(v.x - mx) + __builtin_amdgcn_exp2f(v.y - mx)) + (__builtin_amdgcn_exp2f(v.z - mx) + __builtin_amdgcn_exp2f(v.w - mx));
        M[hs] = mx; IL[hs] = 1.f / wave_sum(sm); }
    f32x4 o[2]; o[0] = (f32x4){0.f, 0.f, 0.f, 0.f}; o[1] = (f32x4){0.f, 0.f, 0.f, 0.f};
    for (int m0 = 0; m0 < 32; m0 += 4) { f32x4 vv[8];
#pragma unroll
        for (int i = 0; i < 8; ++i) vv[i] = *(const GAS f32x4*)(cv + (size_t)(32 * w + m0 + (i >> 1)) * 1024 + (i & 1) * 256);
#pragma unroll
        for (int i = 0; i < 8; ++i) { const int hs = i & 1; const float p = __builtin_amdgcn_exp2f(sc[hs * 256 + 32 * w + m0 + (i >> 1)] - M[hs]) * IL[hs]; o[hs] = o[hs] + vv[i] * p; } }
    *(LAS f32x4*)(wo + ((w * 2 + 0) * 64 + l) * 4) = o[0]; *(LAS f32x4*)(wo + ((w * 2 + 1) * 64 + l) * 4) = o[1];
    LDS_WAIT(); __syncthreads();
    if (tid < 128) { const int hs = tid >> 6, ll = tid & 63; f32x4 a = {0.f, 0.f, 0.f, 0.f};
#pragma unroll
        for (int ww = 0; ww < 8; ++ww) a = a + *(const LAS f32x4*)(wo + ((ww * 2 + hs) * 64 + ll) * 4);
        u32x2 ov; ov.x = pk2(a.x, a.y); ov.y = pk2(a.z, a.w);
        *(GAS u32x2*)(WSP(bf16, WS_OM) + (size_t)row * DM + (2 * hp + hs) * 256 + 4 * ll) = ov; }
    LDS_WAIT(); __syncthreads();
}

__device__ __forceinline__ void final_norm_rows(Frame& F) {
    const int tid = fresh_tid(), lane = tid & 63; (void)tid; (void)lane;
    const int gw = F.vcu * NWAVES + F.wave, NGW = F.G * NWAVES, l = lane;
    const float* X3 = WSP(float, WS_X3); const float* ssq = WSP(float, WS_SSQ3);
    for (int m = gw; m < MV; m += NGW) {
        float s;
        if (m < MP) s = row16_sum(ssq[(size_t)m * 16 + (l & 15)]);
        else { const f32x2 q = *(const GAS f32x2*)(WSP(float, WS_SSQS3) + (m - MP) * 32 + 2 * (l & 15)); s = row16_sum(q.x + q.y); }
        const float rs = 1.f / sqrtf(s * (1.f / DM) + EPS);
        float* dst = m < MP ? F.out + OY_P + (size_t)m * DM : F.out + OY_S + (size_t)(m - MP) * DM;
#pragma unroll
        for (int j = 0; j < 4; ++j) { const f32x4 x = *(const GAS f32x4*)(X3 + (size_t)m * DM + 256 * j + 4 * l), g = *(const GAS f32x4*)(F.in[I_NFIN] + 256 * j + 4 * l);
            *(GAS f32x4*)(dst + 256 * j + 4 * l) = x * rs * g; }
    }
}

template <int K, class Epi> __device__ __forceinline__ void sgemm_unit(Frame& F, const bf16* A, int lda, const bf16* Bt, int rb, int cb, const Epi& E) {
    const int tid = fresh_tid(), lane = tid & 63, r = lane & 31, hh = lane >> 5, w = F.wave;
    constexpr int KW = K / 8, NS = KW / 16;
    LAS float* part = (LAS float*)(F.lds);
    const bf16* ap = A + (size_t)(32 * rb + r) * lda + w * KW + 8 * hh; const bf16* bp = Bt + (size_t)(32 * cb + r) * K + w * KW + 8 * hh;
    f32x16 acc = {};
#pragma unroll
    for (int s0 = 0; s0 < NS; s0 += 8) { bf16x8 af[8], bfr[8];
#pragma unroll
        for (int i = 0; i < 8; ++i) { af[i] = *(const GAS bf16x8*)(ap + 16 * (s0 + i)); bfr[i] = *(const GAS bf16x8*)(bp + 16 * (s0 + i)); }
#pragma unroll
        for (int i = 0; i < 8; ++i) acc = mfma32(af[i], bfr[i], acc); }
#pragma unroll
    for (int q = 0; q < 16; ++q) part[(w * 32 + crow16(q, hh)) * 32 + r] = acc[q];
    LDS_WAIT(); __syncthreads();
    const int row = tid >> 4, c2 = (tid & 15) * 2; float v0 = 0.f, v1 = 0.f;
#pragma unroll
    for (int ww = 0; ww < 8; ++ww) { const LAS float* p = part + (ww * 32 + row) * 32 + c2; v0 += p[0]; v1 += p[1]; }
    E(32 * rb + row, 32 * cb + c2, v0, v1, lane);
    LDS_WAIT(); __syncthreads();
}
__device__ __forceinline__ unsigned pk2c(float a, float b) { return pg8::cvt_pk_bf16(a, b); }
struct SEpiZ {
    bf16* Z; float* out;
    __device__ __forceinline__ void operator()(int srow, int col, float v0, float v1, int lane) const {
        bf16* zp = Z + (size_t)(MP + srow) * DIN + col;
        if (col < ZKA) { v0 *= C2A; v1 *= C2A; }
        else if (col < ZQR) { float* dst = out + (col < ZVA ? OK_S + (size_t)srow * 512 + (col - ZKA) : OV_S + (size_t)srow * 512 + (col - ZVA)); *(GAS f32x2*)dst = (f32x2){v0, v1}; }
        else if (col < ZVR) { const int j = ((col - ZQR) & 63) >> 1; const float ang = (float)PASTLEN * exp2f(-(float)j * (13.287712379549449f / 31.0f));
            double rv = (double)ang * 0.15915494309189535; rv -= floor(rv); const float rf = (float)rv; const float sn = __builtin_amdgcn_sinf(rf), cs = __builtin_amdgcn_cosf(rf);
            const float y0 = v0 * cs - v1 * sn, y1 = v1 * cs + v0 * sn; const float sc = col >= ZKR ? 0.125f : 1.0f; v0 = y0 * sc; v1 = y1 * sc; }
        else if (col >= ZGR) { v0 = v0 * __builtin_amdgcn_rcpf(1.f + __builtin_amdgcn_exp2f(-v0 * LOG2E)); v1 = v1 * __builtin_amdgcn_rcpf(1.f + __builtin_amdgcn_exp2f(-v1 * LOG2E)); }
        *(GAS unsigned*)zp = pk2c(v0, v1);
    }
};
template <bool BASEBF> struct SEpiRes {
    const void* base; float* outf; bf16* outb; float* ssq;
    __device__ __forceinline__ void operator()(int srow, int col, float v0, float v1, int lane) const {
        float b0, b1;
        if (BASEBF) { const unsigned bb = *(const GAS unsigned*)((const bf16*)base + (size_t)srow * DM + col); b0 = bflo(bb); b1 = bfhi(bb); }
        else { const f32x2 b = *(const GAS f32x2*)((const float*)base + (size_t)srow * DM + col); b0 = b.x; b1 = b.y; }
        const float o0 = b0 + v0, o1 = b1 + v1;
        if (outf) *(GAS f32x2*)(outf + (size_t)srow * DM + col) = (f32x2){o0, o1};
        if (outb) *(GAS unsigned*)(outb + (size_t)srow * DM + col) = pk2c(o0, o1);
        const float ss = row16_sum(o0 * o0 + o1 * o1);
        if ((lane & 15) == 0) ssq[srow * 32 + (col >> 5)] = ss;
    }
};
template <int ACT> struct SEpiScale {
    bf16* O; int ldc; const float* ssq; float scale;
    __device__ __forceinline__ void operator()(int srow, int col, float v0, float v1, int lane) const {
        const f32x2 q = *(const GAS f32x2*)(ssq + srow * 32 + 2 * (lane & 15)); const float s = row16_sum(q.x + q.y);
        const float rs = scale / sqrtf(s * (1.f / DM) + EPS); v0 *= rs; v1 *= rs;
        if (ACT == 1) { v0 = fmaxf(v0, 0.f); v1 = fmaxf(v1, 0.f); v0 *= v0; v1 *= v1; }
        *(GAS unsigned*)(O + (size_t)srow * ldc + col) = pk2c(v0, v1);
    }
};

#ifndef PG8_SP2
#define PG8_SP2 true
#endif
#ifndef PG8_ALIGN
#define PG8_ALIGN true
#endif
struct Args { const float* in[N_IN]; float* out; unsigned char* ws; int ph_lo, ph_hi, li, pad; };
__global__ void __launch_bounds__(NWAVES * 64, 2) fwd(Args args) {
    extern __shared__ __attribute__((aligned(16))) unsigned char lds[];
    Frame F;
    F.lds = (LAS unsigned char*)lds;
    F.MISC = (volatile LAS unsigned*)(F.lds + MISC_OFF);
    const int tid0 = threadIdx.x; F.wave = __builtin_amdgcn_readfirstlane(tid0 >> 6);
    F.G = gridDim.x; { const int bx = blockIdx.x; F.vcu = (F.G % 8 == 0) ? (bx % 8) * (F.G / 8) + bx / 8 : bx; }
    F.in = args.in; F.out = args.out; F.ws = args.ws;
    F.ctl = (gu32*)(args.ws + WS_CTL);
    for (int u = tid0; u < (TAB_OFF - LDSCTL_OFF) / 4; u += NWAVES * 64) ((LAS unsigned*)(F.lds + LDSCTL_OFF))[u] = 0u;
    { const int h = tid0 >> 7, rel = tid0 & 127; const float* rb = args.in[I_RELB];
      ((LAS float*)(F.lds + TAB_OFF))[tid0] = (rb[t5_bucket(rel) * 4 + h] - rb[31 * 4 + h]) * LOG2E; }
    __syncthreads();
#if MK_PER_PHASE
#define GRID_BAR() do { } while (0)
#else
    XcdBarrier bar = xcd_barrier_post((unsigned*)(F.ctl + CW_BAR) + args.li * XCD_BAR_WORDS, F.MISC + 8);
#define GRID_BAR() xcd_barrier(bar)
#endif
    const int lo = args.ph_lo, hi = args.ph_hi, bx = blockIdx.x;
#define IN(k) (lo <= (k) && (k) < hi)
#define BOTH(k) (IN(k) && IN((k) + 1))
    bf16* const Zb = WSP(bf16, WS_Z);

    if (IN(0)) { p0_prologue(F); if (BOTH(0)) GRID_BAR(); }

    if (IN(1)) {
        { pg8::Gemm g{WSP(bf16, WS_XN), WSP(bf16, WS_WIN), MP, DIN, DM, DM, DM}; pg8::StaticOrder S; S.init(MP, DIN, F.G, bx);
          EpiZ E{Zb, F.out, WSP(bf16, WS_KRT), WSP(bf16, WS_VRT)};
          pg8::gemm_phase<EpiZ, pg8::StaticOrder, PG8_ALIGN, PG8_SP2>(F.lds + RING_OFF, g, S, E); }
        for (int u = bx; u < 4 * (DIN / 32); u += F.G) sgemm_unit<DM>(F, WSP(bf16, WS_XN) + (size_t)MP * DM, DM, WSP(bf16, WS_WIN), u & 3, u >> 2, SEpiZ{Zb, F.out});
        if (BOTH(1)) GRID_BAR();
    }

    if (IN(2)) {
        const attn_body::StaticOrder S((int)F.G, bx); const int slot = F.vcu % 5;
        { attn_body::AttnUnit au;
          for (int i = 0; i < slot && S.next(i, au); ++i) attn_body::attn_one<8>((char*)lds + RING_OFF, (const attn_body::bf16*)Zb, (attn_body::bf16*)WSP(bf16, WS_OA), (attn_body::lds_cfp)(F.lds + TAB_OFF), au); }
        __syncthreads();
        for (int u = bx; u < 512; u += F.G) ret_stepA(F, u >> 6, u & 63);
        for (int u = bx; u < 256; u += F.G) dec_attn_unit(F, u >> 1, u & 1);
        for (int u = bx; u < 512; u += F.G) dec_ret_unit(F, u >> 2, u & 3);
        { attn_body::AttnUnit au;
          for (int i = slot; S.next(i, au); ++i) attn_body::attn_one<8>((char*)lds + RING_OFF, (const attn_body::bf16*)Zb, (attn_body::bf16*)WSP(bf16, WS_OA), (attn_body::lds_cfp)(F.lds + TAB_OFF), au); }
        if (BOTH(2)) GRID_BAR();
    }

    if (IN(3)) {
        if (bx < 128) ret_scan(F, bx);
        { pg8::Gemm g{WSP(bf16, WS_MEMN), WSP(bf16, WS_WMKV), 2 * NMEM, 2 * DM, DM, DM, DM}; pg8::StaticOrder S; S.init(2 * NMEM, 2 * DM, F.G, (bx + F.G - 128) % F.G);
          EpiMemKV E{F.out, WSP(bf16, WS_MKB), WSP(bf16, WS_MVT)};
          pg8::gemm_phase<EpiMemKV, pg8::StaticOrder, PG8_ALIGN, PG8_SP2>(F.lds + RING_OFF, g, S, E); }
        merge_a_rows(F);
        if (BOTH(3)) GRID_BAR();
    }

    if (IN(4)) { for (int u = bx; u < 512; u += F.G) ret_stepC(F, u >> 6, u & 63); if (BOTH(4)) GRID_BAR(); }

    if (IN(5)) {
        pg8::Gemm g{WSP(bf16, WS_MIX), WSP(bf16, WS_WOUT), MP, DM, DM, DM, DM}; pg8::StaticOrder S; S.init(MP, DM, F.G, bx);
        EpiRes<false> E{args.in[I_XP], nullptr, WSP(bf16, WS_X1B), WSP(float, WS_SSQ1)};
        pg8::gemm_phase<EpiRes<false>, pg8::StaticOrder, PG8_ALIGN, PG8_SP2>(F.lds + RING_OFF, g, S, E);
        for (int u = bx; u < 4 * (DM / 32); u += F.G) sgemm_unit<DM>(F, WSP(bf16, WS_MIX) + (size_t)MP * DM, DM, WSP(bf16, WS_WOUT), u & 3, u >> 2,
            SEpiRes<false>{args.in[I_XS], nullptr, WSP(bf16, WS_X1B) + (size_t)MP * DM, WSP(float, WS_SSQS1)});
        if (BOTH(5)) GRID_BAR();
    }

    if (IN(6)) {
        pg8::Gemm g{WSP(bf16, WS_X1B), WSP(bf16, WS_WMQ), MP, DM, DM, DM, DM}; pg8::StaticOrder S; S.init(MP, DM, F.G, bx);
        EpiScale<0> E{WSP(bf16, WS_QM), DM, WSP(float, WS_SSQ1), C2M};
        pg8::gemm_phase<EpiScale<0>, pg8::StaticOrder, PG8_ALIGN, PG8_SP2>(F.lds + RING_OFF, g, S, E);
        for (int u = bx; u < 4 * (DM / 32); u += F.G) sgemm_unit<DM>(F, WSP(bf16, WS_X1B) + (size_t)MP * DM, DM, WSP(bf16, WS_WMQ), u & 3, u >> 2,
            SEpiScale<0>{WSP(bf16, WS_QM) + (size_t)MP * DM, DM, WSP(float, WS_SSQS1), C2M});
        if (BOTH(6)) GRID_BAR();
    }

    if (IN(7)) {
        if (bx < 256) {
            const int panel = bx >> 2, h = bx & 3, b = panel >> 5;
            { pg8::Gemm g{WSP(bf16, WS_QM) + h * 256, WSP(bf16, WS_MKB) + (size_t)b * NMEM * DM + h * 256, MP, 256, 256, DM, DM}; pg8::OneUnit S{{panel, 0}, true};
              EpiSoftmax E{WSP(bf16, WS_PM) + h * 256, DM};
              pg8::gemm_phase<EpiSoftmax, pg8::OneUnit, false, PG8_SP2>(F.lds + RING_OFF, g, S, E); }
            VM_WAIT(); __syncthreads();
            { pg8::Gemm g{WSP(bf16, WS_PM) + h * 256, WSP(bf16, WS_MVT) + (size_t)h * 256 * 512 + b * NMEM, MP, 256, 256, DM, 512}; pg8::OneUnit S{{panel, 0}, true};
              EpiPlain E{WSP(bf16, WS_OM) + h * 256, DM};
              pg8::gemm_phase<EpiPlain, pg8::OneUnit, false, PG8_SP2>(F.lds + RING_OFF, g, S, E); }
            __syncthreads();
            dec_mem_unit(F, bx >> 1, bx & 1);
        }
        if (BOTH(7)) GRID_BAR();
    }

    if (IN(8)) {
        pg8::Gemm g{WSP(bf16, WS_OM), WSP(bf16, WS_WMO), MP, DM, DM, DM, DM}; pg8::StaticOrder S; S.init(MP, DM, F.G, bx);
        EpiRes<true> E{WSP(bf16, WS_X1B), nullptr, WSP(bf16, WS_X2B), WSP(float, WS_SSQ2)};
        pg8::gemm_phase<EpiRes<true>, pg8::StaticOrder, PG8_ALIGN, PG8_SP2>(F.lds + RING_OFF, g, S, E);
        for (int u = bx; u < 4 * (DM / 32); u += F.G) sgemm_unit<DM>(F, WSP(bf16, WS_OM) + (size_t)MP * DM, DM, WSP(bf16, WS_WMO), u & 3, u >> 2,
            SEpiRes<true>{WSP(bf16, WS_X1B) + (size_t)MP * DM, nullptr, WSP(bf16, WS_X2B) + (size_t)MP * DM, WSP(float, WS_SSQS2)});
        if (BOTH(8)) GRID_BAR();
    }

    if (IN(9)) {
        pg8::Gemm g{WSP(bf16, WS_X2B), WSP(bf16, WS_WUP), MP, FF, DM, DM, DM}; pg8::StaticOrder S; S.init(MP, FF, F.G, bx);
        EpiScale<1> E{WSP(bf16, WS_H), FF, WSP(float, WS_SSQ2), 1.0f};
        pg8::gemm_phase<EpiScale<1>, pg8::StaticOrder, PG8_ALIGN, PG8_SP2>(F.lds + RING_OFF, g, S, E);
        for (int u = bx; u < 4 * (FF / 32); u += F.G) sgemm_unit<DM>(F, WSP(bf16, WS_X2B) + (size_t)MP * DM, DM, WSP(bf16, WS_WUP), u & 3, u >> 2,
            SEpiScale<1>{WSP(bf16, WS_H) + (size_t)MP * FF, FF, WSP(float, WS_SSQS2), 1.0f});
        if (BOTH(9)) GRID_BAR();
    }

    if (IN(10)) {
        pg8::Gemm g{WSP(bf16, WS_H), WSP(bf16, WS_WDN), MP, DM, FF, FF, FF}; pg8::StaticOrder S; S.init(MP, DM, F.G, bx);
        EpiRes<true> E{WSP(bf16, WS_X2B), WSP(float, WS_X3), nullptr, WSP(float, WS_SSQ3)};
        pg8::gemm_phase<EpiRes<true>, pg8::StaticOrder, PG8_ALIGN, PG8_SP2>(F.lds + RING_OFF, g, S, E);
        for (int u = bx; u < 4 * (DM / 32); u += F.G) sgemm_unit<FF>(F, WSP(bf16, WS_H) + (size_t)MP * FF, FF, WSP(bf16, WS_WDN), u & 3, u >> 2,
            SEpiRes<true>{WSP(bf16, WS_X2B) + (size_t)MP * DM, WSP(float, WS_X3) + (size_t)MP * DM, nullptr, WSP(float, WS_SSQS3)});
        if (BOTH(10)) GRID_BAR();
    }

    if (IN(11)) final_norm_rows(F);
#undef IN
#undef BOTH
}

extern "C" void kernel_launch(void* const* d_in, const int* in_sizes, int n_in, void* d_out, int out_size, void* d_ws, size_t ws_size, hipStream_t stream) {
    static int grid = 0;
    if (grid == 0) {
        if (n_in != N_IN || in_sizes[0] != MP * DM || (size_t)out_size != OUT_TOTAL || ws_size < WS_END) { fprintf(stderr, "kernel_launch: unexpected shapes (n_in %d, in0 %d, out %d, ws %zu); nothing launched\n", n_in, n_in > 0 ? in_sizes[0] : -1, out_size, ws_size); grid = -1; return; }
        int dev = 0, cus = 0, per_cu = 0;
        if (hipGetDevice(&dev) != hipSuccess || hipDeviceGetAttribute(&cus, hipDeviceAttributeMultiprocessorCount, dev) != hipSuccess) { fprintf(stderr, "kernel_launch: device query failed\n"); grid = -1; return; }
        if (hipFuncSetAttribute((const void*)fwd, hipFuncAttributeMaxDynamicSharedMemorySize, LDS_BYTES) != hipSuccess) { fprintf(stderr, "kernel_launch: hipFuncSetAttribute failed\n"); grid = -1; return; }
        if (hipOccupancyMaxActiveBlocksPerMultiprocessor(&per_cu, (const void*)fwd, NWAVES * 64, LDS_BYTES) != hipSuccess || per_cu < 1)
            fprintf(stderr, "kernel_launch: note: occupancy query reports %d workgroups per CU\n", per_cu);
        (void)hipGetLastError();
        grid = cus;
        if (grid != 256) fprintf(stderr, "kernel_launch: this kernel's static work split expects 256 CUs, found %d\n", grid);
    }
    if (grid < 0) return;
    if (hipMemsetAsync((char*)d_ws + WS_CTL, 0, CTL_ZERO_BYTES, stream) != hipSuccess) { fprintf(stderr, "kernel_launch: memset failed\n"); return; }
    Args a{};
    for (int i = 0; i < N_IN; ++i) a.in[i] = (const float*)d_in[i];
    a.out = (float*)d_out; a.ws = (unsigned char*)d_ws;
#if MK_PER_PHASE
    for (int p = 0; p < NPH; ++p) { a.ph_lo = p; a.ph_hi = p + 1; hipLaunchKernelGGL(fwd, dim3(grid), dim3(NWAVES * 64), LDS_BYTES, stream, a); }
#elif defined(PROBE_DUP)
    a.ph_lo = 0; a.ph_hi = PROBE_DUP + 1; a.li = 0; hipLaunchKernelGGL(fwd, dim3(grid), dim3(NWAVES * 64), LDS_BYTES, stream, a);
    a.ph_lo = PROBE_DUP; a.ph_hi = NPH; a.li = 1; hipLaunchKernelGGL(fwd, dim3(grid), dim3(NWAVES * 64), LDS_BYTES, stream, a);
#else
    a.ph_lo = 0; a.ph_hi = NPH; hipLaunchKernelGGL(fwd, dim3(grid), dim3(NWAVES * 64), LDS_BYTES, stream, a);
#endif
    const hipError_t le = hipPeekAtLastError();
    if (le != hipSuccess) fprintf(stderr, "kernel_launch: launch failed: %s\n", hipGetErrorName(le));
}
```
